# Optimizing an MI355X kernel written in HIP

```python
import math
import jax, jax.numpy as jnp
from jax import lax
import numpy as np

D_MODEL = 2048
BATCH = 4
SEQ = 4096
DEPTH = 4

CHUNK = 64
Q_BLOCK = 128
ROPE_THETA = 10000.0
EPS = 1e-6

DIFF_HEADS = 8
DIFF_QK_DIM = 64
DIFF_V_DIM = 128

MLA_HEADS = 8
MLA_Q_RANK = 512
MLA_KV_RANK = 256
MLA_NOPE_DIM = 128
MLA_ROPE_DIM = 64
MLA_V_DIM = 128

MEM_TOKENS = 256
MEM_HEADS = 4
MEM_HEAD_DIM = D_MODEL // MEM_HEADS

D_FF = 5632
CONV_WIDTH = 3

DIFF_WIDTH = DIFF_HEADS * DIFF_V_DIM
MLA_WIDTH = MLA_HEADS * MLA_V_DIM
IN_WIDTHS = (DIFF_HEADS * 2 * DIFF_QK_DIM,
             DIFF_HEADS * 2 * DIFF_QK_DIM,
             DIFF_WIDTH,
             MLA_Q_RANK,
             MLA_KV_RANK,
             MLA_ROPE_DIM,
             2 * D_MODEL)
N_IN = sum(IN_WIDTHS)

kernel_name = "hybrid_diffattn_mla_gated_convffn"


def _rms(x, g):
    xf = x.astype(jnp.float32)
    y = xf * lax.rsqrt(jnp.mean(xf * xf, axis=-1, keepdims=True) + EPS)
    return (y * g.astype(jnp.float32)).astype(x.dtype)


def _rope(x, pos):
    d = x.shape[-1]
    inv = ROPE_THETA ** (-jnp.arange(0, d, 2, dtype=jnp.float32) / d)
    ang = pos.astype(jnp.float32)[..., None] * inv
    cos = jnp.cos(ang)[:, :, None, :]
    sin = jnp.sin(ang)[:, :, None, :]
    xf = x.astype(jnp.float32)
    x1, x2 = xf[..., : d // 2], xf[..., d // 2:]
    return jnp.concatenate([x1 * cos - x2 * sin, x2 * cos + x1 * sin], axis=-1).astype(x.dtype)


def _chunk_mask(blk, seq):
    q_chunk = (blk * Q_BLOCK + jnp.arange(Q_BLOCK)) // CHUNK
    k_chunk = jnp.arange(seq) // CHUNK
    return k_chunk[None, :] <= q_chunk[:, None]


def _masked_softmax(s, mask):
    return jax.nn.softmax(jnp.where(mask, s.astype(jnp.float32), -jnp.inf), axis=-1)


def _sweep(fn, *qs):
    b, s = qs[0].shape[:2]
    nb = s // Q_BLOCK
    blocks = tuple(q.reshape(b, nb, Q_BLOCK, *q.shape[2:]).swapaxes(0, 1) for q in qs)
    out = lax.map(lambda a: fn(a[0], *a[1:]), (jnp.arange(nb), *blocks))
    return out.swapaxes(0, 1).reshape(b, s, *out.shape[3:])


def _diff_attention(dq, dk, dv, lam, lam_init, g_sub, pos):
    b, s, _ = dq.shape
    q = dq.reshape(b, s, DIFF_HEADS, 2 * DIFF_QK_DIM)
    k = dk.reshape(b, s, DIFF_HEADS, 2 * DIFF_QK_DIM)
    v = dv.reshape(b, s, DIFF_HEADS, DIFF_V_DIM)
    q1 = _rope(q[..., :DIFF_QK_DIM], pos)
    q2 = _rope(q[..., DIFF_QK_DIM:], pos)
    k1 = _rope(k[..., :DIFF_QK_DIM], pos)
    k2 = _rope(k[..., DIFF_QK_DIM:], pos)
    scale = 1.0 / math.sqrt(DIFF_QK_DIM)

    def block(blk, q1b, q2b):
        mask = _chunk_mask(blk, s)
        p1 = _masked_softmax(jnp.einsum('bqhd,bkhd->bhqk', q1b, k1) * scale, mask)
        p2 = _masked_softmax(jnp.einsum('bqhd,bkhd->bhqk', q2b, k2) * scale, mask)
        p = (p1 - lam * p2).astype(v.dtype)
        return jnp.einsum('bhqk,bkhd->bqhd', p, v)

    o = _sweep(block, q1, q2)
    o = _rms(o, g_sub) * (1.0 - lam_init)
    return o.reshape(b, s, DIFF_WIDTH)


def _mla(c_q, c_kv, k_rope, g_cq, w_uq, g_ckv, w_ukv, pos):
    b, s, _ = c_q.shape
    q = (_rms(c_q, g_cq) @ w_uq).reshape(b, s, MLA_HEADS, MLA_NOPE_DIM + MLA_ROPE_DIM)
    q_nope = q[..., :MLA_NOPE_DIM]
    q_pe = _rope(q[..., MLA_NOPE_DIM:], pos)
    kv = (_rms(c_kv, g_ckv) @ w_ukv).reshape(b, s, MLA_HEADS, MLA_NOPE_DIM + MLA_V_DIM)
    k_nope = kv[..., :MLA_NOPE_DIM]
    v = kv[..., MLA_NOPE_DIM:]
    k_pe = _rope(k_rope[:, :, None, :], pos)[:, :, 0, :]
    scale = 1.0 / math.sqrt(MLA_NOPE_DIM + MLA_ROPE_DIM)

    def block(blk, qnb, qpb):
        mask = _chunk_mask(blk, s)
        sc = jnp.einsum('bqhd,bkhd->bhqk', qnb, k_nope) + jnp.einsum('bqhd,bkd->bhqk', qpb, k_pe)
        p = _masked_softmax(sc * scale, mask).astype(v.dtype)
        return jnp.einsum('bhqk,bkhd->bqhd', p, v)

    return _sweep(block, q_nope, q_pe).reshape(b, s, MLA_WIDTH)


def _memory_attention(h, m, w_q, w_kv, w_o):
    b, s, _ = h.shape
    q = (h @ w_q).reshape(b, s, MEM_HEADS, MEM_HEAD_DIM)
    kv = (m @ w_kv).reshape(b, m.shape[1], 2, MEM_HEADS, MEM_HEAD_DIM)
    k, v = kv[:, :, 0], kv[:, :, 1]
    sc = jnp.einsum('bqhd,bkhd->bhqk', q, k) * (1.0 / math.sqrt(MEM_HEAD_DIM))
    p = jax.nn.softmax(sc.astype(jnp.float32), axis=-1).astype(v.dtype)
    o = jnp.einsum('bhqk,bkhd->bqhd', p, v).reshape(b, s, D_MODEL)
    return o @ w_o


def _conv_glu(h, w_up, conv_w, conv_b, w_down):
    s = h.shape[1]
    u = h @ w_up
    up = jnp.pad(u, ((0, 0), (CONV_WIDTH - 1, 0), (0, 0)))
    c = sum(up[:, j:j + s, :] * conv_w[j] for j in range(CONV_WIDTH)) + conv_b
    a, g = c[..., :D_FF], c[..., D_FF:]
    return (jax.nn.silu(a) * g) @ w_down


def setup_inputs(seed: int = 0) -> dict:
    key = jax.random.key(seed)
    ks = iter(jax.random.split(key, 40))
    L = DEPTH

    def w(shape, fan_in):
        return jax.random.normal(next(ks), shape, jnp.float32) * fan_in ** -0.5

    def gain(shape):
        return 1.0 + 0.05 * jax.random.normal(next(ks), shape, jnp.float32)

    x = jax.random.normal(next(ks), (BATCH, SEQ, D_MODEL), jnp.float32)
    mem = jax.random.normal(next(ks), (BATCH, MEM_TOKENS, D_MODEL), jnp.float32)
    offset = jax.random.randint(next(ks), (BATCH, 1), 0, 64, dtype=jnp.int32) * CHUNK
    positions = (offset + jnp.arange(SEQ, dtype=jnp.int32)[None, :]).astype(jnp.int32)
    return {
        "x": x,
        "mem": mem,
        "positions": positions,
        "g_pre_mix": gain((L, D_MODEL)),
        "w_in": w((L, D_MODEL, N_IN), D_MODEL),
        "b_gate": 0.1 * jax.random.normal(next(ks), (L, 2 * D_MODEL), jnp.float32),
        "lam_q1": 0.1 * jax.random.normal(next(ks), (L, DIFF_QK_DIM), jnp.float32),
        "lam_k1": 0.1 * jax.random.normal(next(ks), (L, DIFF_QK_DIM), jnp.float32),
        "lam_q2": 0.1 * jax.random.normal(next(ks), (L, DIFF_QK_DIM), jnp.float32),
        "lam_k2": 0.1 * jax.random.normal(next(ks), (L, DIFF_QK_DIM), jnp.float32),
        "g_diff_sub": gain((L, DIFF_V_DIM)),
        "g_cq": gain((L, MLA_Q_RANK)),
        "w_uq": w((L, MLA_Q_RANK, MLA_HEADS * (MLA_NOPE_DIM + MLA_ROPE_DIM)), MLA_Q_RANK),
        "g_ckv": gain((L, MLA_KV_RANK)),
        "w_ukv": w((L, MLA_KV_RANK, MLA_HEADS * (MLA_NOPE_DIM + MLA_V_DIM)), MLA_KV_RANK),
        "w_br_diff": w((L, DIFF_WIDTH, D_MODEL), DIFF_WIDTH),
        "w_br_mla": w((L, MLA_WIDTH, D_MODEL), MLA_WIDTH),
        "w_mix_out": w((L, D_MODEL, D_MODEL), D_MODEL),
        "g_post_mix": gain((L, D_MODEL)),
        "g_pre_x": gain((L, D_MODEL)),
        "g_mem": gain((L, D_MODEL)),
        "w_q_x": w((L, D_MODEL, D_MODEL), D_MODEL),
        "w_kv_x": w((L, D_MODEL, 2 * D_MODEL), D_MODEL),
        "w_o_x": w((L, D_MODEL, D_MODEL), D_MODEL),
        "g_post_x": gain((L, D_MODEL)),
        "g_pre_ffn": gain((L, D_MODEL)),
        "w_up": w((L, D_MODEL, 2 * D_FF), D_MODEL),
        "conv_w": w((L, CONV_WIDTH, 2 * D_FF), CONV_WIDTH),
        "conv_b": 0.02 * jax.random.normal(next(ks), (L, 2 * D_FF), jnp.float32),
        "w_down": w((L, D_FF, D_MODEL), D_FF),
        "g_post_ffn": gain((L, D_MODEL)),
    }


def reference(x, mem, positions, g_pre_mix, w_in, b_gate, lam_q1, lam_k1, lam_q2, lam_k2,
              g_diff_sub, g_cq, w_uq, g_ckv, w_ukv, w_br_diff, w_br_mla, w_mix_out,
              g_post_mix, g_pre_x, g_mem, w_q_x, w_kv_x, w_o_x, g_post_x, g_pre_ffn,
              w_up, conv_w, conv_b, w_down, g_post_ffn):
    split_at = [int(i) for i in np.cumsum(IN_WIDTHS)[:-1]]
    for l in range(DEPTH):
        h = _rms(x, g_pre_mix[l])
        proj = h @ w_in[l]
        dq, dk, dv, c_q, c_kv, k_rope, gt = jnp.split(proj, split_at, axis=-1)

        lam_init = 0.8 - 0.6 * math.exp(-0.3 * l)
        lam = (jnp.exp(jnp.sum(lam_q1[l].astype(jnp.float32) * lam_k1[l].astype(jnp.float32)))
               - jnp.exp(jnp.sum(lam_q2[l].astype(jnp.float32) * lam_k2[l].astype(jnp.float32)))
               + lam_init)
        o_diff = _diff_attention(dq, dk, dv, lam, lam_init, g_diff_sub[l], positions)
        o_mla = _mla(c_q, c_kv, k_rope, g_cq[l], w_uq[l], g_ckv[l], w_ukv[l], positions)

        gates = jax.nn.sigmoid((gt + b_gate[l]).astype(jnp.float32)).astype(x.dtype)
        g_a, g_b = gates[..., :D_MODEL], gates[..., D_MODEL:]
        merged = g_a * (o_diff @ w_br_diff[l]) + g_b * (o_mla @ w_br_mla[l])
        x = x + _rms(merged @ w_mix_out[l], g_post_mix[l])

        h = _rms(x, g_pre_x[l])
        m = _rms(mem, g_mem[l])
        x = x + _rms(_memory_attention(h, m, w_q_x[l], w_kv_x[l], w_o_x[l]), g_post_x[l])

        h = _rms(x, g_pre_ffn[l])
        x = x + _rms(_conv_glu(h, w_up[l], conv_w[l], conv_b[l], w_down[l]), g_post_ffn[l])
    return x
```

```cpp
#include <hip/hip_runtime.h>
#include <cstdio>
#include <cstdint>
#include <cmath>

#define LAS __attribute__((address_space(3)))
#define GAS __attribute__((address_space(1)))
typedef unsigned short bf16_t;
typedef short bf16x8 __attribute__((ext_vector_type(8)));
typedef short s16x4 __attribute__((ext_vector_type(4)));
typedef float f32x2 __attribute__((ext_vector_type(2)));
typedef float f32x4 __attribute__((ext_vector_type(4)));
typedef float f32x16 __attribute__((ext_vector_type(16)));
typedef unsigned u32x2 __attribute__((ext_vector_type(2)));
typedef unsigned u32x4 __attribute__((ext_vector_type(4)));

constexpr int DM = 2048, BATCH = 4, SEQ = 4096, DEPTH = 4, MTOK = BATCH * SEQ;
constexpr int NIN_SRC = 8000, NIN = 8192;
constexpr int DFF = 5632, NUP = 2 * DFF;
constexpr int MEMT = 256, MROWS = BATCH * MEMT;
constexpr float EPS = 1e-6f;
constexpr float LOG2E = 1.4426950408889634f;

typedef __bf16 bf16x2_t __attribute__((ext_vector_type(2)));
__device__ __forceinline__ unsigned cvt_pk_bf16(float lo, float hi) { const f32x2 v = {lo, hi}; const bf16x2_t b = __builtin_convertvector(v, bf16x2_t); return __builtin_bit_cast(unsigned, b); }
__device__ __forceinline__ u32x4 pack8(f32x4 a, f32x4 b) { u32x4 w; w.x = cvt_pk_bf16(a[0], a[1]); w.y = cvt_pk_bf16(a[2], a[3]); w.z = cvt_pk_bf16(b[0], b[1]); w.w = cvt_pk_bf16(b[2], b[3]); return w; }
__device__ __forceinline__ float bflo(unsigned w) { return __uint_as_float(w << 16); }
__device__ __forceinline__ float bfhi(unsigned w) { return __uint_as_float(w & 0xffff0000u); }
template <int O> __device__ __forceinline__ float xor_lt32(float v) { return __int_as_float(__builtin_amdgcn_ds_swizzle(__float_as_int(v), (O << 10) | 0x1f)); }
__device__ __forceinline__ float sum_xor32(float v) { auto rr = __builtin_amdgcn_permlane32_swap(__float_as_uint(v), __float_as_uint(v), false, false); return __uint_as_float(rr[0]) + __uint_as_float(rr[1]); }
__device__ __forceinline__ float max_xor32(float v) { auto rr = __builtin_amdgcn_permlane32_swap(__float_as_uint(v), __float_as_uint(v), false, false); return fmaxf(__uint_as_float(rr[0]), __uint_as_float(rr[1])); }
__device__ __forceinline__ float half_sum(float v) { v += xor_lt32<1>(v); v += xor_lt32<2>(v); v += xor_lt32<4>(v); v += xor_lt32<8>(v); v += xor_lt32<16>(v); return v; }
__device__ __forceinline__ float wave_sum(float v) { return sum_xor32(half_sum(v)); }
__device__ __forceinline__ float wave_max(float v) { v = fmaxf(v, xor_lt32<1>(v)); v = fmaxf(v, xor_lt32<2>(v)); v = fmaxf(v, xor_lt32<4>(v)); v = fmaxf(v, xor_lt32<8>(v)); v = fmaxf(v, xor_lt32<16>(v)); return max_xor32(v); }

namespace pg8 {
constexpr int BM = 256, BK = 64, HALF = 128, HTB = HALF * BK * 2  , STAGE_BYTES = 8 * HTB, NXCD = 8, WGM = 8;

__host__ __device__ __forceinline__ int lds_byte(int r, int c) { const int st = (r >> 4) * 2 + (c >> 5), rr = r & 15, cc = c & 31, ob = rr * 64 + cc * 2; return st * 1024 + (ob ^ (((ob >> 9) & 1) << 5)); }
__host__ __device__ __forceinline__ void stage_rc(int b, int& R, int& C) { const int st = b / 1024, sb = b % 1024, swz = sb ^ (((sb >> 9) & 1) << 5); R = (st >> 1) * 16 + swz / 64; C = (st & 1) * 32 + (swz % 64) / 2; }
__host__ __device__ __forceinline__ int perm32(int rho) { const int n = rho >> 4, i = rho & 15; return 8 * (i >> 2) + 4 * n + (i & 3); }

struct Unit { int pm, pn, z; unsigned aoff, boff; };
struct Gemm { const bf16_t* A; const bf16_t* Bt; int lda, ldb, K; };

struct StaticOrder {
    int nM, nN, nwg, G, c, lda, ldb;
    __host__ __device__ __forceinline__ void init(int Mr, int N, int G_, int c_, int lda_, int ldb_) { nM = Mr / BM; nN = N / BM; nwg = nM * nN; G = G_; c = c_; lda = lda_; ldb = ldb_; }
    __host__ __device__ __forceinline__ bool next(int i, Unit& u) const {
        const long L = (long)i * G + c; if (L >= nwg) return false;
        int wgid = (int)L; { const int q = nwg / NXCD, r = nwg % NXCD, xcd = wgid % NXCD, off = wgid / NXCD; wgid = (xcd < r ? xcd * (q + 1) : r * (q + 1) + (xcd - r) * q) + off; }
        const int nig = WGM * nN, gid = wgid / nig, fm = gid * WGM, gsz = (nM - fm) < WGM ? (nM - fm) : WGM;
        u.pm = fm + ((wgid % nig) % gsz); u.pn = (wgid % nig) / gsz; u.z = 0;
        u.aoff = (unsigned)u.pm * (unsigned)(BM * lda); u.boff = (unsigned)u.pn * (unsigned)(BM * ldb); return true;
    }
    __device__ __forceinline__ void a_ready(const Unit&) const {}
    __device__ __forceinline__ void done(const Unit&) const {}
};

typedef f32x4 Acc[2][2][4][2];

template <class Epi, class Sched, bool ALIGN_EPI = false, bool SP2 = false>
__device__ __forceinline__ void gemm_phase(LAS unsigned char* lds, const Gemm g, const Sched& S, const Epi& E) {
    int tid = threadIdx.x; asm volatile("" : "+v"(tid));
    const int wid = __builtin_amdgcn_readfirstlane(tid >> 6), lane = tid & 63, wr = wid >> 2, wc = wid & 3, fr = lane & 15, fq = lane >> 4;
    int K = g.K; asm volatile("" : "+s"(K));
    const int nt = K / BK;
    unsigned voffA[2], voffB[2];
#pragma unroll
    for (int i = 0; i < 2; ++i) { int R, C; stage_rc(tid * 16 + i * 8192, R, C); const int Rb = Epi::PERM ? ((R & ~31) + perm32(R & 31)) : R;
        voffA[i] = (unsigned)(R * g.lda + C) * 2u; voffB[i] = (unsigned)(Rb * g.ldb + C) * 2u; }
    const size_t kstep = (size_t)(BK * 2);
    const size_t hstepA = (size_t)HALF * g.lda * 2, hstepB = (size_t)HALF * g.ldb * 2;
    const unsigned ldsw = (unsigned)wid * 1024u;
    const int aoff = lds_byte(wr * 64 + fr, fq * 8), boff = lds_byte(wc * 32 + fr, fq * 8);
#define PG8_SA(b, h) (((b) * 2 + (h)) * HTB)
#define PG8_SB(b, h) ((4 + (b) * 2 + (h)) * HTB)
#define PG8_STAGE(bufoff, gbase, voff) do { _Pragma("unroll") for (int _i = 0; _i < 2; ++_i) \
        __builtin_amdgcn_global_load_lds((const unsigned*)((const char*)(gbase) + (voff)[_i]), (LAS unsigned*)(lds + (bufoff) + ldsw + _i * 8192), 16, 0, 0); } while (0)
#define PG8_LDA(dst, b, h) do { _Pragma("unroll") for (int m = 0; m < 4; ++m) _Pragma("unroll") for (int k = 0; k < 2; ++k) dst[m][k] = *(const LAS bf16x8*)(lds + PG8_SA(b, h) + aoff + m * 2048 + k * 1024); } while (0)
#define PG8_LDB(dst, b, h) do { _Pragma("unroll") for (int n = 0; n < 2; ++n) _Pragma("unroll") for (int k = 0; k < 2; ++k) dst[n][k] = *(const LAS bf16x8*)(lds + PG8_SB(b, h) + boff + n * 2048 + k * 1024); } while (0)
#define PG8_MMA(ai, bj, At, Bt) do { __builtin_amdgcn_s_setprio(1); _Pragma("unroll") for (int m = 0; m < 4; ++m) _Pragma("unroll") for (int n = 0; n < 2; ++n) _Pragma("unroll") for (int k = 0; k < 2; ++k) \
        acc[ai][bj][m][n] = __builtin_amdgcn_mfma_f32_16x16x32_bf16(Bt[n][k], At[m][k], acc[ai][bj][m][n], 0, 0, 0); __builtin_amdgcn_s_setprio(0); } while (0)
#define PG8_WAIT_V(n) asm volatile("s_waitcnt vmcnt(" #n ")" ::: "memory")
#define PG8_WAIT_L(n) asm volatile("s_waitcnt lgkmcnt(" #n ")" ::: "memory")
#define PG8_BAR __builtin_amdgcn_s_barrier()
#define PG8_SCHED __builtin_amdgcn_sched_barrier(0)
    Unit cur, nxt; int ui = 0;
    if (!S.next(0, cur)) return;
    f32x4 acc[2][2][4][2];
#pragma unroll
    for (int a = 0; a < 2; ++a)
#pragma unroll
        for (int b = 0; b < 2; ++b)
#pragma unroll
            for (int m = 0; m < 4; ++m)
#pragma unroll
                for (int n = 0; n < 2; ++n) acc[a][b][m][n] = (f32x4){0.f, 0.f, 0.f, 0.f};
    bf16x8 At[4][2], B0[2][2], B1[2][2];
    const char* cA = (const char*)g.A + (size_t)cur.aoff * 2; const char* cB = (const char*)g.Bt + (size_t)cur.boff * 2;
    S.a_ready(cur);
    if constexpr (SP2) {
        PG8_STAGE(PG8_SB(0, 0), cB, voffB); PG8_STAGE(PG8_SB(0, 1), cB + hstepB, voffB); PG8_STAGE(PG8_SA(0, 0), cA, voffA); PG8_STAGE(PG8_SA(0, 1), cA + hstepA, voffA);
        if (wr == 1) PG8_BAR;
        PG8_WAIT_V(2); PG8_BAR;
        PG8_STAGE(PG8_SB(1, 0), cB + kstep, voffB); PG8_STAGE(PG8_SA(1, 0), cA + kstep, voffA); PG8_STAGE(PG8_SB(1, 1), cB + hstepB + kstep, voffB);
        PG8_WAIT_V(6); PG8_BAR;
    } else {
        PG8_STAGE(PG8_SB(0, 0), cB, voffB); PG8_STAGE(PG8_SA(0, 0), cA, voffA); PG8_STAGE(PG8_SB(0, 1), cB + hstepB, voffB); PG8_STAGE(PG8_SA(0, 1), cA + hstepA, voffA);
        if (wr == 1) PG8_BAR;
        PG8_WAIT_V(4); PG8_BAR;
        PG8_STAGE(PG8_SB(1, 0), cB + kstep, voffB); PG8_STAGE(PG8_SA(1, 0), cA + kstep, voffA); PG8_STAGE(PG8_SB(1, 1), cB + hstepB + kstep, voffB);
        PG8_WAIT_V(6); PG8_BAR;
    }
    for (;;) {
        const bool has_next = S.next(ui + 1, nxt);
        const char* nA = has_next ? (const char*)g.A + (size_t)nxt.aoff * 2 : cA; const char* nB = has_next ? (const char*)g.Bt + (size_t)nxt.boff * 2 : cB;
        for (int t = 0; t < nt; t += 2) {
            const bool last = (t == nt - 2);
            const char* a1 = cA + (size_t)(t + 1) * kstep;
            const char* a2 = last ? nA : cA + (size_t)(t + 2) * kstep; const char* b2 = last ? nB : cB + (size_t)(t + 2) * kstep;
            const char* a3 = a2 + kstep; const char* b3 = b2 + kstep;
            if (last && has_next) S.a_ready(nxt);
            if constexpr (SP2) {
            PG8_LDB(B0, 0, 0); PG8_LDB(B1, 0, 1); PG8_SCHED; PG8_LDA(At, 0, 0); PG8_STAGE(PG8_SA(1, 1), a1 + hstepA, voffA);
            PG8_WAIT_V(8); PG8_WAIT_L(0); PG8_BAR; PG8_MMA(0, 0, At, B0); PG8_MMA(0, 1, At, B1); PG8_BAR; PG8_SCHED;
            PG8_LDA(At, 0, 1); PG8_STAGE(PG8_SB(0, 0), b2, voffB); PG8_STAGE(PG8_SB(0, 1), b2 + hstepB, voffB); PG8_STAGE(PG8_SA(0, 0), a2, voffA);
            PG8_WAIT_V(8); PG8_WAIT_L(0); PG8_BAR; PG8_MMA(1, 0, At, B0); PG8_MMA(1, 1, At, B1); PG8_BAR; PG8_SCHED;
            PG8_LDB(B0, 1, 0); PG8_LDB(B1, 1, 1); PG8_SCHED; PG8_LDA(At, 1, 0); PG8_STAGE(PG8_SA(0, 1), a2 + hstepA, voffA);
            PG8_WAIT_V(8); PG8_WAIT_L(0); PG8_BAR; PG8_MMA(0, 0, At, B0); PG8_MMA(0, 1, At, B1); PG8_BAR; PG8_SCHED;
            PG8_LDA(At, 1, 1); PG8_STAGE(PG8_SB(1, 0), b3, voffB); PG8_STAGE(PG8_SB(1, 1), b3 + hstepB, voffB); PG8_STAGE(PG8_SA(1, 0), a3, voffA);
            PG8_WAIT_V(8); PG8_WAIT_L(0); PG8_BAR; PG8_MMA(1, 0, At, B0); PG8_MMA(1, 1, At, B1); PG8_BAR; PG8_SCHED;
            } else {
            PG8_LDB(B0, 0, 0); PG8_SCHED; PG8_LDA(At, 0, 0); PG8_STAGE(PG8_SA(1, 1), a1 + hstepA, voffA);
            PG8_WAIT_L(8); PG8_BAR; PG8_WAIT_L(0); PG8_MMA(0, 0, At, B0); PG8_BAR; PG8_SCHED;
            PG8_LDB(B1, 0, 1); PG8_STAGE(PG8_SB(0, 0), b2, voffB);
            PG8_BAR; PG8_WAIT_L(0); PG8_MMA(0, 1, At, B1); PG8_BAR;
            PG8_LDA(At, 0, 1); PG8_STAGE(PG8_SA(0, 0), a2, voffA);
            PG8_BAR; PG8_WAIT_L(0); PG8_MMA(1, 0, At, B0); PG8_BAR; PG8_SCHED;
            PG8_STAGE(PG8_SB(0, 1), b2 + hstepB, voffB);
            PG8_WAIT_V(6); PG8_BAR; PG8_MMA(1, 1, At, B1); PG8_BAR;
            PG8_LDB(B0, 1, 0); PG8_SCHED; PG8_LDA(At, 1, 0); PG8_STAGE(PG8_SA(0, 1), a2 + hstepA, voffA);
            PG8_WAIT_L(8); PG8_BAR; PG8_WAIT_L(0); PG8_MMA(0, 0, At, B0); PG8_BAR; PG8_SCHED;
            PG8_LDB(B1, 1, 1); PG8_STAGE(PG8_SB(1, 0), b3, voffB);
            PG8_BAR; PG8_WAIT_L(0); PG8_MMA(0, 1, At, B1); PG8_BAR;
            PG8_LDA(At, 1, 1); PG8_STAGE(PG8_SA(1, 0), a3, voffA);
            PG8_BAR; PG8_WAIT_L(0); PG8_MMA(1, 0, At, B0); PG8_BAR; PG8_SCHED;
            PG8_STAGE(PG8_SB(1, 1), b3 + hstepB, voffB);
            PG8_WAIT_V(6); PG8_BAR; PG8_MMA(1, 1, At, B1); PG8_BAR;
            }
        }
        if constexpr (ALIGN_EPI) { if (wr == 0) PG8_BAR; }
        if constexpr (!Epi::AFTER_DRAIN) { E(acc, cur, wr, wc, fr, fq); S.done(cur); }
        if (!has_next) break;
        if (!(Epi::MIDK && cur.z == 0)) {
#pragma unroll
        for (int a = 0; a < 2; ++a)
#pragma unroll
            for (int b = 0; b < 2; ++b)
#pragma unroll
                for (int m = 0; m < 4; ++m)
#pragma unroll
                    for (int n = 0; n < 2; ++n) acc[a][b][m][n] = (f32x4){0.f, 0.f, 0.f, 0.f};
        }
        cur = nxt; cA = nA; cB = nB; ++ui;
        if constexpr (ALIGN_EPI) { if (wr == 1) PG8_BAR; }
    }
    PG8_WAIT_V(0);
    if constexpr (!ALIGN_EPI) { if (wr == 0) PG8_BAR; }
    PG8_BAR;
    if constexpr (Epi::AFTER_DRAIN) { E.fused(acc, cur, wr, wc, fr, fq, lds, wid, lane); S.done(cur); }
#undef PG8_SA
#undef PG8_SB
#undef PG8_STAGE
#undef PG8_LDA
#undef PG8_LDB
#undef PG8_MMA
#undef PG8_WAIT_V
#undef PG8_WAIT_L
#undef PG8_BAR
#undef PG8_SCHED
}
}
constexpr size_t MiB = (size_t)1 << 20;
constexpr size_t WO_IN = 0;
constexpr size_t WO_UQ = WO_IN + (size_t)NIN * DM;
constexpr size_t WO_UKV = WO_UQ + (size_t)1536 * 512;
constexpr size_t WO_BR = WO_UKV + (size_t)2048 * 256;
constexpr size_t WO_MIX = WO_BR + (size_t)DM * DM;
constexpr size_t WO_WK = WO_MIX + (size_t)DM * DM;
constexpr size_t WO_VW = WO_WK + (size_t)BATCH * 1024 * DM;
constexpr size_t WO_UP = WO_VW + (size_t)BATCH * DM * 1024;
constexpr size_t WO_DOWN = WO_UP + (size_t)NUP * DM;
constexpr size_t W_LAYER = WO_DOWN + (size_t)DM * DFF;
static_assert(W_LAYER * 2 == 297 * MiB / 2, "layer blob size");

constexpr size_t WS_CTL = 0, CTL_ZERO_BYTES = 1 * MiB;
constexpr size_t WS_CS = 1 * MiB;
constexpr size_t WS_SSQ_CQ = 5 * MiB;
constexpr size_t WS_SSQ_CKV = WS_SSQ_CQ + (size_t)MTOK * 8 * 4;
constexpr size_t WS_W = 38 * MiB;
constexpr size_t WS_H = WS_W + 4 * W_LAYER * 2;
constexpr size_t WS_RA = WS_H + 64 * MiB;
constexpr size_t WS_RB = WS_RA + 352 * MiB;
constexpr size_t WS_RC = WS_RB + 176 * MiB;
constexpr size_t WS_END = WS_RC + 128 * MiB;
static_assert(WS_H == 632 * MiB, "ws map");
constexpr size_t RA_QD = WS_RA, RA_KD = WS_RA + 32 * MiB, RA_VD = WS_RA + 64 * MiB, RA_CQ = WS_RA + 96 * MiB, RA_CKV = WS_RA + 112 * MiB, RA_KPE = WS_RA + 120 * MiB,
                 RA_GATES = WS_RA + 128 * MiB, RA_MERGED = WS_RA + 256 * MiB;
constexpr size_t RA_QX = WS_RA, RA_S = WS_RA + 64 * MiB, RA_P = WS_RA + 128 * MiB, RA_OX = WS_RA + 160 * MiB;
constexpr size_t RA_U = WS_RA;
constexpr size_t RA_QXP = WS_RA, RA_KVXT = WS_RA + 32 * MiB, RA_OXT = WS_RA + 96 * MiB, RA_MEMN = WS_RA + 128 * MiB, RA_KMEM = WS_RA + 144 * MiB, RA_VMEM = WS_RA + 160 * MiB;
constexpr size_t RB_QM = WS_RB, RB_KN = WS_RB + 48 * MiB, RB_VM = WS_RB + 80 * MiB, RB_OCAT = WS_RB + 112 * MiB;
constexpr size_t RB_ACT = WS_RB;
constexpr size_t RC_Y = WS_RC;

constexpr int CW_BAR = 4096;

namespace pg8 {
__device__ __forceinline__ void rope8(f32x4& v0, f32x4& v1, const f32x2* csp) {
    const f32x4 c01 = *(const f32x4*)csp, c23 = *(const f32x4*)(csp + 2);
    const f32x4 a = v0, b = v1;
    v0[0] = a[0] * c01[0] - a[1] * c01[1]; v0[1] = a[1] * c01[0] + a[0] * c01[1];
    v0[2] = a[2] * c01[2] - a[3] * c01[3]; v0[3] = a[3] * c01[2] + a[2] * c01[3];
    v1[0] = b[0] * c23[0] - b[1] * c23[1]; v1[1] = b[1] * c23[0] + b[0] * c23[1];
    v1[2] = b[2] * c23[2] - b[3] * c23[3]; v1[3] = b[3] * c23[2] + b[2] * c23[3];
}
__device__ __forceinline__ float sigm(float v) { return __builtin_amdgcn_rcpf(1.0f + __builtin_amdgcn_exp2f(-v * LOG2E)); }
__device__ __forceinline__ float sq8(u32x4 w) { const float a = bflo(w.x), b = bfhi(w.x), c = bflo(w.y), d = bfhi(w.y), e = bflo(w.z), f = bfhi(w.z), g = bflo(w.w), h = bfhi(w.w);
    return ((a * a + b * b) + (c * c + d * d)) + ((e * e + f * f) + (g * g + h * h)); }

struct EpiProj {
    static constexpr bool PERM = true, AFTER_DRAIN = false, MIDK = false;
    bf16_t *Qd, *Kd, *Vd, *cq, *ckv, *kpe, *gates; float *ssq_cq, *ssq_ckv; const float* bgate; const f32x2* cs;
    __device__ __forceinline__ void operator()(const Acc& acc, const Unit& u, int wr, int wc, int fr, int fq) const {
        const int pn = u.pn, row0 = u.pm * BM + wr * 64 + fr, cb = wc * 32 + 8 * fq;
        if (pn >= 16) {
            const int colt = (pn - 16) * 256 + cb;
            f32x4 bv[2][2];
#pragma unroll
            for (int bj = 0; bj < 2; ++bj)
#pragma unroll
                for (int n = 0; n < 2; ++n) bv[bj][n] = *(const f32x4*)(bgate + colt + bj * HALF + 4 * n);
#pragma unroll
            for (int ai = 0; ai < 2; ++ai)
#pragma unroll
                for (int m = 0; m < 4; ++m) { bf16_t* rowp = gates + (size_t)(row0 + ai * HALF + m * 16) * 4096 + colt;
#pragma unroll
                    for (int bj = 0; bj < 2; ++bj) { f32x4 v0 = acc[ai][bj][m][0] + bv[bj][0], v1 = acc[ai][bj][m][1] + bv[bj][1];
#pragma unroll
                        for (int e = 0; e < 4; ++e) { v0[e] = sigm(v0[e]); v1[e] = sigm(v1[e]); }
                        *(u32x4*)(rowp + bj * HALF) = pack8(v0, v1); } }
        } else if (pn >= 8 && pn < 15) {
            bf16_t* base; int ld, colt; float* ssq = nullptr; int ssld = 0, sslot = 0;
            if (pn < 12) { base = Vd; ld = 1024; colt = (pn - 8) * 256; }
            else if (pn < 14) { base = cq; ld = 512; colt = (pn - 12) * 256; ssq = ssq_cq; ssld = 8; sslot = (pn - 12) * 4 + wc; }
            else { base = ckv; ld = 256; colt = 0; ssq = ssq_ckv; ssld = 4; sslot = wc; }
            colt += cb;
#pragma unroll
            for (int ai = 0; ai < 2; ++ai)
#pragma unroll
                for (int m = 0; m < 4; ++m) { const int row = row0 + ai * HALF + m * 16; bf16_t* rowp = base + (size_t)row * ld + colt; float ss = 0.f;
#pragma unroll
                    for (int bj = 0; bj < 2; ++bj) { const u32x4 w = pack8(acc[ai][bj][m][0], acc[ai][bj][m][1]); *(u32x4*)(rowp + bj * HALF) = w; ss += sq8(w); }
                    if (ssq) { ss += xor_lt32<16>(ss); ss = sum_xor32(ss); if (fq == 0) ssq[(size_t)row * ssld + sslot] = ss; } }
        } else {
            bf16_t* base; int ld, colt;
            if (pn < 4) { base = Qd; ld = 1024; colt = pn * 256; } else if (pn < 8) { base = Kd; ld = 1024; colt = (pn - 4) * 256; } else { base = kpe; ld = 64; colt = 0; }
            colt += cb;
#pragma unroll
            for (int ai = 0; ai < 2; ++ai)
#pragma unroll
                for (int m = 0; m < 4; ++m) { const int row = row0 + ai * HALF + m * 16; bf16_t* rowp = base + (size_t)row * ld + colt; const f32x2* csr = cs + (size_t)row * 32;
#pragma unroll
                    for (int bj = 0; bj < 2; ++bj) { const int col = colt + bj * HALF;
                        if (pn == 15 && col >= 64) continue;
                        f32x4 v0 = acc[ai][bj][m][0], v1 = acc[ai][bj][m][1]; rope8(v0, v1, csr + ((col & 63) >> 1));
                        *(u32x4*)(rowp + bj * HALF) = pack8(v0, v1); } }
        }
    }
};
struct EpiQm {
    static constexpr bool PERM = true, AFTER_DRAIN = false, MIDK = false;
    bf16_t* Qm; const float* ssq; const f32x2* cs;
    __device__ __forceinline__ void operator()(const Acc& acc, const Unit& u, int wr, int wc, int fr, int fq) const {
        const int row0 = u.pm * BM + wr * 64 + fr, colt = u.pn * BM + wc * 32 + 8 * fq;
#pragma unroll
        for (int ai = 0; ai < 2; ++ai)
#pragma unroll
            for (int m = 0; m < 4; ++m) { const int row = row0 + ai * HALF + m * 16;
                const f32x4 s0 = *(const f32x4*)(ssq + (size_t)row * 8), s1 = *(const f32x4*)(ssq + (size_t)row * 8 + 4);
                const float rs = __builtin_amdgcn_rsqf((((s0[0] + s0[1]) + (s0[2] + s0[3])) + ((s1[0] + s1[1]) + (s1[2] + s1[3]))) * (1.0f / 512.0f) + EPS);
                bf16_t* rowp = Qm + (size_t)row * 1536 + colt; const f32x2* csr = cs + (size_t)row * 32;
#pragma unroll
                for (int bj = 0; bj < 2; ++bj) { const int col = colt + bj * HALF, r = col % 192;
                    f32x4 v0 = acc[ai][bj][m][0] * rs, v1 = acc[ai][bj][m][1] * rs;
                    if (r >= 128) rope8(v0, v1, csr + ((r - 128) >> 1));
                    *(u32x4*)(rowp + bj * HALF) = pack8(v0, v1); } }
    }
};
struct EpiKv {
    static constexpr bool PERM = true, AFTER_DRAIN = false, MIDK = false;
    bf16_t *Kn, *Vm; const float* ssq;
    __device__ __forceinline__ void operator()(const Acc& acc, const Unit& u, int wr, int wc, int fr, int fq) const {
        const int row0 = u.pm * BM + wr * 64 + fr; int colt = u.pn * BM; bf16_t* base = Kn; if (colt >= 1024) { base = Vm; colt -= 1024; } colt += wc * 32 + 8 * fq;
#pragma unroll
        for (int ai = 0; ai < 2; ++ai)
#pragma unroll
            for (int m = 0; m < 4; ++m) { const int row = row0 + ai * HALF + m * 16; const f32x4 s = *(const f32x4*)(ssq + (size_t)row * 4);
                const float rs = __builtin_amdgcn_rsqf(((s[0] + s[1]) + (s[2] + s[3])) * (1.0f / 256.0f) + EPS); bf16_t* rowp = base + (size_t)row * 1024 + colt;
#pragma unroll
                for (int bj = 0; bj < 2; ++bj) *(u32x4*)(rowp + bj * HALF) = pack8(acc[ai][bj][m][0] * rs, acc[ai][bj][m][1] * rs); }
    }
};
template <int MODE> struct EpiGate {
    static constexpr bool PERM = true, AFTER_DRAIN = false, MIDK = false;
    const bf16_t* gates; float* t; bf16_t* merged;
    __device__ __forceinline__ void operator()(const Acc& acc, const Unit& u, int wr, int wc, int fr, int fq) const {
        const int row0 = u.pm * BM + wr * 64 + fr, colt = u.pn * BM + wc * 32 + 8 * fq;
#pragma unroll
        for (int ai = 0; ai < 2; ++ai)
#pragma unroll
            for (int m = 0; m < 4; ++m) { const size_t row = (size_t)(row0 + ai * HALF + m * 16);
#pragma unroll
                for (int bj = 0; bj < 2; ++bj) { const int col = colt + bj * HALF;
                    const u32x4 gw = *(const u32x4*)(gates + row * 4096 + MODE * 2048 + col);
                    const f32x4 g0 = (f32x4){bflo(gw.x), bfhi(gw.x), bflo(gw.y), bfhi(gw.y)}, g1 = (f32x4){bflo(gw.z), bfhi(gw.z), bflo(gw.w), bfhi(gw.w)};
                    float* tp = t + row * 2048 + col;
                    if (MODE == 0) { const f32x4 s0 = acc[ai][bj][m][0] * g0, s1 = acc[ai][bj][m][1] * g1; unsigned long long* tq = (unsigned long long*)tp;
                        __hip_atomic_store(tq, ((unsigned long long)__float_as_uint(s0[1]) << 32) | __float_as_uint(s0[0]), __ATOMIC_RELAXED, __HIP_MEMORY_SCOPE_AGENT);
                        __hip_atomic_store(tq + 1, ((unsigned long long)__float_as_uint(s0[3]) << 32) | __float_as_uint(s0[2]), __ATOMIC_RELAXED, __HIP_MEMORY_SCOPE_AGENT);
                        __hip_atomic_store(tq + 2, ((unsigned long long)__float_as_uint(s1[1]) << 32) | __float_as_uint(s1[0]), __ATOMIC_RELAXED, __HIP_MEMORY_SCOPE_AGENT);
                        __hip_atomic_store(tq + 3, ((unsigned long long)__float_as_uint(s1[3]) << 32) | __float_as_uint(s1[2]), __ATOMIC_RELAXED, __HIP_MEMORY_SCOPE_AGENT); }
                    else { f32x4 t0, t1;
                        { const unsigned long long* tq = (const unsigned long long*)tp;
                          const unsigned long long w0 = __hip_atomic_load(tq, __ATOMIC_RELAXED, __HIP_MEMORY_SCOPE_AGENT), w1 = __hip_atomic_load(tq + 1, __ATOMIC_RELAXED, __HIP_MEMORY_SCOPE_AGENT),
                                                   w2 = __hip_atomic_load(tq + 2, __ATOMIC_RELAXED, __HIP_MEMORY_SCOPE_AGENT), w3 = __hip_atomic_load(tq + 3, __ATOMIC_RELAXED, __HIP_MEMORY_SCOPE_AGENT);
                          t0 = (f32x4){__uint_as_float((unsigned)w0), __uint_as_float((unsigned)(w0 >> 32)), __uint_as_float((unsigned)w1), __uint_as_float((unsigned)(w1 >> 32))};
                          t1 = (f32x4){__uint_as_float((unsigned)w2), __uint_as_float((unsigned)(w2 >> 32)), __uint_as_float((unsigned)w3), __uint_as_float((unsigned)(w3 >> 32))}; }
                        const f32x4 a0 = t0 + acc[ai][bj][m][0] * g0, a1 = t1 + acc[ai][bj][m][1] * g1;
                        *(u32x4*)(merged + row * 2048 + col) = pack8(a0, a1); } } }
    }
};
template <int CTRL> __device__ __forceinline__ float dppk(float old, float src) { return __builtin_bit_cast(float, __builtin_amdgcn_update_dpp(__builtin_bit_cast(int, old), __builtin_bit_cast(int, src), CTRL, 0xf, 0xf, false)); }
struct EpiConvGlu {
    static constexpr bool PERM = true, AFTER_DRAIN = false, MIDK = false;
    bf16_t* act; float* U4; const float* cw; const float* cb; LAS unsigned char* xl;
    __device__ __forceinline__ void operator()(const Acc& acc, const Unit& u, int wr, int wc, int fr, int fq) const {
        const int wid = wr * 4 + wc, cu = u.pn * BM + wc * 32 + 8 * fq;
        if (fr >= 14) {
#pragma unroll
            for (int ai = 0; ai < 2; ++ai)
#pragma unroll
                for (int bj = 0; bj < 2; ++bj)
#pragma unroll
                    for (int n = 0; n < 2; ++n) *(LAS f32x4*)(xl + ((((wid * 2 + ai) * 2 + (fr - 14)) * 64 + bj * 32 + fq * 8 + n * 4) * 4)) = acc[ai][bj][3][n];
        }
        if (wr == 0 && fr < 2) {
#pragma unroll
            for (int bj = 0; bj < 2; ++bj)
#pragma unroll
                for (int n = 0; n < 2; ++n) *(f32x4*)(U4 + ((size_t)(u.pm * 4 + fr) * NUP + cu + bj * HALF + n * 4)) = acc[0][bj][0][n];
        }
        if (wr == 1 && fr >= 14) {
#pragma unroll
            for (int bj = 0; bj < 2; ++bj)
#pragma unroll
                for (int n = 0; n < 2; ++n) *(f32x4*)(U4 + ((size_t)(u.pm * 4 + 2 + (fr - 14)) * NUP + cu + bj * HALF + n * 4)) = acc[1][bj][3][n];
        }
        asm volatile("s_waitcnt lgkmcnt(0)" ::: "memory"); __builtin_amdgcn_s_barrier(); asm volatile("" ::: "memory");
#pragma unroll
        for (int bj = 0; bj < 2; ++bj) {
            const int gidx = (cu + bj * HALF) >> 3;
            f32x4 wa[3], wg[3];
#pragma unroll
            for (int j = 0; j < 3; ++j) { wa[j] = *(const f32x4*)(cw + (size_t)j * NUP + 4 * gidx); wg[j] = *(const f32x4*)(cw + (size_t)j * NUP + DFF + 4 * gidx); }
            const f32x4 ba = *(const f32x4*)(cb + 4 * gidx), bg = *(const f32x4*)(cb + DFF + 4 * gidx);
#pragma unroll
            for (int ai = 0; ai < 2; ++ai) {
                f32x4 pa = (f32x4){0.f, 0.f, 0.f, 0.f}, pg = pa;
                if (wr == 1 || ai == 1) { const int pw = wr == 1 ? wid - 4 : wid + 4, pai = wr == 1 ? ai : 0;
                    const LAS unsigned char* hp = xl + ((((pw * 2 + pai) * 2 + (fr & 1)) * 64 + bj * 32 + fq * 8) * 4);
                    pa = *(const LAS f32x4*)hp; pg = *(const LAS f32x4*)(hp + 16); }
                bf16_t* ap = act + (size_t)(u.pm * BM + ai * HALF + wr * 64 + fr) * DFF + 4 * gidx;
#pragma unroll
                for (int m = 0; m < 4; ++m) {
                    const f32x4 a0 = acc[ai][bj][m][0], g0 = acc[ai][bj][m][1]; f32x4 a1, a2, g1, g2;
#pragma unroll
                    for (int e = 0; e < 4; ++e) {
                        const float ma = dppk<0x140>(0.f, pa[e]), mg = dppk<0x140>(0.f, pg[e]);
                        a1[e] = dppk<0x111>(ma, a0[e]); g1[e] = dppk<0x111>(mg, g0[e]);
                        a2[e] = dppk<0x112>(dppk<0xB1>(0.f, ma), a0[e]); g2[e] = dppk<0x112>(dppk<0xB1>(0.f, mg), g0[e]);
                    }
                    const f32x4 ca = a2 * wa[0] + a1 * wa[1] + a0 * wa[2] + ba, cg = g2 * wg[0] + g1 * wg[1] + g0 * wg[2] + bg; f32x4 o;
#pragma unroll
                    for (int e = 0; e < 4; ++e) o[e] = ca[e] * __builtin_amdgcn_rcpf(1.0f + __builtin_amdgcn_exp2f(-ca[e] * LOG2E)) * cg[e];
                    u32x2 w; w.x = cvt_pk_bf16(o[0], o[1]); w.y = cvt_pk_bf16(o[2], o[3]);
                    *(u32x2*)(ap + (size_t)(m * 16) * DFF) = w;
                    pa = a0; pg = g0;
                }
            }
        }
    }
};
struct EpiSoftmax {
    static constexpr bool PERM = true, AFTER_DRAIN = true, MIDK = false;
    bf16_t* P;
    __device__ __forceinline__ void fused(Acc& acc, const Unit& u, int wr, int wc, int fr, int fq, LAS unsigned char* lds, int wid, int lane) const {
        const float C = 0.044194173824159216f * LOG2E;
        LAS f32x2* T = (LAS f32x2*)lds;
#pragma unroll
        for (int ai = 0; ai < 2; ++ai)
#pragma unroll
            for (int m = 0; m < 4; ++m) {
                float mx = -3.0e38f;
#pragma unroll
                for (int bj = 0; bj < 2; ++bj)
#pragma unroll
                    for (int n = 0; n < 2; ++n) { const f32x4 x = acc[ai][bj][m][n]; mx = fmaxf(mx, fmaxf(fmaxf(x[0], x[1]), fmaxf(x[2], x[3]))); }
                mx = fmaxf(mx, xor_lt32<16>(mx)); mx = max_xor32(mx);
                float s = 0.f;
#pragma unroll
                for (int bj = 0; bj < 2; ++bj)
#pragma unroll
                    for (int n = 0; n < 2; ++n) { const f32x4 x = acc[ai][bj][m][n];
#pragma unroll
                        for (int e = 0; e < 4; ++e) s += __builtin_amdgcn_exp2f((x[e] - mx) * C); }
                s += xor_lt32<16>(s); s = sum_xor32(s);
                if (fq == 0) T[(ai * HALF + wr * 64 + m * 16 + fr) * 4 + wc] = (f32x2){mx, s};
            }
        asm volatile("s_waitcnt lgkmcnt(0)" ::: "memory"); __builtin_amdgcn_s_barrier(); asm volatile("" ::: "memory");
        const int row0 = u.pm * BM + wr * 64 + fr, col0 = u.pn * BM + wc * 32 + 8 * fq;
#pragma unroll
        for (int ai = 0; ai < 2; ++ai)
#pragma unroll
            for (int m = 0; m < 4; ++m) { const int rl = ai * HALF + wr * 64 + m * 16 + fr;
                const f32x2 t0 = T[rl * 4 + 0], t1 = T[rl * 4 + 1], t2 = T[rl * 4 + 2], t3 = T[rl * 4 + 3];
                const float M = fmaxf(fmaxf(t0.x, t1.x), fmaxf(t2.x, t3.x));
                const float S = (t0.y * __builtin_amdgcn_exp2f((t0.x - M) * C) + t1.y * __builtin_amdgcn_exp2f((t1.x - M) * C)) + (t2.y * __builtin_amdgcn_exp2f((t2.x - M) * C) + t3.y * __builtin_amdgcn_exp2f((t3.x - M) * C));
                const float inv = __builtin_amdgcn_rcpf(S), MC = -M * C;
                bf16_t* rowp = P + (size_t)(row0 + ai * HALF + m * 16) * 1024 + col0;
#pragma unroll
                for (int bj = 0; bj < 2; ++bj) { f32x4 v0 = acc[ai][bj][m][0], v1 = acc[ai][bj][m][1];
#pragma unroll
                    for (int e = 0; e < 4; ++e) { v0[e] = __builtin_amdgcn_exp2f(fmaf(v0[e], C, MC)) * inv; v1[e] = __builtin_amdgcn_exp2f(fmaf(v1[e], C, MC)) * inv; }
                    *(u32x4*)(rowp + bj * HALF) = pack8(v0, v1); } }
        (void)wid; (void)lane;
    }
};
struct EpiGate2 {
    static constexpr bool PERM = true, AFTER_DRAIN = false, MIDK = true;
    const bf16_t* gates; bf16_t* merged;
    __device__ __forceinline__ void operator()(Acc& acc, const Unit& u, int wr, int wc, int fr, int fq) const {
        if (u.z == 0) {
        const int row0 = u.pm * BM + wr * 64 + fr, colt = u.pn * BM + wc * 32 + 8 * fq;
#pragma unroll
        for (int ai = 0; ai < 2; ++ai)
#pragma unroll
            for (int m = 0; m < 4; ++m) { const bf16_t* gp = gates + (size_t)(row0 + ai * HALF + m * 16) * 4096 + colt;
#pragma unroll
                for (int bj = 0; bj < 2; ++bj) { const u32x4 ga = *(const u32x4*)(gp + bj * HALF), gb = *(const u32x4*)(gp + 2048 + bj * HALF);
                    const f32x4 a0 = (f32x4){bflo(ga.x), bfhi(ga.x), bflo(ga.y), bfhi(ga.y)}, a1 = (f32x4){bflo(ga.z), bfhi(ga.z), bflo(ga.w), bfhi(ga.w)};
                    const f32x4 b0 = (f32x4){bflo(gb.x), bfhi(gb.x), bflo(gb.y), bfhi(gb.y)}, b1 = (f32x4){bflo(gb.z), bfhi(gb.z), bflo(gb.w), bfhi(gb.w)};
#pragma unroll
                    for (int e = 0; e < 4; ++e) { acc[ai][bj][m][0][e] *= a0[e] * __builtin_amdgcn_rcpf(fmaxf(b0[e], 1e-30f)); acc[ai][bj][m][1][e] *= a1[e] * __builtin_amdgcn_rcpf(fmaxf(b1[e], 1e-30f)); }
                    asm volatile("" : "+v"(acc[ai][bj][m][0]), "+v"(acc[ai][bj][m][1]) :: "memory"); } }
                return; }
        const int row0 = u.pm * BM + wr * 64 + fr, colt = u.pn * BM + wc * 32 + 8 * fq;
#pragma unroll
        for (int ai = 0; ai < 2; ++ai)
#pragma unroll
            for (int m = 0; m < 4; ++m) { const size_t row = (size_t)(row0 + ai * HALF + m * 16);
#pragma unroll
                for (int bj = 0; bj < 2; ++bj) { const int col = colt + bj * HALF; const u32x4 gb = *(const u32x4*)(gates + row * 4096 + 2048 + col);
                    f32x4 b0 = (f32x4){bflo(gb.x), bfhi(gb.x), bflo(gb.y), bfhi(gb.y)}, b1 = (f32x4){bflo(gb.z), bfhi(gb.z), bflo(gb.w), bfhi(gb.w)};
#pragma unroll
                    for (int e = 0; e < 4; ++e) { b0[e] = fmaxf(b0[e], 1e-30f); b1[e] = fmaxf(b1[e], 1e-30f); }
                    *(u32x4*)(merged + row * 2048 + col) = pack8(acc[ai][bj][m][0] * b0, acc[ai][bj][m][1] * b1); } }
    }
};
struct EpiF32 {
    static constexpr bool PERM = false, AFTER_DRAIN = false, MIDK = false;
    float* C; int ldc;
    __device__ __forceinline__ void operator()(const Acc& acc, const Unit& u, int wr, int wc, int fr, int fq) const {
        const int row0 = u.pm * BM + wr * 64 + fr, col0 = u.pn * BM + wc * 32 + 4 * fq;
#pragma unroll
        for (int ai = 0; ai < 2; ++ai)
#pragma unroll
            for (int m = 0; m < 4; ++m) { float* rowp = C + (size_t)(row0 + ai * HALF + m * 16) * ldc + col0;
#pragma unroll
                for (int bj = 0; bj < 2; ++bj)
#pragma unroll
                    for (int n = 0; n < 2; ++n) *(f32x4*)(rowp + bj * HALF + n * 16) = acc[ai][bj][m][n]; }
    }
};
struct EpiBf16 {
    static constexpr bool PERM = true, AFTER_DRAIN = false, MIDK = false;
    bf16_t* O; int ldc;
    __device__ __forceinline__ void operator()(const Acc& acc, const Unit& u, int wr, int wc, int fr, int fq) const {
        const int row0 = u.pm * BM + wr * 64 + fr, col0 = u.pn * BM + wc * 32 + 8 * fq;
#pragma unroll
        for (int ai = 0; ai < 2; ++ai)
#pragma unroll
            for (int m = 0; m < 4; ++m) { bf16_t* rowp = O + (size_t)(row0 + ai * HALF + m * 16) * ldc + col0;
#pragma unroll
                for (int bj = 0; bj < 2; ++bj) *(u32x4*)(rowp + bj * HALF) = pack8(acc[ai][bj][m][0], acc[ai][bj][m][1]); }
    }
};
struct EpiMemKv {
    static constexpr bool PERM = true, AFTER_DRAIN = false, MIDK = false;
    bf16_t* Kmem;
    __device__ __forceinline__ void operator()(const Acc& acc, const Unit& u, int wr, int wc, int fr, int fq) const {
        bf16_t* O = Kmem + (size_t)(u.z & 1) * ((RA_VMEM - RA_KMEM) / 2) + (size_t)(u.z >> 1) * (1024 * 2048);
        const int row0 = u.pm * BM + wr * 64 + fr, col0 = u.pn * BM + wc * 32 + 8 * fq;
#pragma unroll
        for (int ai = 0; ai < 2; ++ai)
#pragma unroll
            for (int m = 0; m < 4; ++m) { bf16_t* rowp = O + (size_t)(row0 + ai * HALF + m * 16) * 2048 + col0;
#pragma unroll
                for (int bj = 0; bj < 2; ++bj) *(u32x4*)(rowp + bj * HALF) = pack8(acc[ai][bj][m][0], acc[ai][bj][m][1]); }
    }
};
struct EpiFold {
    static constexpr bool PERM = true, AFTER_DRAIN = false, MIDK = false;
    bf16_t* Wall;
    __device__ __forceinline__ void operator()(const Acc& acc, const Unit& u, int wr, int wc, int fr, int fq) const {
        const int ty = u.z & 1, ldc = ty ? 1024 : 2048;
        bf16_t* O = Wall + (size_t)(u.z >> 1) * W_LAYER + WO_WK + (size_t)ty * ((WO_VW - WO_WK) + (size_t)(u.pn >> 2) * (2048 * 1024));
        const int row0 = u.pm * BM + wr * 64 + fr, col0 = (ty ? (u.pn & 3) : u.pn) * BM + wc * 32 + 8 * fq;
#pragma unroll
        for (int ai = 0; ai < 2; ++ai)
#pragma unroll
            for (int m = 0; m < 4; ++m) { bf16_t* rowp = O + (size_t)(row0 + ai * HALF + m * 16) * ldc + col0;
#pragma unroll
                for (int bj = 0; bj < 2; ++bj) *(u32x4*)(rowp + bj * HALF) = pack8(acc[ai][bj][m][0], acc[ai][bj][m][1]); }
    }
};

struct GateOrder {
    StaticOrder S;
    __device__ __forceinline__ bool next(int i, Unit& u) const { if (!S.next(i >> 1, u)) return false; u.z = i & 1; u.aoff += (unsigned)(i & 1) * 1024u; u.boff += (unsigned)(i & 1) * 1024u; return true; }
    __device__ __forceinline__ void a_ready(const Unit&) const {}
    __device__ __forceinline__ void done(const Unit&) const {}
};
struct MemKvOrder {
    int G, c;
    __device__ __forceinline__ bool next(int i, Unit& u) const {
        const int L = i * G + c; if (L >= 256) return false;
        const int ly = L >> 6, r = L & 63, ty = r >> 5, q = r & 31;
        u.pm = q >> 3; u.pn = q & 7; u.z = ly * 2 + ty;
        u.aoff = (unsigned)(RA_MEMN / 2) + (unsigned)ly * (1024u * 2048u) + (unsigned)u.pm * (256u * 2048u);
        u.boff = (unsigned)(RA_KVXT / 2) + (unsigned)ly * (4096u * 2048u) + (unsigned)(ty * 2048 + u.pn * 256) * 2048u; return true;
    }
    __device__ __forceinline__ void a_ready(const Unit&) const {}
    __device__ __forceinline__ void done(const Unit&) const {}
};
struct FoldOrder {
    int G, c;
    __device__ __forceinline__ bool next(int i, Unit& u) const {
        const int L = i * G + c; if (L >= 1024) return false;
        const int ly = L >> 8, r = L & 255, ty = r >> 7, q = r & 127; u.z = ly * 2 + ty;
        if (ty == 0) { u.pm = q >> 3; u.pn = q & 7; const unsigned b = (unsigned)u.pm >> 2, h = (unsigned)u.pm & 3u;
            u.aoff = (unsigned)(RA_KMEM / 2) + (unsigned)ly * (1024u * 2048u) + b * (256u * 2048u) + h * 512u;
            u.boff = (unsigned)(RA_QXP / 2) + (unsigned)ly * (2048u * 2048u) + (unsigned)u.pn * (256u * 2048u) + h * 512u; }
        else { u.pm = q >> 4; u.pn = q & 15; const unsigned b = (unsigned)u.pn >> 2, h = (unsigned)u.pn & 3u;
            u.aoff = (unsigned)(RA_OXT / 2) + (unsigned)ly * (2048u * 2048u) + (unsigned)u.pm * (256u * 2048u) + h * 512u;
            u.boff = (unsigned)(RA_VMEM / 2) + (unsigned)ly * (1024u * 2048u) + b * (256u * 2048u) + h * 512u; }
        return true;
    }
    __device__ __forceinline__ void a_ready(const Unit&) const {}
    __device__ __forceinline__ void done(const Unit&) const {}
};
struct CrossSOrder {
    int G, c;
    __device__ __forceinline__ bool next(int i, Unit& u) const {
        const int L = i * G + c; if (L >= 256) return false;
        u.pm = L >> 2; u.pn = L & 3; u.z = 0; const unsigned b = (unsigned)u.pm >> 4;
        u.aoff = (unsigned)u.pm * (256u * 2048u); u.boff = (b * 1024u + (unsigned)u.pn * 256u) * 2048u; return true;
    }
    __device__ __forceinline__ void a_ready(const Unit&) const {}
    __device__ __forceinline__ void done(const Unit&) const {}
};
struct CrossYOrder {
    int G, c;
    __device__ __forceinline__ bool next(int i, Unit& u) const {
        const int L = i * G + c; if (L >= 512) return false;
        u.pm = L >> 3; u.pn = L & 7; u.z = 0; const unsigned b = (unsigned)u.pm >> 4;
        u.aoff = (unsigned)u.pm * (256u * 1024u); u.boff = (b * 2048u + (unsigned)u.pn * 256u) * 1024u; return true;
    }
    __device__ __forceinline__ void a_ready(const Unit&) const {}
    __device__ __forceinline__ void done(const Unit&) const {}
};
}
namespace att {
constexpr int NW = 8, QBLK = 32, KVBLK = 64;
constexpr float THR = 8.f;
constexpr int SHM_V = KVBLK * 128 * 2;
constexpr int OFF_V = 0, OFF_K = 2 * SHM_V, OFF_QL = 81920  , OFF_WS = 122880;
#define SBAR() __builtin_amdgcn_sched_barrier(0)
__device__ __forceinline__ int crow(int r, int hi) { return (r & 3) + 8 * (r >> 2) + 4 * hi; }

__device__ __forceinline__ void partialSM(f32x16& p0, f32x16& p1, float& m_reg, float& alpha, const float C, const bool valid) {
    if (!valid) {
#pragma unroll
        for (int r = 0; r < 16; ++r) { p0[r] = 0.f; p1[r] = 0.f; }
        alpha = 1.f; return; }
    float pmax = p0[0];
#pragma unroll
    for (int r = 1; r < 16; ++r) pmax = fmaxf(pmax, p0[r]);
#pragma unroll
    for (int r = 0; r < 16; ++r) pmax = fmaxf(pmax, p1[r]);
    { auto rr = __builtin_amdgcn_permlane32_swap(__float_as_uint(pmax), __float_as_uint(pmax), false, false);
      pmax = fmaxf(__uint_as_float(rr[0]), __uint_as_float(rr[1])); }
    float mn;
    if (__builtin_expect(__all((pmax - m_reg) * C <= THR * LOG2E), 1)) { mn = m_reg; alpha = 1.f; }
    else { mn = fmaxf(m_reg, pmax); alpha = __builtin_amdgcn_exp2f((m_reg - mn) * C); m_reg = mn; }
    const float mnC = -mn * C;
#pragma unroll
    for (int r = 0; r < 16; ++r) p0[r] = fmaf(p0[r], C, mnC);
#pragma unroll
    for (int r = 0; r < 16; ++r) p1[r] = fmaf(p1[r], C, mnC);
#pragma unroll
    for (int r = 0; r < 16; ++r) p0[r] = __builtin_amdgcn_exp2f(p0[r]);
}
__device__ __forceinline__ void finishSM(f32x16& p0, f32x16& p1, float alpha, float& l_reg, bf16x8& pa0, bf16x8& pa1, bf16x8& pa2, bf16x8& pa3, const bool valid) {
    if (valid) {
#pragma unroll
        for (int r = 0; r < 16; ++r) p1[r] = __builtin_amdgcn_exp2f(p1[r]);
    }
    float ps = 0;
#pragma unroll
    for (int r = 0; r < 16; ++r) ps += p0[r];
#pragma unroll
    for (int r = 0; r < 16; ++r) ps += p1[r];
    { auto rr = __builtin_amdgcn_permlane32_swap(__float_as_uint(ps), __float_as_uint(ps), false, false);
      ps = __uint_as_float(rr[0]) + __uint_as_float(rr[1]); }
    l_reg = l_reg * alpha + ps;
#define PK4(P, BASE, OUT) do { unsigned a0 = cvt_pk_bf16(P[BASE + 0], P[BASE + 1]), a1 = cvt_pk_bf16(P[BASE + 2], P[BASE + 3]);   \
    unsigned b0 = cvt_pk_bf16(P[BASE + 4], P[BASE + 5]), b1 = cvt_pk_bf16(P[BASE + 6], P[BASE + 7]);                              \
    auto r0 = __builtin_amdgcn_permlane32_swap(a0, b0, false, false); auto r1 = __builtin_amdgcn_permlane32_swap(a1, b1, false, false); \
    u32x4 w = {r0[0], r1[0], r0[1], r1[1]}; OUT = __builtin_bit_cast(bf16x8, w); } while (0)
    PK4(p0, 0, pa0); PK4(p0, 8, pa1); PK4(p1, 0, pa2); PK4(p1, 8, pa3);
#undef PK4
}
template <int NQ, int NL>
__device__ __forceinline__ void qkt(f32x16& p0, f32x16& p1, const LAS unsigned char* Ks, const bf16x8* qr, const LAS unsigned char* ql, int r32, int hi) {
    constexpr int STRIDE = NQ * 32;
    const int sw = (r32 >> 1) & 7;
    const LAS unsigned char* k0p = Ks + r32 * STRIDE; const LAS unsigned char* k1p = k0p + 32 * STRIDE;
#pragma unroll
    for (int r = 0; r < 16; ++r) { p0[r] = 0.f; p1[r] = 0.f; }
#pragma unroll
    for (int d0 = 0; d0 < NQ; ++d0) { const int off = ((2 * d0 + hi) ^ sw) << 4;
        const bf16x8 b0 = *(const LAS bf16x8*)(k0p + off), b1 = *(const LAS bf16x8*)(k1p + off);
        bf16x8 qf; if (d0 < NQ - NL) qf = qr[d0]; else qf = *(const LAS bf16x8*)(ql + (d0 - (NQ - NL)) * 1024);
        p0 = __builtin_amdgcn_mfma_f32_32x32x16_bf16(b0, qf, p0, 0, 0, 0);
        p1 = __builtin_amdgcn_mfma_f32_32x32x16_bf16(b1, qf, p1, 0, 0, 0); }
}
__device__ __forceinline__ int v_st(int k, int c) { const int kk = (k & ~0xC) | ((k & 4) << 1) | ((k & 8) >> 1); return ((kk >> 3) * 4 + (c >> 5)) * 512 + ((kk & 7) * 32 + (c & 31)) * 2; }
__device__ __forceinline__ int v_rd_base(int lane) { return ((lane & 3) << 3) | (((lane >> 2) & 3) << 6) | (((lane >> 4) & 1) << 5) | (((lane >> 5) & 1) << 8); }
constexpr int v_rd_off(int d0, int ks, int half) { return d0 * 512 + ks * 4096 + half * 2048; }
template <int OFF> __device__ __forceinline__ s16x4 tr_read(int vb) {
    s16x4 r; asm volatile("ds_read_b64_tr_b16 %0, %1 offset:%2" : "=&v"(r) : "v"(vb), "i"(OFF) : "memory"); return r;
}
template <int D0> __device__ __forceinline__ void pv_one(f32x16& od, int vb, bf16x8 pa0, bf16x8 pa1, bf16x8 pa2, bf16x8 pa3) {
    const s16x4 l0 = tr_read<v_rd_off(D0, 0, 0)>(vb), h0 = tr_read<v_rd_off(D0, 0, 1)>(vb), l1 = tr_read<v_rd_off(D0, 1, 0)>(vb), h1 = tr_read<v_rd_off(D0, 1, 1)>(vb);
    const s16x4 l2 = tr_read<v_rd_off(D0, 2, 0)>(vb), h2 = tr_read<v_rd_off(D0, 2, 1)>(vb), l3 = tr_read<v_rd_off(D0, 3, 0)>(vb), h3 = tr_read<v_rd_off(D0, 3, 1)>(vb);
    asm volatile("s_waitcnt lgkmcnt(0)" ::: "memory"); SBAR();
#define PK(L, H) (bf16x8){L[0], L[1], L[2], L[3], H[0], H[1], H[2], H[3]}
    od = __builtin_amdgcn_mfma_f32_32x32x16_bf16(pa0, PK(l0, h0), od, 0, 0, 0);
    od = __builtin_amdgcn_mfma_f32_32x32x16_bf16(pa1, PK(l1, h1), od, 0, 0, 0);
    od = __builtin_amdgcn_mfma_f32_32x32x16_bf16(pa2, PK(l2, h2), od, 0, 0, 0);
    od = __builtin_amdgcn_mfma_f32_32x32x16_bf16(pa3, PK(l3, h3), od, 0, 0, 0);
#undef PK
}
__device__ __forceinline__ void pv_d0(f32x16* o, int vb, bf16x8 pa0, bf16x8 pa1, bf16x8 pa2, bf16x8 pa3) {
    pv_one<0>(o[0], vb, pa0, pa1, pa2, pa3); pv_one<1>(o[1], vb, pa0, pa1, pa2, pa3); pv_one<2>(o[2], vb, pa0, pa1, pa2, pa3); pv_one<3>(o[3], vb, pa0, pa1, pa2, pa3);
}

template <int NQ, bool MLA>
__device__ __forceinline__ void attn_pass(const bf16_t* __restrict__ Qb, const int ldq, const bf16_t* __restrict__ Kh, const bf16_t* __restrict__ Kpe, const bf16_t* __restrict__ Vh,
                                          const int NT, const float C, LAS unsigned char* lds, f32x16 (&o)[4]) {
    constexpr int STRIDE = NQ * 32, SHM_K = KVBLK * STRIDE;
    int tid = threadIdx.x; asm volatile("" : "+v"(tid));
    const int wid = __builtin_amdgcn_readfirstlane(tid >> 6), lane = tid & 63, r32 = lane & 31, hi = lane >> 5;
    LAS unsigned char* V_lds = lds + OFF_V; LAS unsigned char* K_lds = lds + OFF_K;
    LAS float* wsf = (LAS float*)(lds + OFF_WS) + wid * 64; LAS float* li_l = wsf; LAS float* al_l = wsf + 32;
    constexpr int NL = MLA ? 4 : 0;
    LAS unsigned char* ql = lds + OFF_QL + wid * 4096 + lane * 16;
    float m_reg = -1e30f, l_reg = 0.f; bf16x8 qr[NQ - NL];
#pragma unroll
    for (int d = 0; d < 4; ++d)
#pragma unroll
        for (int r = 0; r < 16; ++r) o[d][r] = 0.f;
    { const bf16_t* Qw = Qb + (size_t)(wid * QBLK + r32) * ldq + hi * 8;
#pragma unroll
      for (int d0 = 0; d0 < NQ - NL; ++d0) qr[d0] = *(const bf16x8*)(Qw + d0 * 16);
#pragma unroll
      for (int d0 = NQ - NL; d0 < NQ; ++d0) *(LAS bf16x8*)(ql + (d0 - (NQ - NL)) * 1024) = *(const bf16x8*)(Qw + d0 * 16); }
    const int sr = tid >> 4, sc = (tid & 15) * 8, vst0 = v_st(sr, sc), vst1 = v_st(32 + sr, sc);
    const int kr = tid >> 3, kc = tid & 7;
    int kst0, kst1, kst2;
    if (MLA) { kst0 = sr * STRIDE + (((tid & 15) ^ ((sr >> 1) & 7)) << 4); kst1 = kst0 + 32 * STRIDE; kst2 = kr * STRIDE + (((16 + kc) ^ ((kr >> 1) & 7)) << 4); }
    else { kst0 = kr * STRIDE + ((kc ^ ((kr >> 1) & 7)) << 4); kst1 = 0; kst2 = 0; }
    const int vb0 = (int)(unsigned)(uintptr_t)V_lds + v_rd_base(lane);
    const int jw = NT - 4 + (wid >> 1);
    bf16x8 vs0, vs1, ks0, ks1, ks2;
#define SLOAD(k0) do { vs0 = *(const bf16x8*)(Vh + (size_t)((k0) + sr) * 1024 + sc); vs1 = *(const bf16x8*)(Vh + (size_t)((k0) + 32 + sr) * 1024 + sc); \
    if (MLA) { ks0 = *(const bf16x8*)(Kh + (size_t)((k0) + sr) * 1024 + sc); ks1 = *(const bf16x8*)(Kh + (size_t)((k0) + 32 + sr) * 1024 + sc); ks2 = *(const bf16x8*)(Kpe + (size_t)((k0) + kr) * 64 + kc * 8); } \
    else { ks0 = *(const bf16x8*)(Kh + (size_t)((k0) + kr) * 1024 + kc * 8); } } while (0)
#define SWRITE(b) do { *(LAS bf16x8*)(V_lds + (b) * SHM_V + vst0) = vs0; *(LAS bf16x8*)(V_lds + (b) * SHM_V + vst1) = vs1; \
    *(LAS bf16x8*)(K_lds + (b) * SHM_K + kst0) = ks0; if (MLA) { *(LAS bf16x8*)(K_lds + (b) * SHM_K + kst1) = ks1; *(LAS bf16x8*)(K_lds + (b) * SHM_K + kst2) = ks2; } } while (0)
#define RESC(a) do { if (__any((a) < 1.f)) { if (hi == 0) al_l[r32] = (a); asm volatile("s_waitcnt lgkmcnt(0)" ::: "memory"); \
    _Pragma("unroll") for (int d = 0; d < 4; ++d) _Pragma("unroll") for (int r = 0; r < 16; ++r) o[d][r] *= al_l[crow(r, hi)]; } } while (0)
    f32x16 p0, p1; float al; bf16x8 pa0, pa1, pa2, pa3;
    SLOAD(0); SWRITE(0); __syncthreads();
    SLOAD(KVBLK);
    for (int j = 0; j < NT; ++j) {
        const int bsel = j & 1;
        if (j <= jw) {
            SBAR(); qkt<NQ, NL>(p0, p1, K_lds + bsel * SHM_K, qr, ql, r32, hi);
            partialSM(p0, p1, m_reg, al, C, true);
            RESC(al);
            finishSM(p0, p1, al, l_reg, pa0, pa1, pa2, pa3, true); SBAR();
            pv_d0(o, vb0 + bsel * SHM_V, pa0, pa1, pa2, pa3);
        }
        if (j + 1 < NT) {
#ifdef DIAG_XBAR
            __syncthreads();
#endif
            SWRITE(bsel ^ 1); __syncthreads();
            if (j + 2 < NT) SLOAD((j + 2) * KVBLK);
        }
    }
    __syncthreads();
    if (hi == 0) li_l[r32] = l_reg; asm volatile("s_waitcnt lgkmcnt(0)" ::: "memory");
#pragma unroll
    for (int r = 0; r < 16; ++r) { const float rl = __builtin_amdgcn_rcpf(li_l[crow(r, hi)]);
#pragma unroll
        for (int d = 0; d < 4; ++d) o[d][r] *= rl; }
    asm volatile("s_waitcnt lgkmcnt(0)" ::: "memory");
#undef SLOAD
#undef SWRITE
#undef RESC
}

__device__ __forceinline__ void glds16(const void* gsrc, unsigned lds_dst) { unsigned keep;
    asm volatile("s_mov_b32 %0, m0\n\ts_mov_b32 m0, %2\n\ts_nop 0\n\tglobal_load_lds_dwordx4 %1, off\n\ts_mov_b32 m0, %0" : "=&s"(keep) : "v"(gsrc), "s"(lds_dst) : "memory"); }
__host__ __device__ __forceinline__ int vq_k(int q) { const int sub = q >> 5, kk = (sub >> 2) * 8 + ((q & 31) >> 2); return (kk & ~0xC) | ((kk & 4) << 1) | ((kk & 8) >> 1); }
__host__ __device__ __forceinline__ int vq_c(int q) { return ((q >> 5) & 3) * 32 + (q & 3) * 8; }
constexpr int P2_V = 0, P2_K = 32768, P2_KP = 65536;
#define WAITBAR() asm volatile("s_waitcnt vmcnt(0) lgkmcnt(0)\n\ts_barrier" ::: "memory")

template <bool MLA>
__device__ __forceinline__ void qkt2(f32x16& p0, f32x16& p1, const LAS unsigned char* Kb, const LAS unsigned char* Kpb, const bf16x8* qr, const LAS unsigned char* ql, int r32, int hi) {
#pragma unroll
    for (int r = 0; r < 16; ++r) { p0[r] = 0.f; p1[r] = 0.f; }
    if (MLA) {
        const LAS unsigned char* k0p = Kb + r32 * 256; const LAS unsigned char* k1p = k0p + 32 * 256; const int sw = r32 & 15;
#pragma unroll
        for (int d0 = 0; d0 < 8; ++d0) { const int off = ((2 * d0 + hi) ^ sw) << 4;
            const bf16x8 b0 = *(const LAS bf16x8*)(k0p + off), b1 = *(const LAS bf16x8*)(k1p + off);
            p0 = __builtin_amdgcn_mfma_f32_32x32x16_bf16(b0, qr[d0], p0, 0, 0, 0); p1 = __builtin_amdgcn_mfma_f32_32x32x16_bf16(b1, qr[d0], p1, 0, 0, 0); }
        const LAS unsigned char* e0p = Kpb + r32 * 128; const LAS unsigned char* e1p = e0p + 32 * 128; const int sw2 = (r32 >> 1) & 7;
#pragma unroll
        for (int d0 = 0; d0 < 4; ++d0) { const int off = ((2 * d0 + hi) ^ sw2) << 4;
            const bf16x8 b0 = *(const LAS bf16x8*)(e0p + off), b1 = *(const LAS bf16x8*)(e1p + off), qf = *(const LAS bf16x8*)(ql + d0 * 1024);
            p0 = __builtin_amdgcn_mfma_f32_32x32x16_bf16(b0, qf, p0, 0, 0, 0); p1 = __builtin_amdgcn_mfma_f32_32x32x16_bf16(b1, qf, p1, 0, 0, 0); }
    } else {
        const LAS unsigned char* k0p = Kb + r32 * 128; const LAS unsigned char* k1p = k0p + 32 * 128; const int sw = (r32 >> 1) & 7;
#pragma unroll
        for (int d0 = 0; d0 < 4; ++d0) { const int off = ((2 * d0 + hi) ^ sw) << 4;
            const bf16x8 b0 = *(const LAS bf16x8*)(k0p + off), b1 = *(const LAS bf16x8*)(k1p + off);
            p0 = __builtin_amdgcn_mfma_f32_32x32x16_bf16(b0, qr[d0], p0, 0, 0, 0); p1 = __builtin_amdgcn_mfma_f32_32x32x16_bf16(b1, qr[d0], p1, 0, 0, 0); }
    }
}
template <bool MLA>
__device__ __forceinline__ void attn_pass2(const bf16_t* __restrict__ Qb, const int ldq, const bf16_t* __restrict__ Kh, const bf16_t* __restrict__ Kpe, const bf16_t* __restrict__ Vh,
                                           const int NT, const float C, LAS unsigned char* lds, f32x16 (&o)[4]) {
    constexpr int NQR = MLA ? 8 : 4, SHM_K2 = MLA ? 16384 : 8192;
    int tid = threadIdx.x; asm volatile("" : "+v"(tid));
    const int wid = __builtin_amdgcn_readfirstlane(tid >> 6), lane = tid & 63, r32 = lane & 31, hi = lane >> 5;
    LAS unsigned char* V_lds = lds + P2_V; LAS unsigned char* K_lds = lds + P2_K; LAS unsigned char* Kp_lds = lds + P2_KP;
    LAS float* wsf = (LAS float*)(lds + OFF_WS) + wid * 64; LAS float* li_l = wsf; LAS float* al_l = wsf + 32;
    LAS unsigned char* ql = lds + OFF_QL + wid * 4096 + lane * 16;
    const unsigned ldsb = (unsigned)(uintptr_t)lds;
    const unsigned dV = ldsb + P2_V + wid * 1024, dK = ldsb + P2_K + wid * 1024, dP = ldsb + P2_KP + wid * 1024;
#define LANEOFFS() int t2_ = tid; asm volatile("" : "+v"(t2_)); const int q0_ = t2_ & 511; \
    const unsigned voV0 = (unsigned)(vq_k(q0_) * 1024 + vq_c(q0_)) * 2u; \
    const unsigned voK0 = MLA ? (unsigned)((q0_ >> 4) * 1024 + (((q0_ & 15) ^ ((q0_ >> 4) & 15)) * 8)) * 2u : (unsigned)((q0_ >> 3) * 1024 + (((q0_ & 7) ^ ((q0_ >> 4) & 7)) * 8)) * 2u; \
    const unsigned voP = (unsigned)((q0_ >> 3) * 64 + (((q0_ & 7) ^ ((q0_ >> 4) & 7)) * 8)) * 2u; (void)voV0; (void)voK0; (void)voP
#define DMA_K(t, b) do { LANEOFFS(); const char* kb_ = (const char*)Kh + (size_t)(t) * (KVBLK * 1024 * 2); glds16(kb_ + voK0, (unsigned)__builtin_amdgcn_readfirstlane(dK + (b) * SHM_K2)); \
    if (MLA) { glds16(kb_ + voK0 + 65536, (unsigned)__builtin_amdgcn_readfirstlane(dK + (b) * SHM_K2 + 8192)); glds16((const char*)Kpe + (size_t)(t) * (KVBLK * 64 * 2) + voP, (unsigned)__builtin_amdgcn_readfirstlane(dP + (b) * 8192)); } } while (0)
#define DMA_V(t, b) do { LANEOFFS(); const char* vb_ = (const char*)Vh + (size_t)(t) * (KVBLK * 1024 * 2); glds16(vb_ + voV0, (unsigned)__builtin_amdgcn_readfirstlane(dV + (b) * SHM_V)); glds16(vb_ + voV0 + 65536, (unsigned)__builtin_amdgcn_readfirstlane(dV + (b) * SHM_V + 8192)); } while (0)
    DMA_K(0, 0);
    float m_reg = -1e30f, l_reg = 0.f; bf16x8 qr[NQR];
#pragma unroll
    for (int d = 0; d < 4; ++d)
#pragma unroll
        for (int r = 0; r < 16; ++r) o[d][r] = 0.f;
    { const bf16_t* Qw = Qb + (size_t)(wid * QBLK + r32) * ldq + hi * 8;
#pragma unroll
      for (int d0 = 0; d0 < NQR; ++d0) qr[d0] = *(const bf16x8*)(Qw + d0 * 16);
      if (MLA) {
#pragma unroll
          for (int d0 = 0; d0 < 4; ++d0) *(LAS bf16x8*)(ql + d0 * 1024) = *(const bf16x8*)(Qw + (8 + d0) * 16); } }
    const int vb0 = (int)(ldsb + P2_V) + v_rd_base(lane);
    const int jw = NT - 4 + (wid >> 1);
#define RESC2(a) do { if (__any((a) < 1.f)) { if (hi == 0) al_l[r32] = (a); asm volatile("s_waitcnt lgkmcnt(0)" ::: "memory"); \
    _Pragma("unroll") for (int d = 0; d < 4; ++d) _Pragma("unroll") for (int r = 0; r < 16; ++r) o[d][r] *= al_l[crow(r, hi)]; } } while (0)
    f32x16 pA0, pA1, pB0, pB1; float alA = 1.f, alB = 1.f; bf16x8 pa0, pa1, pa2, pa3;
    WAITBAR();
    DMA_K(1, 1); DMA_V(0, 0);
    SBAR(); qkt2<MLA>(pA0, pA1, K_lds, Kp_lds, qr, ql, r32, hi); partialSM(pA0, pA1, m_reg, alA, C, true);
    WAITBAR();
#define STEP2(PX0, PX1, ALX, PY0, PY1, ALY, KOFF, KPOFF, VOFF, VQ, VP) do { \
        SBAR(); if (VQ) qkt2<MLA>(PX0, PX1, K_lds + (KOFF), Kp_lds + (KPOFF), qr, ql, r32, hi); \
        if (VP) { finishSM(PY0, PY1, ALY, l_reg, pa0, pa1, pa2, pa3, true); SBAR(); pv_d0(o, vb0 + (VOFF), pa0, pa1, pa2, pa3); } \
        partialSM(PX0, PX1, m_reg, ALX, C, VQ); RESC2(ALX); WAITBAR(); } while (0)
    int j = 1;
    for (; j + 1 <= NT - 4; j += 2) {
        DMA_K(j + 1, 0); DMA_V(j, 1);
        STEP2(pB0, pB1, alB, pA0, pA1, alA, SHM_K2, 8192, 0, true, true);
        DMA_K(j + 2, 1); DMA_V(j + 1, 0);
        STEP2(pA0, pA1, alA, pB0, pB1, alB, 0, 0, SHM_V, true, true);
    }
    {
        const bool vj = (j <= jw), vn = (j + 1 <= jw);
        DMA_K(j + 1, 0); DMA_V(j, 1);
        STEP2(pB0, pB1, alB, pA0, pA1, alA, SHM_K2, 8192, 0, vj, true);
        DMA_K(j + 2, 1); DMA_V(j + 1, 0);
        STEP2(pA0, pA1, alA, pB0, pB1, alB, 0, 0, SHM_V, vn, vj);
    }
    {
        const bool vp = (NT - 2 <= jw), vj = (NT - 1 <= jw);
        DMA_V(NT - 1, 1);
        SBAR(); if (vj) qkt2<MLA>(pB0, pB1, K_lds + SHM_K2, Kp_lds + 8192, qr, ql, r32, hi);
        if (vp) { finishSM(pA0, pA1, alA, l_reg, pa0, pa1, pa2, pa3, true); SBAR(); pv_d0(o, vb0, pa0, pa1, pa2, pa3); }
        partialSM(pB0, pB1, m_reg, alB, C, vj);
        RESC2(alB);
        WAITBAR();
        if (vj) { finishSM(pB0, pB1, alB, l_reg, pa0, pa1, pa2, pa3, true); SBAR(); pv_d0(o, vb0 + SHM_V, pa0, pa1, pa2, pa3); }
    }
    WAITBAR();
    if (hi == 0) li_l[r32] = l_reg; asm volatile("s_waitcnt lgkmcnt(0)" ::: "memory");
#pragma unroll
    for (int r = 0; r < 16; ++r) { const float rl = __builtin_amdgcn_rcpf(li_l[crow(r, hi)]);
#pragma unroll
        for (int d = 0; d < 4; ++d) o[d][r] *= rl; }
    asm volatile("s_waitcnt lgkmcnt(0)" ::: "memory");
#undef DMA_K
#undef DMA_V
#undef LANEOFFS
#undef RESC2
#undef STEP2
}
#undef WAITBAR
#undef SBAR
}
typedef GAS unsigned gu32;
#define RLX_AGENT __ATOMIC_RELAXED, __HIP_MEMORY_SCOPE_AGENT
#define LDS_WAIT() asm volatile("s_waitcnt lgkmcnt(0)" ::: "memory")
#define VM_WAIT() asm volatile("s_waitcnt vmcnt(0)" ::: "memory")
#define XB_TMO      128
#define XB_XCNT(j)  (256  + 64 * (j))
#define XB_XSUB(j)  (1280 + 64 * (j))
#define XB_XGEN(j)  (2304 + 64 * (j))
#define XB_TOP      3328
#define XB_TOPGEN   3392
#define XCD_BAR_WORDS 3456
#define XB_SPIN_CAP (1u << 18)

__device__ __forceinline__ unsigned xb_ld(unsigned* p)              { return __hip_atomic_load(p, __ATOMIC_RELAXED, __HIP_MEMORY_SCOPE_AGENT); }
__device__ __forceinline__ unsigned xb_add(unsigned* p, unsigned v) { return __hip_atomic_fetch_add(p, v, __ATOMIC_RELAXED, __HIP_MEMORY_SCOPE_AGENT); }
__device__ __forceinline__ unsigned xb_xcc_id() { return (unsigned)__builtin_amdgcn_s_getreg((3 << 11) | 20) & 0xFu; }
#define XB_SPIN(cond, bar) do { unsigned _sp = 0; while (cond) { __builtin_amdgcn_s_sleep(1); \
    if ((++_sp & 255u) == 0u) { if (xb_ld(&(bar)[XB_TMO])) break; if (_sp > XB_SPIN_CAP) { atomicAdd(&(bar)[XB_TMO], 1u); break; } } } } while (0)

struct XcdBarrier {
    unsigned* bar; unsigned x;
    volatile LAS unsigned* st;
};
__device__ __forceinline__ XcdBarrier xcd_barrier_post(unsigned* bar, volatile LAS unsigned* st) {
    XcdBarrier b; b.bar = bar; b.x = xb_xcc_id(); b.st = st;
    if (threadIdx.x == 0) (void)xb_add(&bar[XB_XCNT(b.x)], 1u);
    return b;
}
__device__ __forceinline__ void xcd_barrier_complete(unsigned* bar, unsigned x, unsigned& nloc, unsigned& nx) {
    const unsigned G = gridDim.x * gridDim.y * gridDim.z;
    unsigned sum, cnt, mine, sp = 0u;
    for (;;) {
        sum = 0u; cnt = 0u; mine = 0u;
#pragma unroll
        for (unsigned j = 0; j < 16; ++j) { const unsigned c = xb_ld(&bar[XB_XCNT(j)]); sum += c; cnt += (c > 0u) ? 1u : 0u; mine = (j == x) ? c : mine; }
        if (sum == G) break;
        __builtin_amdgcn_s_sleep(1);
        if ((++sp & 255u) == 0u) { if (xb_ld(&bar[XB_TMO])) break; if (sp > XB_SPIN_CAP) { atomicAdd(&bar[XB_TMO], 1u); break; } }
    }
    nloc = mine > 0u ? mine : 1u; nx = cnt > 0u ? cnt : 1u;
}
__device__ __forceinline__ void xcd_barrier(const XcdBarrier& b) {
    asm volatile("s_waitcnt vmcnt(0)" ::: "memory");
    __syncthreads();
    if (threadIdx.x == 0) {
        unsigned* bar = b.bar;
        __builtin_amdgcn_s_waitcnt(0);
        unsigned nloc = b.st[0], nx = b.st[1];
        if (nloc == 0u) { xcd_barrier_complete(bar, b.x, nloc, nx); b.st[0] = nloc; b.st[1] = nx; }
        const unsigned old = xb_add(&bar[XB_XSUB(b.x)], 1u);
        const unsigned gen = old / nloc;
        if (old + 1u == (gen + 1u) * nloc) {
            __builtin_amdgcn_fence(__ATOMIC_RELEASE, "agent");
            asm volatile("s_waitcnt vmcnt(0)" ::: "memory");
            const unsigned og = xb_add(&bar[XB_TOP], 1u);
            const unsigned tg = og / nx;
            if (og + 1u == (tg + 1u) * nx) xb_add(&bar[XB_TOPGEN], 1u);
            else XB_SPIN(xb_ld(&bar[XB_TOPGEN]) == tg, bar);
            __builtin_amdgcn_fence(__ATOMIC_ACQUIRE, "agent");
            xb_add(&bar[XB_XGEN(b.x)], 1u);
            asm volatile("s_waitcnt vmcnt(0)" ::: "memory");
        } else {
            XB_SPIN(xb_ld(&bar[XB_XGEN(b.x)]) == gen, bar);
            __builtin_amdgcn_fence(__ATOMIC_ACQUIRE, "agent");
            asm volatile("s_waitcnt vmcnt(0)" ::: "memory");
        }
    }
    __syncthreads();
}

__device__ __forceinline__ float dot4(f32x4 a) { return (a[0] * a[0] + a[1] * a[1]) + (a[2] * a[2] + a[3] * a[3]); }
__device__ __forceinline__ u32x2 pack4(f32x4 a) { u32x2 w; w.x = cvt_pk_bf16(a[0], a[1]); w.y = cvt_pk_bf16(a[2], a[3]); return w; }

__device__ __forceinline__ void thin_first_norm(const float* xin, float* xout, const float* g, bf16_t* h, int gw, int NGW, int lane) {
    f32x4 gq[8];
#pragma unroll
    for (int j = 0; j < 8; ++j) gq[j] = ((const f32x4*)g)[lane + 64 * j];
    for (int m = gw; m < MTOK; m += NGW) {
        const f32x4* xr = (const f32x4*)(xin + (size_t)m * DM) + lane; f32x4* xo = (f32x4*)(xout + (size_t)m * DM) + lane; f32x4 v[8]; float s = 0.f;
#pragma unroll
        for (int j = 0; j < 8; ++j) { v[j] = xr[64 * j]; s += dot4(v[j]); }
        const float rstd = __builtin_amdgcn_rsqf(wave_sum(s) * (1.0f / DM) + EPS);
        u32x2* ho = (u32x2*)(h + (size_t)m * DM) + lane;
#pragma unroll
        for (int j = 0; j < 8; ++j) { xo[64 * j] = v[j]; ho[64 * j] = pack4(v[j] * rstd * gq[j]); }
    }
}
__device__ __forceinline__ void thin_res_norm(const bf16_t* y, float* x, const float* g_post, const float* g_pre, bf16_t* h, int gw, int NGW, int lane, float* xout = nullptr) {
    f32x4 gp[8], gq[8];
#pragma unroll
    for (int j = 0; j < 8; ++j) { gp[j] = ((const f32x4*)g_post)[lane + 64 * j]; gq[j] = g_pre ? ((const f32x4*)g_pre)[lane + 64 * j] : (f32x4){0.f, 0.f, 0.f, 0.f}; }
    for (int m = gw; m < MTOK; m += NGW) {
        const u32x2* yr = (const u32x2*)(y + (size_t)m * DM) + lane; f32x4* xr = (f32x4*)(x + (size_t)m * DM) + lane; f32x4 v[8], xv[8]; float s = 0.f;
#pragma unroll
        for (int j = 0; j < 8; ++j) { const u32x2 w = yr[64 * j]; v[j] = (f32x4){bflo(w.x), bfhi(w.x), bflo(w.y), bfhi(w.y)}; xv[j] = xr[64 * j]; }
#pragma unroll
        for (int j = 0; j < 8; ++j) s += dot4(v[j]);
        const float rstd = __builtin_amdgcn_rsqf(wave_sum(s) * (1.0f / DM) + EPS); float s2 = 0.f;
        f32x4* xw = xout ? (f32x4*)(xout + (size_t)m * DM) + lane : xr;
#pragma unroll
        for (int j = 0; j < 8; ++j) { xv[j] = xv[j] + v[j] * rstd * gp[j]; xw[64 * j] = xv[j]; s2 += dot4(xv[j]); }
        if (g_pre) { const float rstd2 = __builtin_amdgcn_rsqf(wave_sum(s2) * (1.0f / DM) + EPS); u32x2* ho = (u32x2*)(h + (size_t)m * DM) + lane;
#pragma unroll
            for (int j = 0; j < 8; ++j) ho[64 * j] = pack4(xv[j] * rstd2 * gq[j]); }
    }
}
__device__ __forceinline__ void thin_mem_norm(const float* mem, const float* g_mem, bf16_t* memn, int gw, int NGW, int lane) {
    for (int r = gw; r < MROWS; r += NGW) {
        const f32x4* xr = (const f32x4*)(mem + (size_t)r * DM) + lane; f32x4 v[8]; float s = 0.f;
#pragma unroll
        for (int j = 0; j < 8; ++j) { v[j] = xr[64 * j]; s += dot4(v[j]); }
        const float rstd = __builtin_amdgcn_rsqf(wave_sum(s) * (1.0f / DM) + EPS);
        for (int l = 0; l < DEPTH; ++l) { const f32x4* g = (const f32x4*)(g_mem + (size_t)l * DM) + lane; u32x2* ho = (u32x2*)(memn + ((size_t)l * MROWS + r) * DM) + lane;
#pragma unroll
            for (int j = 0; j < 8; ++j) ho[64 * j] = pack4(v[j] * rstd * g[64 * j]); }
    }
}
__device__ __forceinline__ void thin_softmax(const float* S, bf16_t* P, int gw, int NGW, int lane) {
    const float C = 0.044194173824159216f * LOG2E;
    for (int m = gw; m < MTOK; m += NGW) {
        const f32x4* sr = (const f32x4*)(S + (size_t)m * 1024) + lane; u32x2* po = (u32x2*)(P + (size_t)m * 1024) + lane; f32x4 v[4];
#pragma unroll
        for (int j = 0; j < 4; ++j) v[j] = sr[64 * j];
#pragma unroll
        for (int j = 0; j < 4; ++j) {
            const float mx = wave_max(fmaxf(fmaxf(v[j][0], v[j][1]), fmaxf(v[j][2], v[j][3])));
            f32x4 e;
#pragma unroll
            for (int k = 0; k < 4; ++k) e[k] = __builtin_amdgcn_exp2f((v[j][k] - mx) * C);
            const float sum = wave_sum((e[0] + e[1]) + (e[2] + e[3]));
            po[64 * j] = pack4(e * __builtin_amdgcn_rcpf(sum));
        }
    }
}
__device__ __forceinline__ void thin_conv_glu(const bf16_t* u, bf16_t* act, const float* cw, const float* cb, int gw, int NGW, int lane) {
    constexpr int NBLK = NUP / 512, NCH = MTOK / 64;
    for (int task = gw; task < NBLK * NCH; task += NGW) {
        const int chunk = task / NBLK, blk = task % NBLK, gidx = blk * 64 + lane, m0 = chunk * 64;
        f32x4 wa[3], wg[3];
#pragma unroll
        for (int j = 0; j < 3; ++j) { wa[j] = *(const f32x4*)(cw + (size_t)j * NUP + 4 * gidx); wg[j] = *(const f32x4*)(cw + (size_t)j * NUP + DFF + 4 * gidx); }
        const f32x4 ba = *(const f32x4*)(cb + 4 * gidx), bg = *(const f32x4*)(cb + DFF + 4 * gidx);
        const bf16_t* up = u + (size_t)m0 * NUP + 8 * gidx; bf16_t* ap = act + (size_t)m0 * DFF + 4 * gidx;
        u32x4 p2 = (u32x4){0u, 0u, 0u, 0u}, p1 = p2;
        if ((m0 & (SEQ - 1)) != 0) { p2 = *(const u32x4*)(up - 2 * (size_t)NUP); p1 = *(const u32x4*)(up - (size_t)NUP); }
        for (int r0 = 0; r0 < 64; r0 += 8) {
            u32x4 cur[8];
#pragma unroll
            for (int i = 0; i < 8; ++i) cur[i] = *(const u32x4*)(up + (size_t)(r0 + i) * NUP);
#pragma unroll
            for (int i = 0; i < 8; ++i) { const u32x4 c = cur[i];
                const f32x4 a2 = (f32x4){bflo(p2.x), bfhi(p2.x), bflo(p2.y), bfhi(p2.y)}, g2 = (f32x4){bflo(p2.z), bfhi(p2.z), bflo(p2.w), bfhi(p2.w)};
                const f32x4 a1 = (f32x4){bflo(p1.x), bfhi(p1.x), bflo(p1.y), bfhi(p1.y)}, g1 = (f32x4){bflo(p1.z), bfhi(p1.z), bflo(p1.w), bfhi(p1.w)};
                const f32x4 a0 = (f32x4){bflo(c.x), bfhi(c.x), bflo(c.y), bfhi(c.y)}, g0 = (f32x4){bflo(c.z), bfhi(c.z), bflo(c.w), bfhi(c.w)};
                const f32x4 ca = a2 * wa[0] + a1 * wa[1] + a0 * wa[2] + ba, cg = g2 * wg[0] + g1 * wg[1] + g0 * wg[2] + bg;
                f32x4 o;
#pragma unroll
                for (int e = 0; e < 4; ++e) o[e] = ca[e] * __builtin_amdgcn_rcpf(1.0f + __builtin_amdgcn_exp2f(-ca[e] * LOG2E)) * cg[e];
                *(u32x2*)(ap + (size_t)(r0 + i) * DFF) = pack4(o);
                p2 = p1; p1 = c; }
        }
    }
}

__device__ __forceinline__ void thin_conv_fix(const float* U4, bf16_t* act, const float* cw, const float* cb, int gw, int NGW, int lane) {
    constexpr int NG = NUP / 8;
    for (int i = gw * 64 + lane; i < 64 * 2 * NG; i += NGW * 64) {
        const int pm = i / (2 * NG), rem = i - pm * (2 * NG), r = rem / NG, gidx = rem - r * NG; const bool first = (pm & 15) == 0;
        const float* t0 = U4 + (size_t)(pm * 4) * NUP + 8 * gidx; const float* tp = U4 + (size_t)((pm - 1) * 4) * NUP + 8 * gidx;
        const f32x4 z = (f32x4){0.f, 0.f, 0.f, 0.f};
        f32x4 a0, g0, a1, g1, a2, g2;
        if (r == 0) { a0 = *(const f32x4*)t0; g0 = *(const f32x4*)(t0 + 4);
            a1 = first ? z : *(const f32x4*)(tp + 3 * (size_t)NUP); g1 = first ? z : *(const f32x4*)(tp + 3 * (size_t)NUP + 4);
            a2 = first ? z : *(const f32x4*)(tp + 2 * (size_t)NUP); g2 = first ? z : *(const f32x4*)(tp + 2 * (size_t)NUP + 4); }
        else { a0 = *(const f32x4*)(t0 + NUP); g0 = *(const f32x4*)(t0 + NUP + 4); a1 = *(const f32x4*)t0; g1 = *(const f32x4*)(t0 + 4);
            a2 = first ? z : *(const f32x4*)(tp + 3 * (size_t)NUP); g2 = first ? z : *(const f32x4*)(tp + 3 * (size_t)NUP + 4); }
        const f32x4 ca = a2 * *(const f32x4*)(cw + 4 * gidx) + a1 * *(const f32x4*)(cw + NUP + 4 * gidx) + a0 * *(const f32x4*)(cw + 2 * (size_t)NUP + 4 * gidx) + *(const f32x4*)(cb + 4 * gidx);
        const f32x4 cg = g2 * *(const f32x4*)(cw + DFF + 4 * gidx) + g1 * *(const f32x4*)(cw + NUP + DFF + 4 * gidx) + g0 * *(const f32x4*)(cw + 2 * (size_t)NUP + DFF + 4 * gidx) + *(const f32x4*)(cb + DFF + 4 * gidx);
        f32x4 o;
#pragma unroll
        for (int e = 0; e < 4; ++e) o[e] = ca[e] * __builtin_amdgcn_rcpf(1.0f + __builtin_amdgcn_exp2f(-ca[e] * LOG2E)) * cg[e];
        *(u32x2*)(act + (size_t)(pm * 256 + r) * DFF + 4 * gidx) = pack4(o);
    }
}

struct MapId { __device__ __forceinline__ int operator()(int n) const { return n; } };
struct MapIn { __device__ __forceinline__ int operator()(int n) const {
    if (n < 2048) { const int i = n & 63; return (n & ~63) + 2 * (i & 31) + (i >> 5); }
    if (n < 3840) return n;
    if (n < 3904) { const int i = n - 3840; return 3840 + 2 * (i & 31) + (i >> 5); }
    return n + 192; } };
struct MapUq { __device__ __forceinline__ int operator()(int n) const { const int hd = n / 192, r = n - hd * 192; if (r < 128) return n; const int i = r - 128; return hd * 192 + 128 + 2 * (i & 31) + (i >> 5); } };
struct MapUkv { __device__ __forceinline__ int operator()(int n) const { const int hd = n >> 8, r = n & 255; return r < 128 ? hd * 128 + r : 1024 + hd * 128 + (r - 128); } };
struct MapUp { __device__ __forceinline__ int operator()(int n) const { if (n < DFF) return 8 * (n >> 2) + (n & 3); const int q = n - DFF; return 8 * (q >> 2) + 4 + (q & 3); } };

template <class Map>
__device__ __forceinline__ void tr_item(const float* W, int N, bf16_t* WT, int ldd, int kofs, const float* gs, LAS float* scr, int item, int lane, Map map) {
    const int nblk = N / 32, kb = item / nblk, nb = item - kb * nblk, k0 = 64 * kb, n0 = 32 * nb;
    const int rr = lane >> 3, c4 = (lane & 7) * 4;
    f32x4 v[8];
#pragma unroll
    for (int i = 0; i < 8; ++i) v[i] = *(const f32x4*)(W + (size_t)(k0 + 8 * i + rr) * N + n0 + c4);
    if (gs) {
#pragma unroll
        for (int i = 0; i < 8; ++i) v[i] = v[i] * gs[k0 + 8 * i + rr]; }
#pragma unroll
    for (int i = 0; i < 8; ++i) { LAS float* d = scr + (8 * i + rr) * 33 + c4; d[0] = v[i][0]; d[1] = v[i][1]; d[2] = v[i][2]; d[3] = v[i][3]; }
    LDS_WAIT(); asm volatile("" ::: "memory");
    const int c = lane & 7;
#pragma unroll
    for (int j = 0; j < 4; ++j) { const int n = (lane >> 3) + 8 * j; const LAS float* s = scr + (8 * c) * 33 + n;
        u32x4 o; o.x = cvt_pk_bf16(s[0 * 33], s[1 * 33]); o.y = cvt_pk_bf16(s[2 * 33], s[3 * 33]); o.z = cvt_pk_bf16(s[4 * 33], s[5 * 33]); o.w = cvt_pk_bf16(s[6 * 33], s[7 * 33]);
        *(u32x4*)(WT + (size_t)map(n0 + n) * ldd + kofs + k0 + 8 * c) = o; }
    LDS_WAIT(); asm volatile("" ::: "memory");
}

#ifdef DIAG_CKS
__device__ __forceinline__ void cks_rows(const unsigned* buf, int row_words, int nrows, unsigned* persist, unsigned* ctlw, int gw, int NGW, int lane) {
    for (int m = gw; m < nrows; m += NGW) {
        const unsigned* r = buf + (size_t)m * row_words; unsigned c = 0u;
        for (int i = lane; i < row_words; i += 64) c = c * 31u + r[i] * (2u * (unsigned)i + 1u);
        c += (unsigned)__builtin_amdgcn_ds_swizzle((int)c, (1 << 10) | 0x1f); c += (unsigned)__builtin_amdgcn_ds_swizzle((int)c, (2 << 10) | 0x1f); c += (unsigned)__builtin_amdgcn_ds_swizzle((int)c, (4 << 10) | 0x1f);
        c += (unsigned)__builtin_amdgcn_ds_swizzle((int)c, (8 << 10) | 0x1f); c += (unsigned)__builtin_amdgcn_ds_swizzle((int)c, (16 << 10) | 0x1f);
        { auto rr = __builtin_amdgcn_permlane32_swap(c, c, false, false); c = rr[0] + rr[1]; }
        if (lane == 0) { unsigned* ps = persist + 2 * (size_t)m; const unsigned o0 = __hip_atomic_load(ps, __ATOMIC_RELAXED, __HIP_MEMORY_SCOPE_AGENT), o1 = __hip_atomic_load(ps + 1, __ATOMIC_RELAXED, __HIP_MEMORY_SCOPE_AGENT);
            if (o1 == (o0 ^ 0x5a5a5a5au) && o0 != c) __hip_atomic_fetch_add(ctlw, 1u, __ATOMIC_RELAXED, __HIP_MEMORY_SCOPE_AGENT);
            __hip_atomic_store(ps, c, __ATOMIC_RELAXED, __HIP_MEMORY_SCOPE_AGENT); __hip_atomic_store(ps + 1, c ^ 0x5a5a5a5au, __ATOMIC_RELAXED, __HIP_MEMORY_SCOPE_AGENT); }
    }
}
#endif
#ifndef MK_SINGLE
#define MK_SINGLE 1
#endif
constexpr int NWAVES = 8;
constexpr int RING_BYTES = 131072, LDSCTL_OFF = RING_BYTES, MISC_OFF = LDSCTL_OFF + 320, LDS_BYTES = 147456;
constexpr int NPL = 16, NPH = 2 + DEPTH * NPL;

struct Args { const void* in[31]; float* out; unsigned char* ws; int ph_lo, ph_hi; float lam_init[4]; float inv_freq[32]; };
static_assert(sizeof(Args) == 31 * 8 + 8 + 8 + 8 + 16 + 128, "Args has no padding");

__global__ void __launch_bounds__(NWAVES * 64, 2) fwd(Args args) {
    extern __shared__ __attribute__((aligned(16))) unsigned char lds_raw[];
    LAS unsigned char* lds = (LAS unsigned char*)lds_raw;
    volatile LAS unsigned* MISC = (volatile LAS unsigned*)(lds + MISC_OFF);
    for (int u = threadIdx.x; u < (LDS_BYTES - LDSCTL_OFF) / 4; u += NWAVES * 64) ((LAS unsigned*)(lds + LDSCTL_OFF))[u] = 0u;
    __syncthreads();
    const int lo = args.ph_lo, hi = args.ph_hi;
    unsigned* barw = (unsigned*)(GAS unsigned*)(((const __attribute__((address_space(4))) unsigned long long*)__builtin_amdgcn_kernarg_segment_ptr())[32] + WS_CTL) + CW_BAR;
    XcdBarrier bar; bar.bar = barw; bar.x = 0; bar.st = MISC + 8;
    if (hi - lo > 1) bar = xcd_barrier_post(barw, MISC + 8);
#ifndef PHMASK
#define PHMASK 0x3ffff
#endif
#ifndef PROBE_PHASE
#define PROBE_PHASE -1
#endif
#define PREP(k) for (int rep_ = 0; rep_ < ((PROBE_PHASE) == (k) ? 2 : 1); ++rep_)
#define EN(j) (((PHMASK) >> (j)) & 1)
#define PH(k) (lo <= (k) && (k) < hi)
#ifdef PROBE_DOUBLE_BAR
#define SEAM(k) do { if (PH(k) && PH((k) + 1)) { xcd_barrier(bar); xcd_barrier(bar); } } while (0)
#else
#define SEAM(k) do { if (PH(k) && PH((k) + 1)) xcd_barrier(bar); } while (0)
#endif

    typedef const __attribute__((address_space(4))) unsigned long long* kptr_t;
#define KARGS() ({ kptr_t _p = (kptr_t)__builtin_amdgcn_kernarg_segment_ptr(); asm volatile("" : "+s"(_p)); _p; })
#define PHASE_BEGIN() kptr_t kp = KARGS(); unsigned char* ws = (unsigned char*)(GAS unsigned char*)kp[32]; int tid = threadIdx.x, G = gridDim.x, bx = blockIdx.x; asm volatile("" : "+v"(tid), "+s"(G), "+s"(bx)); \
    const int vcu = (G % 8 == 0) ? (bx % 8) * (G / 8) + bx / 8 : bx;     \
    const int lane = tid & 63, wave = __builtin_amdgcn_readfirstlane(tid >> 6), gw = vcu * NWAVES + wave, NGW = G * NWAVES; (void)lane; (void)gw; (void)ws; (void)NGW
#define INP(i) ((const float*)(const GAS float*)kp[i])
#define x_in INP(0)
#define mem INP(1)
#define positions ((const int*)(const GAS int*)kp[2])
#define g_pre_mix INP(3)
#define w_in INP(4)
#define b_gate INP(5)
#define lam_q1 INP(6)
#define lam_k1 INP(7)
#define lam_q2 INP(8)
#define lam_k2 INP(9)
#define g_diff_sub INP(10)
#define g_cq INP(11)
#define w_uq INP(12)
#define g_ckv INP(13)
#define w_ukv INP(14)
#define w_br_diff INP(15)
#define w_br_mla INP(16)
#define w_mix_out INP(17)
#define g_post_mix INP(18)
#define g_pre_x INP(19)
#define g_mem INP(20)
#define w_q_x INP(21)
#define w_kv_x INP(22)
#define w_o_x INP(23)
#define g_post_x INP(24)
#define g_pre_ffn INP(25)
#define w_up INP(26)
#define conv_w INP(27)
#define conv_b INP(28)
#define w_down INP(29)
#define g_post_ffn INP(30)
#define X ((float*)(GAS float*)kp[31])
#define LAM_INIT(l) (((const __attribute__((address_space(4))) float*)kp)[68 + (l)])
#define INV_FREQ(i) (((const __attribute__((address_space(4))) float*)kp)[72 + (i)])
#define WSB ((bf16_t*)ws)
#define Wall ((bf16_t*)(ws + WS_W))
#define H ((bf16_t*)(ws + WS_H))
#define cs ((f32x2*)(ws + WS_CS))
#define ssq_cq ((float*)(ws + WS_SSQ_CQ))
#define ssq_ckv ((float*)(ws + WS_SSQ_CKV))
#define Kmem ((bf16_t*)(ws + RA_KMEM))
#define Vmem ((bf16_t*)(ws + RA_VMEM))
#define Qd ((bf16_t*)(ws + RA_QD))
#define Kd ((bf16_t*)(ws + RA_KD))
#define Vd ((bf16_t*)(ws + RA_VD))
#define cq ((bf16_t*)(ws + RA_CQ))
#define ckv ((bf16_t*)(ws + RA_CKV))
#define kpe ((bf16_t*)(ws + RA_KPE))
#define gates ((bf16_t*)(ws + RA_GATES))
#define merged ((bf16_t*)(ws + RA_MERGED))
#define q_x ((bf16_t*)(ws + RA_QX))
#define Pm ((bf16_t*)(ws + RA_P))
#define o_x ((bf16_t*)(ws + RA_OX))
#define Ub ((bf16_t*)(ws + RA_U))
#define Sx ((float*)(ws + RA_S))
#define memn ((bf16_t*)(ws + RA_MEMN))
#define Qm ((bf16_t*)(ws + RB_QM))
#define Kn ((bf16_t*)(ws + RB_KN))
#define Vm ((bf16_t*)(ws + RB_VM))
#define ocat ((bf16_t*)(ws + RB_OCAT))
#define act ((bf16_t*)(ws + RB_ACT))
#define Y ((float*)(ws + RC_Y))
#define YB ((bf16_t*)(ws + RC_Y + 64 * MiB))

#ifdef DIAG_NANFILL
    {
        PHASE_BEGIN();
        u32x4* p = (u32x4*)(ws + WS_CS); const size_t n16 = (WS_END - WS_CS) / 16;
        for (size_t i = (size_t)gw * 64 + lane; i < n16; i += (size_t)NGW * 64) p[i] = (u32x4){0xffffffffu, 0xffffffffu, 0xffffffffu, 0xffffffffu};
        u32x4* q = (u32x4*)X; const size_t m16 = (size_t)MTOK * DM / 4;
        for (size_t i = (size_t)gw * 64 + lane; i < m16; i += (size_t)NGW * 64) q[i] = (u32x4){0xffffffffu, 0xffffffffu, 0xffffffffu, 0xffffffffu};
    }
    xcd_barrier(bar);
#endif
    if (EN(16) && PH(0)) {
        PHASE_BEGIN();
        LAS float* scr = (LAS float*)(lds + wave * 8448);
        constexpr int I_IN = 32 * 250, I_UQ = 8 * 48, I_UKV = 4 * 64, I_BR = 16 * 64, I_SQ = 32 * 64, I_KVX = 32 * 128, I_UP = 32 * 352, I_DN = 88 * 64;
        constexpr int I_LAYER = I_IN + I_UQ + I_UKV + 2 * I_BR + 3 * I_SQ + I_KVX + I_UP + I_DN;
#ifndef PROBE_PR0_REPS
#define PROBE_PR0_REPS 1
#endif
        for (int rep_ = 0; rep_ < PROBE_PR0_REPS; ++rep_)
        for (int it = gw; it < DEPTH * I_LAYER; it += NGW) {
            const int l = it / I_LAYER; int r = it - l * I_LAYER; bf16_t* Wl = Wall + (size_t)l * W_LAYER;
            if (r < I_IN) { tr_item(w_in + (size_t)l * DM * NIN_SRC, NIN_SRC, Wl + WO_IN, DM, 0, nullptr, scr, r, lane, MapIn()); continue; } r -= I_IN;
            if (r < I_UQ) { tr_item(w_uq + (size_t)l * 512 * 1536, 1536, Wl + WO_UQ, 512, 0, g_cq + l * 512, scr, r, lane, MapUq()); continue; } r -= I_UQ;
            if (r < I_UKV) { tr_item(w_ukv + (size_t)l * 256 * 2048, 2048, Wl + WO_UKV, 256, 0, g_ckv + l * 256, scr, r, lane, MapUkv()); continue; } r -= I_UKV;
            if (r < I_BR) { tr_item(w_br_diff + (size_t)l * 1024 * DM, DM, Wl + WO_BR, DM, 0, nullptr, scr, r, lane, MapId()); continue; } r -= I_BR;
            if (r < I_BR) { tr_item(w_br_mla + (size_t)l * 1024 * DM, DM, Wl + WO_BR, DM, 1024, nullptr, scr, r, lane, MapId()); continue; } r -= I_BR;
            if (r < I_SQ) { tr_item(w_mix_out + (size_t)l * DM * DM, DM, Wl + WO_MIX, DM, 0, nullptr, scr, r, lane, MapId()); continue; } r -= I_SQ;
            if (r < I_SQ) { const float* s_ = w_q_x + (size_t)l * DM * DM + (size_t)r * 2048; bf16_t* d_ = (bf16_t*)(ws + RA_QXP) + (size_t)l * DM * DM + (size_t)r * 2048;
#pragma unroll
                for (int i = 0; i < 4; ++i) { const f32x4 a = *(const f32x4*)(s_ + (i * 64 + lane) * 8), b2 = *(const f32x4*)(s_ + (i * 64 + lane) * 8 + 4); *(u32x4*)(d_ + (i * 64 + lane) * 8) = pack8(a, b2); } continue; } r -= I_SQ;
            if (r < I_KVX) { tr_item(w_kv_x + (size_t)l * DM * 2 * DM, 2 * DM, (bf16_t*)(ws + RA_KVXT) + (size_t)l * 2 * DM * DM, DM, 0, nullptr, scr, r, lane, MapId()); continue; } r -= I_KVX;
            if (r < I_SQ) { tr_item(w_o_x + (size_t)l * DM * DM, DM, (bf16_t*)(ws + RA_OXT) + (size_t)l * DM * DM, DM, 0, nullptr, scr, r, lane, MapId()); continue; } r -= I_SQ;
            if (r < I_UP) { tr_item(w_up + (size_t)l * DM * NUP, NUP, Wl + WO_UP, DM, 0, nullptr, scr, r, lane, MapUp()); continue; } r -= I_UP;
            tr_item(w_down + (size_t)l * DFF * DM, DM, Wl + WO_DOWN, DFF, 0, nullptr, scr, r, lane, MapId());
        }
        for (int i = gw * 64 + lane; i < DEPTH * 192 * (DM / 8); i += NGW * 64) { const int l = i / (192 * (DM / 8)), r = i - l * (192 * (DM / 8));
            *(u32x4*)(Wall + (size_t)l * W_LAYER + WO_IN + (size_t)3904 * DM + (size_t)r * 8) = (u32x4){0u, 0u, 0u, 0u}; }
        for (int idx = gw * 64 + lane; idx < MTOK * 32; idx += NGW * 64) {
            const int m = idx >> 5, i = idx & 31;
            const float ang = (float)positions[m] * INV_FREQ(i);
            const double rev = (double)ang * 0.15915494309189535; const float f = (float)(rev - __builtin_rint(rev));
            cs[idx] = (f32x2){__builtin_amdgcn_cosf(f), __builtin_amdgcn_sinf(f)};
        }
        thin_mem_norm(mem, g_mem, memn, gw, NGW, lane);
        thin_first_norm(x_in, X, g_pre_mix, H, gw, NGW, lane);
    }
    SEAM(0);
    if (EN(17) && PH(1)) {
        PHASE_BEGIN();
        { pg8::Gemm g{WSB, WSB, DM, DM, DM}; pg8::MemKvOrder S{G, bx}; pg8::EpiMemKv E{Kmem};
          pg8::gemm_phase<pg8::EpiMemKv, pg8::MemKvOrder, true, true>(lds, g, S, E); }
        xcd_barrier(bar);
        { pg8::Gemm g{WSB, WSB, DM, DM, 512}; pg8::FoldOrder S{G, bx}; pg8::EpiFold E{Wall};
          pg8::gemm_phase<pg8::EpiFold, pg8::FoldOrder, true, true>(lds, g, S, E); }
    }
    SEAM(1);

    for (int l = 0; l < DEPTH; ++l) {
        const int pb = 2 + l * NPL;
        if (pb + NPL <= lo || pb >= hi) continue;
        if (EN(0) && PH(pb + 0)) PREP(0) {
            PHASE_BEGIN(); const bf16_t* Wl = Wall + (size_t)l * W_LAYER; (void)Wl;
            pg8::Gemm g{H, Wl + WO_IN, DM, DM, DM}; pg8::StaticOrder S; S.init(MTOK, NIN, G, bx, DM, DM);
            pg8::EpiProj E{Qd, Kd, Vd, cq, ckv, kpe, gates, ssq_cq, ssq_ckv, b_gate + (size_t)l * 4096, cs};
            pg8::gemm_phase<pg8::EpiProj, pg8::StaticOrder, true, true>(lds, g, S, E);
        }
        SEAM(pb + 0);
        if (EN(1) && PH(pb + 1)) PREP(1) {
            PHASE_BEGIN(); const bf16_t* Wl = Wall + (size_t)l * W_LAYER; (void)Wl;
            { pg8::Gemm g{cq, Wl + WO_UQ, 512, 512, 512}; pg8::StaticOrder S; S.init(MTOK, 1536, G, bx, 512, 512); pg8::EpiQm E{Qm, ssq_cq, cs};
              pg8::gemm_phase<pg8::EpiQm, pg8::StaticOrder, true, true>(lds, g, S, E); }
            { pg8::Gemm g{ckv, Wl + WO_UKV, 256, 256, 256}; pg8::StaticOrder S; S.init(MTOK, 2048, G, bx, 256, 256); pg8::EpiKv E{Kn, Vm, ssq_ckv};
              pg8::gemm_phase<pg8::EpiKv, pg8::StaticOrder, true, true>(lds, g, S, E); }
        }
        SEAM(pb + 1);
#ifdef DIAG_PREFILL
        if (PH(pb + 2)) { { PHASE_BEGIN(); u32x4* p = (u32x4*)ocat; const size_t n16 = (size_t)MTOK * 2048 * 2 / 16;
            for (size_t i = (size_t)gw * 64 + lane; i < n16; i += (size_t)NGW * 64) p[i] = (u32x4){0u, 0u, 0u, 0u}; } xcd_barrier(bar); }
#endif
#ifdef DIAG_CKS
        if (l == 0 && PH(pb + 2)) { PHASE_BEGIN(); unsigned* pz = (unsigned*)(ws + WS_END + 1 * MiB) + (size_t)l * 8 * 2 * MTOK; unsigned* cw = (unsigned*)(ws + WS_CTL);
            cks_rows((const unsigned*)Qd, 512, MTOK, pz + 0 * 2 * MTOK, cw + 68, gw, NGW, lane); cks_rows((const unsigned*)Kd, 512, MTOK, pz + 1 * 2 * MTOK, cw + 68, gw, NGW, lane);
            cks_rows((const unsigned*)Vd, 512, MTOK, pz + 2 * 2 * MTOK, cw + 68, gw, NGW, lane); cks_rows((const unsigned*)Qm, 768, MTOK, pz + 3 * 2 * MTOK, cw + 69, gw, NGW, lane);
            cks_rows((const unsigned*)Kn, 512, MTOK, pz + 4 * 2 * MTOK, cw + 69, gw, NGW, lane); cks_rows((const unsigned*)Vm, 512, MTOK, pz + 5 * 2 * MTOK, cw + 69, gw, NGW, lane);
            cks_rows((const unsigned*)kpe, 32, MTOK, pz + 6 * 2 * MTOK, cw + 69, gw, NGW, lane); cks_rows((const unsigned*)H, 1024, MTOK, pz + 7 * 2 * MTOK, cw + 70, gw, NGW, lane); }
#endif
        if (EN(2) && PH(pb + 2)) {
            PHASE_BEGIN(); const bf16_t* Wl = Wall + (size_t)l * W_LAYER; (void)Wl;
            float lam;
            { const float a = lam_q1[l * 64 + lane] * lam_k1[l * 64 + lane], b2 = lam_q2[l * 64 + lane] * lam_k2[l * 64 + lane];
              lam = __builtin_amdgcn_exp2f(wave_sum(a) * LOG2E) - __builtin_amdgcn_exp2f(wave_sum(b2) * LOG2E) + LAM_INIT(l); }
            const float omli = 1.0f - LAM_INIT(l);
            const float Cd = 0.125f * LOG2E, Cm = 0.07216878364870322f * LOG2E;
            const int r32 = lane & 31, hi = lane >> 5;
#define SCRL() (Y + ((size_t)bx * NWAVES + wave) * 4096 + lane)
            LAS bf16_t* stg = (LAS bf16_t*)(lds + 81920 + wave * 4096);
            LAS bf16_t* stw = stg + hi * 4 * 64 + r32;
            const int srow = lane >> 3, sch = lane & 7;
#define STORE_O(Og) do { _Pragma("unroll") for (int hf = 0; hf < 2; ++hf) { \
                _Pragma("unroll") for (int r = 0; r < 16; ++r) _Pragma("unroll") for (int dd = 0; dd < 2; ++dd) \
                    stw[((r & 3) + 8 * (r >> 2)) * 64 + dd * 32] = (bf16_t)(cvt_pk_bf16(o[hf * 2 + dd][r], 0.f) & 0xffffu); \
                LDS_WAIT(); asm volatile("" ::: "memory"); \
                _Pragma("unroll") for (int i = 0; i < 4; ++i) { const u32x4 v = *(const LAS u32x4*)(stg + (i * 8 + srow) * 64 + sch * 8); \
                    *(u32x4*)((Og) + (size_t)(i * 8 + srow) * 2048 + hf * 64 + sch * 8) = v; } \
                LDS_WAIT(); asm volatile("" ::: "memory"); } } while (0)
#ifdef DIAG_CKS
#define CKS_O(slot, cw) do { unsigned c_ = 0u; _Pragma("unroll") for (int d_ = 0; d_ < 4; ++d_) _Pragma("unroll") for (int r_ = 0; r_ < 16; ++r_) c_ = c_ * 31u + __float_as_uint(o[d_][r_]); \
                c_ += (unsigned)__builtin_amdgcn_ds_swizzle((int)c_, (1 << 10) | 0x1f); c_ += (unsigned)__builtin_amdgcn_ds_swizzle((int)c_, (2 << 10) | 0x1f); c_ += (unsigned)__builtin_amdgcn_ds_swizzle((int)c_, (4 << 10) | 0x1f); \
                c_ += (unsigned)__builtin_amdgcn_ds_swizzle((int)c_, (8 << 10) | 0x1f); c_ += (unsigned)__builtin_amdgcn_ds_swizzle((int)c_, (16 << 10) | 0x1f); \
                { auto rr_ = __builtin_amdgcn_permlane32_swap(c_, c_, false, false); c_ = rr_[0] + rr_[1]; } \
                if (lane == 0) { unsigned* ps_ = (unsigned*)(ws + WS_END) + 2 * (size_t)(slot); const unsigned o0_ = __hip_atomic_load(ps_, __ATOMIC_RELAXED, __HIP_MEMORY_SCOPE_AGENT), o1_ = __hip_atomic_load(ps_ + 1, __ATOMIC_RELAXED, __HIP_MEMORY_SCOPE_AGENT); \
                    if (l == 0 && o1_ == (o0_ ^ 0x5a5a5a5au) && o0_ != c_) __hip_atomic_fetch_add((unsigned*)(ws + WS_CTL) + (cw), 1u, __ATOMIC_RELAXED, __HIP_MEMORY_SCOPE_AGENT); \
                    __hip_atomic_store(ps_, c_, __ATOMIC_RELAXED, __HIP_MEMORY_SCOPE_AGENT); __hip_atomic_store(ps_ + 1, c_ ^ 0x5a5a5a5au, __ATOMIC_RELAXED, __HIP_MEMORY_SCOPE_AGENT); } } while (0)
#else
#define CKS_O(slot, cw) do {} while (0)
#endif
#ifndef ATT_V1_DIFF
#define ATT_DIFF att::attn_pass2<false>
#else
#define ATT_DIFF att::attn_pass<4, false>
#endif
#ifdef ATT_P2_MLA
#define ATT_MLA att::attn_pass2<true>
#else
#define ATT_MLA att::attn_pass<12, true>
#endif
#ifndef PROBE_ATT_REPS
#define PROBE_ATT_REPS 1
#endif
            for (int rep_ = 0; rep_ < PROBE_ATT_REPS; ++rep_)
            for (int pr = vcu; pr < 256; pr += G) {
                const int bh = pr >> 3, s = pr & 7, b = bh >> 3, hd = bh & 7; const size_t kv0 = (size_t)b * SEQ;
#ifndef NO_DIFF
                for (int k = 0; k < 2; ++k) {
                    const int qb = k ? 15 - s : s, NT = 4 * qb + 4; const size_t row0 = kv0 + (size_t)qb * 256;
                    f32x16 o[4];
#ifdef DIAG_SELFCHK
                    for (int rep = 0; rep < 2; ++rep) {
                        att::attn_pass<4, false>(Qd + row0 * 1024 + hd * 128, 1024, Kd + kv0 * 1024 + hd * 128, nullptr, Vd + kv0 * 1024 + hd * 128, NT, Cd, lds, o);
                        if (rep == 0) {
#pragma unroll
                            for (int q = 0; q < 16; ++q) *(f32x4*)(scrl + 4 * q) = (f32x4){o[q >> 2][(q & 3) * 4], o[q >> 2][(q & 3) * 4 + 1], o[q >> 2][(q & 3) * 4 + 2], o[q >> 2][(q & 3) * 4 + 3]};
                        } else { bool bad = false;
#pragma unroll
                            for (int q = 0; q < 32; ++q) { const unsigned long long w = __hip_atomic_load((const unsigned long long*)(scrl + 2 * q), __ATOMIC_RELAXED, __HIP_MEMORY_SCOPE_AGENT);
                                const int d0 = q >> 3, r = (q & 7) * 2; bad |= ((unsigned)w != __float_as_uint(o[d0][r])) | ((unsigned)(w >> 32) != __float_as_uint(o[d0][r + 1])); }
                            if (bad) __hip_atomic_fetch_add((unsigned*)(ws + WS_CTL) + 64, 1u, __ATOMIC_RELAXED, __HIP_MEMORY_SCOPE_AGENT); }
                    }
#endif
                    for (int br = 0; br < 2; ++br) {
                        ATT_DIFF(Qd + row0 * 1024 + hd * 128 + br * 64, 1024, Kd + kv0 * 1024 + hd * 128 + br * 64, nullptr, Vd + kv0 * 1024 + hd * 128, NT, Cd, lds, o);
                        if (br == 0) {
#pragma unroll
                            for (int d0 = 0; d0 < 4; ++d0) { float* pd = SCRL() + d0 * 1024; asm volatile("" : "+v"(pd));
#pragma unroll
                                for (int r = 0; r < 16; ++r) pd[r * 64] = o[d0][r]; }
                        }
                        CKS_O((((size_t)l * 512 + bh * 16 + qb) * 8 + wave) * 4 + br, 65);
                    }
                    float ss[16];
#pragma unroll
                    for (int r = 0; r < 16; ++r) ss[r] = 0.f;
#pragma unroll
                    for (int d0 = 0; d0 < 4; ++d0) { const float* pd = SCRL() + d0 * 1024; asm volatile("" : "+v"(pd));
#pragma unroll
                        for (int r = 0; r < 16; ++r) { const float d = pd[r * 64] - lam * o[d0][r]; o[d0][r] = d; ss[r] += d * d; } }
#pragma unroll
                    for (int r = 0; r < 16; ++r) {
                        ss[r] = __builtin_amdgcn_rsqf(half_sum(ss[r]) * (1.0f / 128.0f) + EPS) * omli; }
#pragma unroll
                    for (int d0 = 0; d0 < 4; ++d0)
#pragma unroll
                        for (int r = 0; r < 16; ++r) o[d0][r] = o[d0][r] * ss[r] * g_diff_sub[l * 128 + d0 * 32 + r32];
                    bf16_t* og = ocat + (row0 + (size_t)wave * 32) * 2048 + hd * 128;
                    CKS_O((((size_t)l * 512 + bh * 16 + qb) * 8 + wave) * 4 + 2, 66);
                    STORE_O(og);
                }
#endif
#ifndef NO_MLA
                for (int k = 0; k < 2; ++k) {
                    const int qb = k ? 15 - s : s, NT = 4 * qb + 4; const size_t row0 = kv0 + (size_t)qb * 256;
                    f32x16 o[4];
                    ATT_MLA(Qm + row0 * 1536 + hd * 192, 1536, Kn + kv0 * 1024 + hd * 128, kpe + kv0 * 64, Vm + kv0 * 1024 + hd * 128, NT, Cm, lds, o);
                    bf16_t* og = ocat + (row0 + (size_t)wave * 32) * 2048 + 1024 + hd * 128;
                    CKS_O((((size_t)l * 512 + bh * 16 + qb) * 8 + wave) * 4 + 3, 67);
                    STORE_O(og);
                }
#endif
            }
#undef STORE_O
#undef SCRL
#undef CKS_O
            __syncthreads();
        }
#ifdef DIAG_NOATT
        if (PH(pb + 2)) { PHASE_BEGIN();
            for (size_t i = (size_t)gw * 64 + lane; i < (size_t)MTOK * 1024; i += (size_t)NGW * 64) { const size_t m = i >> 10, c = i & 1023;
                const float a = bflo((unsigned)Qd[i]) + bflo((unsigned)Kd[i]) + bflo((unsigned)Vd[i]) + bflo((unsigned)kpe[m * 64 + (c & 63)]);
                const float b2 = bflo((unsigned)Kn[i]) + bflo((unsigned)Vm[i]) + bflo((unsigned)Qm[m * 1536 + c]) + bflo((unsigned)Qm[m * 1536 + 512 + c]);
                ocat[m * 2048 + c] = (bf16_t)(cvt_pk_bf16(a * 0.5f, 0.f) & 0xffffu); ocat[m * 2048 + 1024 + c] = (bf16_t)(cvt_pk_bf16(b2 * 0.5f, 0.f) & 0xffffu); } }
#endif
        SEAM(pb + 2);
#ifdef DIAG_CKS
        if (l == 0 && PH(pb + 2)) { PHASE_BEGIN(); cks_rows((const unsigned*)ocat, 1024, MTOK, (unsigned*)(ws + WS_END + 2 * MiB), (unsigned*)(ws + WS_CTL) + 71, gw, NGW, lane); }
#endif
        if (EN(3) && PH(pb + 3)) PREP(3) {
            PHASE_BEGIN(); const bf16_t* Wl = Wall + (size_t)l * W_LAYER; (void)Wl;
            pg8::Gemm g{ocat, Wl + WO_BR, DM, DM, 1024}; pg8::GateOrder S; S.S.init(MTOK, DM, G, bx, DM, DM); pg8::EpiGate2 E{gates, merged};
            pg8::gemm_phase<pg8::EpiGate2, pg8::GateOrder, true, true>(lds, g, S, E);
        }
        SEAM(pb + 3);
        if (EN(4) && PH(pb + 4)) PREP(4) {
            PHASE_BEGIN(); const bf16_t* Wl = Wall + (size_t)l * W_LAYER; (void)Wl;
            pg8::Gemm g{merged, Wl + WO_MIX, DM, DM, DM}; pg8::StaticOrder S; S.init(MTOK, DM, G, bx, DM, DM); pg8::EpiBf16 E{YB, DM};
            pg8::gemm_phase<pg8::EpiBf16, pg8::StaticOrder, true, true>(lds, g, S, E);
        }
        SEAM(pb + 4);
#ifdef DIAG_CKS
        if (l == 0 && PH(pb + 4)) { PHASE_BEGIN(); cks_rows((const unsigned*)Y, 2048, MTOK, (unsigned*)(ws + WS_END + 4 * MiB), (unsigned*)(ws + WS_CTL) + 73, gw, NGW, lane); }
#endif
        if (EN(5) && PH(pb + 5)) { PHASE_BEGIN();
#ifdef PROBE_THIN
            thin_res_norm(YB, X, g_post_mix + (size_t)l * DM, g_pre_x + (size_t)l * DM, H, gw, NGW, lane, (float*)(ws + WS_RB));
#endif
            thin_res_norm(YB, X, g_post_mix + (size_t)l * DM, g_pre_x + (size_t)l * DM, H, gw, NGW, lane); }
        SEAM(pb + 5);
        if (EN(6) && PH(pb + 6)) PREP(6) {
            PHASE_BEGIN(); const bf16_t* Wl = Wall + (size_t)l * W_LAYER; (void)Wl;
            pg8::Gemm g{H, Wl + WO_WK, DM, DM, DM}; pg8::CrossSOrder S{G, bx}; pg8::EpiSoftmax E{Pm};
            pg8::gemm_phase<pg8::EpiSoftmax, pg8::CrossSOrder, false, true>(lds, g, S, E);
        }
        SEAM(pb + 6);
        if (EN(10) && PH(pb + 10)) PREP(10) {
            PHASE_BEGIN(); const bf16_t* Wl = Wall + (size_t)l * W_LAYER; (void)Wl;
            pg8::Gemm g{Pm, Wl + WO_VW, 1024, 1024, 1024}; pg8::CrossYOrder S{G, bx}; pg8::EpiBf16 E{YB, DM};
            pg8::gemm_phase<pg8::EpiBf16, pg8::CrossYOrder, true, true>(lds, g, S, E);
        }
        SEAM(pb + 10);
        if (EN(11) && PH(pb + 11)) { PHASE_BEGIN();
#ifdef PROBE_THIN
            thin_res_norm(YB, X, g_post_x + (size_t)l * DM, g_pre_ffn + (size_t)l * DM, H, gw, NGW, lane, (float*)(ws + WS_RB));
#endif
            thin_res_norm(YB, X, g_post_x + (size_t)l * DM, g_pre_ffn + (size_t)l * DM, H, gw, NGW, lane); }
        SEAM(pb + 11);
        if (EN(12) && PH(pb + 12)) PREP(12) {
            PHASE_BEGIN(); const bf16_t* Wl = Wall + (size_t)l * W_LAYER; (void)Wl;
            pg8::Gemm g{H, Wl + WO_UP, DM, DM, DM}; pg8::StaticOrder S; S.init(MTOK, NUP, G, bx, DM, DM);
            pg8::EpiConvGlu E{act, Y, conv_w + (size_t)l * 3 * NUP, conv_b + (size_t)l * NUP, lds + 132096};
            pg8::gemm_phase<pg8::EpiConvGlu, pg8::StaticOrder, true, true>(lds, g, S, E);
        }
        SEAM(pb + 12);
        if (EN(13) && PH(pb + 13)) PREP(13) { PHASE_BEGIN(); thin_conv_fix(Y, act, conv_w + (size_t)l * 3 * NUP, conv_b + (size_t)l * NUP, gw, NGW, lane); }
        SEAM(pb + 13);
        if (EN(14) && PH(pb + 14)) PREP(14) {
            PHASE_BEGIN(); const bf16_t* Wl = Wall + (size_t)l * W_LAYER; (void)Wl;
            pg8::Gemm g{act, Wl + WO_DOWN, DFF, DFF, DFF}; pg8::StaticOrder S; S.init(MTOK, DM, G, bx, DFF, DFF); pg8::EpiBf16 E{YB, DM};
            pg8::gemm_phase<pg8::EpiBf16, pg8::StaticOrder, true, true>(lds, g, S, E);
        }
        SEAM(pb + 14);
        if (EN(15) && PH(pb + 15)) { PHASE_BEGIN(); thin_res_norm(YB, X, g_post_ffn + (size_t)l * DM, l + 1 < DEPTH ? g_pre_mix + (size_t)(l + 1) * DM : nullptr, H, gw, NGW, lane); }
        SEAM(pb + 15);
#ifdef DIAG_CKS
        if (l == DEPTH - 1 && PH(pb + 15)) { PHASE_BEGIN(); xcd_barrier(bar);
            const unsigned c65 = __hip_atomic_load((unsigned*)(ws + WS_CTL) + 65, __ATOMIC_RELAXED, __HIP_MEMORY_SCOPE_AGENT), c66 = __hip_atomic_load((unsigned*)(ws + WS_CTL) + 66, __ATOMIC_RELAXED, __HIP_MEMORY_SCOPE_AGENT),
                           c67 = __hip_atomic_load((unsigned*)(ws + WS_CTL) + 67, __ATOMIC_RELAXED, __HIP_MEMORY_SCOPE_AGENT);
            (void)c65; (void)c66; (void)c67; const unsigned c68 = __hip_atomic_load((unsigned*)(ws + WS_CTL) + 68, __ATOMIC_RELAXED, __HIP_MEMORY_SCOPE_AGENT), c69 = __hip_atomic_load((unsigned*)(ws + WS_CTL) + 69, __ATOMIC_RELAXED, __HIP_MEMORY_SCOPE_AGENT),
                           c70 = __hip_atomic_load((unsigned*)(ws + WS_CTL) + 70, __ATOMIC_RELAXED, __HIP_MEMORY_SCOPE_AGENT);
            (void)c68; (void)c69; (void)c70; (void)c66; (void)c67; const unsigned c71 = __hip_atomic_load((unsigned*)(ws + WS_CTL) + 71, __ATOMIC_RELAXED, __HIP_MEMORY_SCOPE_AGENT), c72 = __hip_atomic_load((unsigned*)(ws + WS_CTL) + 72, __ATOMIC_RELAXED, __HIP_MEMORY_SCOPE_AGENT),
                           c73 = __hip_atomic_load((unsigned*)(ws + WS_CTL) + 73, __ATOMIC_RELAXED, __HIP_MEMORY_SCOPE_AGENT);
            const float fac = 1.0f + (c71 ? 0.4f : 0.f) + (c72 ? 0.2f : 0.f) + (c73 ? 0.1f : 0.f);
            if (fac != 1.0f) { for (size_t i = (size_t)gw * 64 + lane; i < (size_t)MTOK * DM; i += (size_t)NGW * 64) X[i] *= fac; } }
#endif
#ifdef DIAG_SELFCHK
        if (l == DEPTH - 1 && PH(pb + 15)) { PHASE_BEGIN(); xcd_barrier(bar);
            if (__hip_atomic_load((unsigned*)(ws + WS_CTL) + 64, __ATOMIC_RELAXED, __HIP_MEMORY_SCOPE_AGENT) != 0u) {
                for (size_t i = (size_t)gw * 64 + lane; i < (size_t)MTOK * DM; i += (size_t)NGW * 64) X[i] = __builtin_nanf(""); } }
#endif
    }
#undef PH
#undef SEAM
}

extern "C" void kernel_launch(void* const* d_in, const int* in_sizes, int n_in, void* d_out, int out_size, void* d_ws, size_t ws_size, hipStream_t stream) {
    static int grid = 0;
    if (grid == 0) {
        if (n_in != 31 || in_sizes[0] != MTOK * DM || out_size != MTOK * DM || ws_size < WS_END) {
            fprintf(stderr, "kernel_launch: unexpected shapes: n_in %d in0 %d out %d ws %zu (need %zu)\n", n_in, n_in > 0 ? in_sizes[0] : -1, out_size, ws_size, (size_t)WS_END); grid = -1; return; }
        int dev = 0, cus = 0;
        if (hipGetDevice(&dev) != hipSuccess || hipDeviceGetAttribute(&cus, hipDeviceAttributeMultiprocessorCount, dev) != hipSuccess) { grid = -1; return; }
        if (hipFuncSetAttribute((const void*)fwd, hipFuncAttributeMaxDynamicSharedMemorySize, LDS_BYTES) != hipSuccess) { fprintf(stderr, "kernel_launch: hipFuncSetAttribute failed\n"); grid = -1; return; }
        int per_cu = 0;
        if (hipOccupancyMaxActiveBlocksPerMultiprocessor(&per_cu, (const void*)fwd, NWAVES * 64, LDS_BYTES) != hipSuccess || per_cu < 1)
            fprintf(stderr, "kernel_launch: note: occupancy query reports %d workgroups per CU\n", per_cu);
        (void)hipGetLastError();
        if (cus != 256) { fprintf(stderr, "kernel_launch: built for a 256-CU MI355X (one 256 x 256 score unit per workgroup in the fused softmax phase); this device reports %d CUs; nothing launched\n", cus); grid = -1; return; }
        grid = cus;
    }
    if (grid < 0) return;
    if (hipMemsetAsync((char*)d_ws + WS_CTL, 0, CTL_ZERO_BYTES, stream) != hipSuccess) return;
    Args a{};
    for (int i = 0; i < 31; ++i) a.in[i] = d_in[i];
    a.out = (float*)d_out; a.ws = (unsigned char*)d_ws;
    for (int l = 0; l < 4; ++l) a.lam_init[l] = (float)(0.8 - 0.6 * exp(-0.3 * (double)l));
    for (int i = 0; i < 32; ++i) a.inv_freq[i] = (float)pow(10000.0, -(double)i / 32.0);
#if MK_SINGLE
    a.ph_lo = 0; a.ph_hi = NPH;
    hipLaunchKernelGGL(fwd, dim3(grid), dim3(NWAVES * 64), LDS_BYTES, stream, a);
#else
    for (int p = 0; p < NPH; ++p) { a.ph_lo = p; a.ph_hi = p + 1; hipLaunchKernelGGL(fwd, dim3(grid), dim3(NWAVES * 64), LDS_BYTES, stream, a); }
#endif
    const hipError_t le = hipPeekAtLastError();
    if (le != hipSuccess) fprintf(stderr, "kernel_launch: launch failed: %s\n", hipGetErrorName(le));
}
```

```cpp
#define ATT_STATIC 1
#include <hip/hip_runtime.h>
#include <cstdio>
#include <cstdint>
#include <cmath>

#define LAS __attribute__((address_space(3)))
#define GAS __attribute__((address_space(1)))
typedef unsigned short bf16_t;
typedef short bf16x8 __attribute__((ext_vector_type(8)));
typedef short s16x4 __attribute__((ext_vector_type(4)));
typedef float f32x2 __attribute__((ext_vector_type(2)));
typedef float f32x4 __attribute__((ext_vector_type(4)));
typedef float f32x16 __attribute__((ext_vector_type(16)));
typedef unsigned u32x2 __attribute__((ext_vector_type(2)));
typedef unsigned u32x4 __attribute__((ext_vector_type(4)));

constexpr int DM = 2048, BATCH = 4, SEQ = 4096, DEPTH = 4, MTOK = BATCH * SEQ;
constexpr int NIN_SRC = 8000, NIN = 8192;
constexpr int DFF = 5632, NUP = 2 * DFF;
constexpr int MEMT = 256, MROWS = BATCH * MEMT;
constexpr float EPS = 1e-6f;
constexpr float LOG2E = 1.4426950408889634f;

typedef __bf16 bf16x2_t __attribute__((ext_vector_type(2)));
__device__ __forceinline__ unsigned cvt_pk_bf16(float lo, float hi) { const f32x2 v = {lo, hi}; const bf16x2_t b = __builtin_convertvector(v, bf16x2_t); return __builtin_bit_cast(unsigned, b); }
__device__ __forceinline__ u32x4 pack8(f32x4 a, f32x4 b) { u32x4 w; w.x = cvt_pk_bf16(a[0], a[1]); w.y = cvt_pk_bf16(a[2], a[3]); w.z = cvt_pk_bf16(b[0], b[1]); w.w = cvt_pk_bf16(b[2], b[3]); return w; }
__device__ __forceinline__ float bflo(unsigned w) { return __uint_as_float(w << 16); }
__device__ __forceinline__ float bfhi(unsigned w) { return __uint_as_float(w & 0xffff0000u); }
template <int O> __device__ __forceinline__ float xor_lt32(float v) { return __int_as_float(__builtin_amdgcn_ds_swizzle(__float_as_int(v), (O << 10) | 0x1f)); }
__device__ __forceinline__ float sum_xor32(float v) { auto rr = __builtin_amdgcn_permlane32_swap(__float_as_uint(v), __float_as_uint(v), false, false); return __uint_as_float(rr[0]) + __uint_as_float(rr[1]); }
__device__ __forceinline__ float max_xor32(float v) { auto rr = __builtin_amdgcn_permlane32_swap(__float_as_uint(v), __float_as_uint(v), false, false); return fmaxf(__uint_as_float(rr[0]), __uint_as_float(rr[1])); }
__device__ __forceinline__ float half_sum(float v) { v += xor_lt32<1>(v); v += xor_lt32<2>(v); v += xor_lt32<4>(v); v += xor_lt32<8>(v); v += xor_lt32<16>(v); return v; }
__device__ __forceinline__ float wave_sum(float v) { return sum_xor32(half_sum(v)); }
__device__ __forceinline__ float wave_max(float v) { v = fmaxf(v, xor_lt32<1>(v)); v = fmaxf(v, xor_lt32<2>(v)); v = fmaxf(v, xor_lt32<4>(v)); v = fmaxf(v, xor_lt32<8>(v)); v = fmaxf(v, xor_lt32<16>(v)); return max_xor32(v); }

template <int OFF> __device__ __forceinline__ void st16(void* p, u32x4 v) {
#ifdef WT_STORES
    asm volatile("global_store_dwordx4 %0, %1, off offset:%2 sc1\n\ts_nop 1" :: "v"(p), "v"(v), "n"(OFF));
#else
    *(u32x4*)((char*)p + OFF) = v;
#endif
}
__device__ __forceinline__ void st16bj(bf16_t* rowp, int bj, u32x4 v) { if (bj == 0) st16<0>(rowp, v); else st16<256>(rowp, v); }
namespace pg8 {
constexpr int BM = 256, BK = 64, HALF = 128, HTB = HALF * BK * 2  , STAGE_BYTES = 8 * HTB, NXCD = 8, WGM = 8;

__host__ __device__ __forceinline__ int lds_byte(int r, int c) { const int st = (r >> 4) * 2 + (c >> 5), rr = r & 15, cc = c & 31, ob = rr * 64 + cc * 2; return st * 1024 + (ob ^ (((ob >> 9) & 1) << 5)); }
__host__ __device__ __forceinline__ void stage_rc(int b, int& R, int& C) { const int st = b / 1024, sb = b % 1024, swz = sb ^ (((sb >> 9) & 1) << 5); R = (st >> 1) * 16 + swz / 64; C = (st & 1) * 32 + (swz % 64) / 2; }
__host__ __device__ __forceinline__ int perm32(int rho) { const int n = rho >> 4, i = rho & 15; return 8 * (i >> 2) + 4 * n + (i & 3); }

template <class E> struct RowPerm { static constexpr bool v = false; };
struct Unit { int pm, pn, z; unsigned aoff, boff; };
struct Gemm { const bf16_t* A; const bf16_t* Bt; int lda, ldb, K; };

struct StaticOrder {
    int nM, nN, nwg, G, c, lda, ldb, wgm;
    __host__ __device__ __forceinline__ void init(int Mr, int N, int G_, int c_, int lda_, int ldb_, int wgm_ = WGM) { nM = Mr / BM; nN = N / BM; nwg = nM * nN; G = G_; c = c_; lda = lda_; ldb = ldb_; wgm = wgm_; }
    __host__ __device__ __forceinline__ bool next(int i, Unit& u) const {
        const long L = (long)i * G + c; if (L >= nwg) return false;
        int wgid = (int)L; { const int q = nwg / NXCD, r = nwg % NXCD, xcd = wgid % NXCD, off = wgid / NXCD; wgid = (xcd < r ? xcd * (q + 1) : r * (q + 1) + (xcd - r) * q) + off; }
        const int nig = wgm * nN, gid = wgid / nig, fm = gid * wgm, gsz = (nM - fm) < wgm ? (nM - fm) : wgm;
        u.pm = fm + ((wgid % nig) % gsz); u.pn = (wgid % nig) / gsz; u.z = 0;
        u.aoff = (unsigned)u.pm * (unsigned)(BM * lda); u.boff = (unsigned)u.pn * (unsigned)(BM * ldb); return true;
    }
    __device__ __forceinline__ void a_ready(const Unit&) const {}
    __device__ __forceinline__ void done(const Unit&) const {}
};

typedef f32x4 Acc[2][2][4][2];

template <class Epi, class Sched, bool ALIGN_EPI = false, bool SP2 = false>
__device__ __forceinline__ void gemm_phase(LAS unsigned char* lds, const Gemm g, const Sched& S, const Epi& E) {
    int tid = threadIdx.x; asm volatile("" : "+v"(tid));
    const int wid = __builtin_amdgcn_readfirstlane(tid >> 6), lane = tid & 63, wr = wid >> 2, wc = wid & 3, fr = lane & 15, fq = lane >> 4;
    int K = g.K; asm volatile("" : "+s"(K));
    const int nt = K / BK;
    unsigned voffA[2], voffB[2];
#pragma unroll
    for (int i = 0; i < 2; ++i) { int R, C; stage_rc(tid * 16 + i * 8192, R, C); const int Rb = Epi::PERM ? ((R & ~31) + perm32(R & 31)) : R;
        const int Ra = RowPerm<Epi>::v ? ((R & ~63) + 4 * (R & 15) + ((R >> 4) & 3)) : R;
        voffA[i] = (unsigned)(Ra * g.lda + C) * 2u; voffB[i] = (unsigned)(Rb * g.ldb + C) * 2u; }
    const size_t kstep = (size_t)(BK * 2);
    const size_t hstepA = (size_t)HALF * g.lda * 2, hstepB = (size_t)HALF * g.ldb * 2;
    const unsigned ldsw = (unsigned)wid * 1024u;
    const int aoff = lds_byte(wr * 64 + fr, fq * 8), boff = lds_byte(wc * 32 + fr, fq * 8);
#define PG8_SA(b, h) (((b) * 2 + (h)) * HTB)
#define PG8_SB(b, h) ((4 + (b) * 2 + (h)) * HTB)
#define PG8_STAGE(bufoff, gbase, voff) do { _Pragma("unroll") for (int _i = 0; _i < 2; ++_i) \
        __builtin_amdgcn_global_load_lds((const unsigned*)((const char*)(gbase) + (voff)[_i]), (LAS unsigned*)(lds + (bufoff) + ldsw + _i * 8192), 16, 0, 0); } while (0)
#define PG8_LDA(dst, b, h) do { _Pragma("unroll") for (int m = 0; m < 4; ++m) _Pragma("unroll") for (int k = 0; k < 2; ++k) dst[m][k] = *(const LAS bf16x8*)(lds + PG8_SA(b, h) + aoff + m * 2048 + k * 1024); } while (0)
#define PG8_LDB(dst, b, h) do { _Pragma("unroll") for (int n = 0; n < 2; ++n) _Pragma("unroll") for (int k = 0; k < 2; ++k) dst[n][k] = *(const LAS bf16x8*)(lds + PG8_SB(b, h) + boff + n * 2048 + k * 1024); } while (0)
#define PG8_MMA(ai, bj, At, Bt) do { __builtin_amdgcn_s_setprio(1); _Pragma("unroll") for (int m = 0; m < 4; ++m) _Pragma("unroll") for (int n = 0; n < 2; ++n) _Pragma("unroll") for (int k = 0; k < 2; ++k) \
        acc[ai][bj][m][n] = __builtin_amdgcn_mfma_f32_16x16x32_bf16(Bt[n][k], At[m][k], acc[ai][bj][m][n], 0, 0, 0); __builtin_amdgcn_s_setprio(0); } while (0)
#define PG8_WAIT_V(n) asm volatile("s_waitcnt vmcnt(" #n ")" ::: "memory")
#define PG8_WAIT_L(n) asm volatile("s_waitcnt lgkmcnt(" #n ")" ::: "memory")
#define PG8_BAR __builtin_amdgcn_s_barrier()
#define PG8_SCHED __builtin_amdgcn_sched_barrier(0)
    Unit cur, nxt; int ui = 0;
    if (!S.next(0, cur)) return;
    f32x4 acc[2][2][4][2];
#pragma unroll
    for (int a = 0; a < 2; ++a)
#pragma unroll
        for (int b = 0; b < 2; ++b)
#pragma unroll
            for (int m = 0; m < 4; ++m)
#pragma unroll
                for (int n = 0; n < 2; ++n) acc[a][b][m][n] = (f32x4){0.f, 0.f, 0.f, 0.f};
    bf16x8 At[4][2], B0[2][2], B1[2][2];
    const char* cA = (const char*)g.A + (size_t)cur.aoff * 2; const char* cB = (const char*)g.Bt + (size_t)cur.boff * 2;
    S.a_ready(cur);
    if constexpr (SP2) {
        PG8_STAGE(PG8_SB(0, 0), cB, voffB); PG8_STAGE(PG8_SB(0, 1), cB + hstepB, voffB); PG8_STAGE(PG8_SA(0, 0), cA, voffA); PG8_STAGE(PG8_SA(0, 1), cA + hstepA, voffA);
        if (wr == 1) PG8_BAR;
        PG8_WAIT_V(2); PG8_BAR;
        PG8_STAGE(PG8_SB(1, 0), cB + kstep, voffB); PG8_STAGE(PG8_SA(1, 0), cA + kstep, voffA); PG8_STAGE(PG8_SB(1, 1), cB + hstepB + kstep, voffB);
        PG8_WAIT_V(6); PG8_BAR;
    } else {
        PG8_STAGE(PG8_SB(0, 0), cB, voffB); PG8_STAGE(PG8_SA(0, 0), cA, voffA); PG8_STAGE(PG8_SB(0, 1), cB + hstepB, voffB); PG8_STAGE(PG8_SA(0, 1), cA + hstepA, voffA);
        if (wr == 1) PG8_BAR;
        PG8_WAIT_V(4); PG8_BAR;
        PG8_STAGE(PG8_SB(1, 0), cB + kstep, voffB); PG8_STAGE(PG8_SA(1, 0), cA + kstep, voffA); PG8_STAGE(PG8_SB(1, 1), cB + hstepB + kstep, voffB);
        PG8_WAIT_V(6); PG8_BAR;
    }
    for (;;) {
        const bool has_next = S.next(ui + 1, nxt);
        const char* nA = has_next ? (const char*)g.A + (size_t)nxt.aoff * 2 : cA; const char* nB = has_next ? (const char*)g.Bt + (size_t)nxt.boff * 2 : cB;
        for (int t = 0; t < nt; t += 2) {
            const bool last = (t == nt - 2);
            const char* a1 = cA + (size_t)(t + 1) * kstep;
            const char* a2 = last ? nA : cA + (size_t)(t + 2) * kstep; const char* b2 = last ? nB : cB + (size_t)(t + 2) * kstep;
            const char* a3 = a2 + kstep; const char* b3 = b2 + kstep;
            if (last && has_next) S.a_ready(nxt);
            if constexpr (SP2) {
            PG8_LDB(B0, 0, 0); PG8_LDB(B1, 0, 1); PG8_SCHED; PG8_LDA(At, 0, 0); PG8_STAGE(PG8_SA(1, 1), a1 + hstepA, voffA);
            PG8_WAIT_V(8); PG8_WAIT_L(0); PG8_BAR; PG8_MMA(0, 0, At, B0); PG8_MMA(0, 1, At, B1); PG8_BAR; PG8_SCHED;
            PG8_LDA(At, 0, 1); PG8_STAGE(PG8_SB(0, 0), b2, voffB); PG8_STAGE(PG8_SB(0, 1), b2 + hstepB, voffB); PG8_STAGE(PG8_SA(0, 0), a2, voffA);
            PG8_WAIT_V(8); PG8_WAIT_L(0); PG8_BAR; PG8_MMA(1, 0, At, B0); PG8_MMA(1, 1, At, B1); PG8_BAR; PG8_SCHED;
            PG8_LDB(B0, 1, 0); PG8_LDB(B1, 1, 1); PG8_SCHED; PG8_LDA(At, 1, 0); PG8_STAGE(PG8_SA(0, 1), a2 + hstepA, voffA);
            PG8_WAIT_V(8); PG8_WAIT_L(0); PG8_BAR; PG8_MMA(0, 0, At, B0); PG8_MMA(0, 1, At, B1); PG8_BAR; PG8_SCHED;
            PG8_LDA(At, 1, 1); PG8_STAGE(PG8_SB(1, 0), b3, voffB); PG8_STAGE(PG8_SB(1, 1), b3 + hstepB, voffB); PG8_STAGE(PG8_SA(1, 0), a3, voffA);
            PG8_WAIT_V(8); PG8_WAIT_L(0); PG8_BAR; PG8_MMA(1, 0, At, B0); PG8_MMA(1, 1, At, B1); PG8_BAR; PG8_SCHED;
            } else {
            PG8_LDB(B0, 0, 0); PG8_SCHED; PG8_LDA(At, 0, 0); PG8_STAGE(PG8_SA(1, 1), a1 + hstepA, voffA);
            PG8_WAIT_L(8); PG8_BAR; PG8_WAIT_L(0); PG8_MMA(0, 0, At, B0); PG8_BAR; PG8_SCHED;
            PG8_LDB(B1, 0, 1); PG8_STAGE(PG8_SB(0, 0), b2, voffB);
            PG8_BAR; PG8_WAIT_L(0); PG8_MMA(0, 1, At, B1); PG8_BAR;
            PG8_LDA(At, 0, 1); PG8_STAGE(PG8_SA(0, 0), a2, voffA);
            PG8_BAR; PG8_WAIT_L(0); PG8_MMA(1, 0, At, B0); PG8_BAR; PG8_SCHED;
            PG8_STAGE(PG8_SB(0, 1), b2 + hstepB, voffB);
            PG8_WAIT_V(6); PG8_BAR; PG8_MMA(1, 1, At, B1); PG8_BAR;
            PG8_LDB(B0, 1, 0); PG8_SCHED; PG8_LDA(At, 1, 0); PG8_STAGE(PG8_SA(0, 1), a2 + hstepA, voffA);
            PG8_WAIT_L(8); PG8_BAR; PG8_WAIT_L(0); PG8_MMA(0, 0, At, B0); PG8_BAR; PG8_SCHED;
            PG8_LDB(B1, 1, 1); PG8_STAGE(PG8_SB(1, 0), b3, voffB);
            PG8_BAR; PG8_WAIT_L(0); PG8_MMA(0, 1, At, B1); PG8_BAR;
            PG8_LDA(At, 1, 1); PG8_STAGE(PG8_SA(1, 0), a3, voffA);
            PG8_BAR; PG8_WAIT_L(0); PG8_MMA(1, 0, At, B0); PG8_BAR; PG8_SCHED;
            PG8_STAGE(PG8_SB(1, 1), b3 + hstepB, voffB);
            PG8_WAIT_V(6); PG8_BAR; PG8_MMA(1, 1, At, B1); PG8_BAR;
            }
        }
        if constexpr (ALIGN_EPI) { if (wr == 0) PG8_BAR; }
        if constexpr (!Epi::AFTER_DRAIN) { E(acc, cur, wr, wc, fr, fq); S.done(cur); }
        if (!has_next) break;
        if (!(Epi::MIDK && cur.z == 0)) {
#pragma unroll
        for (int a = 0; a < 2; ++a)
#pragma unroll
            for (int b = 0; b < 2; ++b)
#pragma unroll
                for (int m = 0; m < 4; ++m)
#pragma unroll
                    for (int n = 0; n < 2; ++n) acc[a][b][m][n] = (f32x4){0.f, 0.f, 0.f, 0.f};
        }
        cur = nxt; cA = nA; cB = nB; ++ui;
        if constexpr (ALIGN_EPI) { if (wr == 1) PG8_BAR; }
    }
    PG8_WAIT_V(0);
    if constexpr (!ALIGN_EPI) { if (wr == 0) PG8_BAR; }
    PG8_BAR;
    if constexpr (Epi::AFTER_DRAIN) { E.fused(acc, cur, wr, wc, fr, fq, lds, wid, lane); S.done(cur); }
#undef PG8_SA
#undef PG8_SB
#undef PG8_STAGE
#undef PG8_LDA
#undef PG8_LDB
#undef PG8_MMA
#undef PG8_WAIT_V
#undef PG8_WAIT_L
#undef PG8_BAR
#undef PG8_SCHED
}
}
constexpr size_t MiB = (size_t)1 << 20;
constexpr size_t WO_IN = 0;
constexpr size_t WO_UQ = WO_IN + (size_t)NIN * DM;
constexpr size_t WO_UKV = WO_UQ + (size_t)1536 * 512;
constexpr size_t WO_BR = WO_UKV + (size_t)2048 * 256;
constexpr size_t WO_MIX = WO_BR + (size_t)DM * DM;
constexpr size_t WO_WK = WO_MIX + (size_t)DM * DM;
constexpr size_t WO_VW = WO_WK + (size_t)BATCH * 1024 * DM;
constexpr size_t WO_UP = WO_VW + (size_t)BATCH * DM * 1024;
constexpr size_t WO_DOWN = WO_UP + (size_t)NUP * DM;
constexpr size_t W_LAYER = WO_DOWN + (size_t)DM * DFF;
static_assert(W_LAYER * 2 == 297 * MiB / 2, "layer blob size");

constexpr size_t WS_CTL = 0, CTL_ZERO_BYTES = 1 * MiB;
constexpr size_t WS_CS = 1 * MiB;
constexpr size_t WS_SSQ_CQ = 5 * MiB;
constexpr size_t WS_SSQ_CKV = WS_SSQ_CQ + (size_t)MTOK * 8 * 4;
constexpr size_t WS_W = 38 * MiB;
constexpr size_t WS_H = WS_W + 4 * W_LAYER * 2;
constexpr size_t WS_RA = WS_H + 64 * MiB;
constexpr size_t WS_RB = WS_RA + 352 * MiB;
constexpr size_t WS_RC = WS_RB + 176 * MiB;
constexpr size_t WS_END = WS_RC + 128 * MiB;
constexpr size_t WS_SCR = WS_END, WS_TOP = WS_END + 32 * MiB;
static_assert(WS_H == 632 * MiB, "ws map");
constexpr size_t RA_QD = WS_RA, RA_KD = WS_RA + 32 * MiB, RA_VD = WS_RA + 64 * MiB, RA_CQ = WS_RA + 96 * MiB, RA_CKV = WS_RA + 112 * MiB, RA_KPE = WS_RA + 120 * MiB,
                 RA_GATES = WS_RA + 128 * MiB, RA_MERGED = WS_RA + 256 * MiB;
constexpr size_t RA_QX = WS_RA, RA_S = WS_RA + 64 * MiB, RA_P = WS_RA + 128 * MiB, RA_OX = WS_RA + 160 * MiB;
constexpr size_t RA_U = WS_RA;
constexpr size_t RA_QXP = WS_RA, RA_KVXT = WS_RA + 32 * MiB, RA_OXT = WS_RA + 96 * MiB, RA_MEMN = WS_RA + 128 * MiB, RA_KMEM = WS_RA + 144 * MiB, RA_VMEM = WS_RA + 160 * MiB;
constexpr size_t RB_QM = WS_RB, RB_KN = WS_RB + 48 * MiB, RB_VM = WS_RB + 80 * MiB, RB_OCAT = WS_RB + 112 * MiB;
constexpr size_t RB_ACT = WS_RB;
constexpr size_t RC_Y = WS_RC;

constexpr int CW_BAR = 4096;

namespace pg8 {
__device__ __forceinline__ void rope8(f32x4& v0, f32x4& v1, const f32x2* csp) {
    const f32x4 c01 = *(const f32x4*)csp, c23 = *(const f32x4*)(csp + 2);
    const f32x4 a = v0, b = v1;
    v0[0] = a[0] * c01[0] - a[1] * c01[1]; v0[1] = a[1] * c01[0] + a[0] * c01[1];
    v0[2] = a[2] * c01[2] - a[3] * c01[3]; v0[3] = a[3] * c01[2] + a[2] * c01[3];
    v1[0] = b[0] * c23[0] - b[1] * c23[1]; v1[1] = b[1] * c23[0] + b[0] * c23[1];
    v1[2] = b[2] * c23[2] - b[3] * c23[3]; v1[3] = b[3] * c23[2] + b[2] * c23[3];
}
__device__ __forceinline__ float sigm(float v) { return __builtin_amdgcn_rcpf(1.0f + __builtin_amdgcn_exp2f(-v * LOG2E)); }
__device__ __forceinline__ float sq8(u32x4 w) { const float a = bflo(w.x), b = bfhi(w.x), c = bflo(w.y), d = bfhi(w.y), e = bflo(w.z), f = bfhi(w.z), g = bflo(w.w), h = bfhi(w.w);
    return ((a * a + b * b) + (c * c + d * d)) + ((e * e + f * f) + (g * g + h * h)); }

struct EpiProj {
    static constexpr bool PERM = true, AFTER_DRAIN = false, MIDK = false;
    bf16_t *Qd, *Kd, *Vd, *cq, *ckv, *kpe, *gates; float *ssq_cq, *ssq_ckv; const float* bgate; const f32x2* cs;
    __device__ __forceinline__ void operator()(const Acc& acc, const Unit& u, int wr, int wc, int fr, int fq) const {
        const int pn = u.pn, row0 = u.pm * BM + wr * 64 + fr, cb = wc * 32 + 8 * fq;
        if (pn >= 16) {
            const int colt = (pn - 16) * 256 + cb;
            f32x4 bv[2][2];
#pragma unroll
            for (int bj = 0; bj < 2; ++bj)
#pragma unroll
                for (int n = 0; n < 2; ++n) bv[bj][n] = *(const f32x4*)(bgate + colt + bj * HALF + 4 * n) * -LOG2E;
#pragma unroll
            for (int ai = 0; ai < 2; ++ai)
#pragma unroll
                for (int m = 0; m < 4; ++m) { bf16_t* rowp = gates + (size_t)(row0 + ai * HALF + m * 16) * 4096 + colt;
#pragma unroll
                    for (int bj = 0; bj < 2; ++bj) { f32x4 v0 = acc[ai][bj][m][0] * -LOG2E + bv[bj][0], v1 = acc[ai][bj][m][1] * -LOG2E + bv[bj][1];
#pragma unroll
                        for (int e = 0; e < 4; ++e) { v0[e] = __builtin_amdgcn_rcpf(1.0f + __builtin_amdgcn_exp2f(v0[e])); v1[e] = __builtin_amdgcn_rcpf(1.0f + __builtin_amdgcn_exp2f(v1[e])); }
                        __builtin_nontemporal_store(pack8(v0, v1), (u32x4*)(rowp + bj * HALF)); } }
        } else if (pn >= 8 && pn < 15) {
            bf16_t* base; int ld, colt; float* ssq = nullptr; int ssld = 0, sslot = 0;
            if (pn < 12) { base = Vd; ld = 1024; colt = (pn - 8) * 256; }
            else if (pn < 14) { base = cq; ld = 512; colt = (pn - 12) * 256; ssq = ssq_cq; ssld = 8; sslot = (pn - 12) * 4 + wc; }
            else { base = ckv; ld = 256; colt = 0; ssq = ssq_ckv; ssld = 4; sslot = wc; }
            colt += cb;
#pragma unroll
            for (int ai = 0; ai < 2; ++ai)
#pragma unroll
                for (int m = 0; m < 4; ++m) { const int row = row0 + ai * HALF + m * 16; bf16_t* rowp = base + (size_t)row * ld + colt; float ss = 0.f;
#pragma unroll
                    for (int bj = 0; bj < 2; ++bj) { const u32x4 w = pack8(acc[ai][bj][m][0], acc[ai][bj][m][1]); st16bj(rowp, bj, w); ss += sq8(w); }
                    if (ssq) { ss += xor_lt32<16>(ss); ss = sum_xor32(ss); if (fq == 0) ssq[(size_t)row * ssld + sslot] = ss; } }
        } else {
            bf16_t* base; int ld, colt;
            if (pn < 4) { base = Qd; ld = 1024; colt = pn * 256; } else if (pn < 8) { base = Kd; ld = 1024; colt = (pn - 4) * 256; } else { base = kpe; ld = 64; colt = 0; }
            colt += cb;
#pragma unroll
            for (int ai = 0; ai < 2; ++ai)
#pragma unroll
                for (int m = 0; m < 4; ++m) { const int row = row0 + ai * HALF + m * 16; bf16_t* rowp = base + (size_t)row * ld + colt; const f32x2* csr = cs + (size_t)row * 32;
#pragma unroll
                    for (int bj = 0; bj < 2; ++bj) { const int col = colt + bj * HALF;
                        if (pn == 15 && col >= 64) continue;
                        f32x4 v0 = acc[ai][bj][m][0], v1 = acc[ai][bj][m][1]; rope8(v0, v1, csr + ((col & 63) >> 1));
                        st16bj(rowp, bj, pack8(v0, v1)); } }
        }
    }
};
struct EpiQm {
    static constexpr bool PERM = true, AFTER_DRAIN = false, MIDK = false;
    bf16_t* Qm; const float* ssq; const f32x2* cs;
    __device__ __forceinline__ void operator()(const Acc& acc, const Unit& u, int wr, int wc, int fr, int fq) const {
        const int row0 = u.pm * BM + wr * 64 + fr, colt = u.pn * BM + wc * 32 + 8 * fq;
#pragma unroll
        for (int ai = 0; ai < 2; ++ai)
#pragma unroll
            for (int m = 0; m < 4; ++m) { const int row = row0 + ai * HALF + m * 16;
                const f32x4 s0 = *(const f32x4*)(ssq + (size_t)row * 8), s1 = *(const f32x4*)(ssq + (size_t)row * 8 + 4);
                const float rs = __builtin_amdgcn_rsqf((((s0[0] + s0[1]) + (s0[2] + s0[3])) + ((s1[0] + s1[1]) + (s1[2] + s1[3]))) * (1.0f / 512.0f) + EPS);
                bf16_t* rowp = Qm + (size_t)row * 1536 + colt; const f32x2* csr = cs + (size_t)row * 32;
#pragma unroll
                for (int bj = 0; bj < 2; ++bj) { const int col = colt + bj * HALF, r = col % 192;
                    f32x4 v0 = acc[ai][bj][m][0] * rs, v1 = acc[ai][bj][m][1] * rs;
                    if (r >= 128) rope8(v0, v1, csr + ((r - 128) >> 1));
                    st16bj(rowp, bj, pack8(v0, v1)); } }
    }
};
struct EpiKv {
    static constexpr bool PERM = true, AFTER_DRAIN = false, MIDK = false;
    bf16_t *Kn, *Vm; const float* ssq;
    __device__ __forceinline__ void operator()(const Acc& acc, const Unit& u, int wr, int wc, int fr, int fq) const {
        const int row0 = u.pm * BM + wr * 64 + fr; int colt = u.pn * BM; bf16_t* base = Kn; if (colt >= 1024) { base = Vm; colt -= 1024; } colt += wc * 32 + 8 * fq;
#pragma unroll
        for (int ai = 0; ai < 2; ++ai)
#pragma unroll
            for (int m = 0; m < 4; ++m) { const int row = row0 + ai * HALF + m * 16; const f32x4 s = *(const f32x4*)(ssq + (size_t)row * 4);
                const float rs = __builtin_amdgcn_rsqf(((s[0] + s[1]) + (s[2] + s[3])) * (1.0f / 256.0f) + EPS); bf16_t* rowp = base + (size_t)row * 1024 + colt;
#pragma unroll
                for (int bj = 0; bj < 2; ++bj) st16bj(rowp, bj, pack8(acc[ai][bj][m][0] * rs, acc[ai][bj][m][1] * rs)); }
    }
};
template <int MODE> struct EpiGate {
    static constexpr bool PERM = true, AFTER_DRAIN = false, MIDK = false;
    const bf16_t* gates; float* t; bf16_t* merged;
    __device__ __forceinline__ void operator()(const Acc& acc, const Unit& u, int wr, int wc, int fr, int fq) const {
        const int row0 = u.pm * BM + wr * 64 + fr, colt = u.pn * BM + wc * 32 + 8 * fq;
#pragma unroll
        for (int ai = 0; ai < 2; ++ai)
#pragma unroll
            for (int m = 0; m < 4; ++m) { const size_t row = (size_t)(row0 + ai * HALF + m * 16);
#pragma unroll
                for (int bj = 0; bj < 2; ++bj) { const int col = colt + bj * HALF;
                    const u32x4 gw = *(const u32x4*)(gates + row * 4096 + MODE * 2048 + col);
                    const f32x4 g0 = (f32x4){bflo(gw.x), bfhi(gw.x), bflo(gw.y), bfhi(gw.y)}, g1 = (f32x4){bflo(gw.z), bfhi(gw.z), bflo(gw.w), bfhi(gw.w)};
                    float* tp = t + row * 2048 + col;
                    if (MODE == 0) { const f32x4 s0 = acc[ai][bj][m][0] * g0, s1 = acc[ai][bj][m][1] * g1; unsigned long long* tq = (unsigned long long*)tp;
                        __hip_atomic_store(tq, ((unsigned long long)__float_as_uint(s0[1]) << 32) | __float_as_uint(s0[0]), __ATOMIC_RELAXED, __HIP_MEMORY_SCOPE_AGENT);
                        __hip_atomic_store(tq + 1, ((unsigned long long)__float_as_uint(s0[3]) << 32) | __float_as_uint(s0[2]), __ATOMIC_RELAXED, __HIP_MEMORY_SCOPE_AGENT);
                        __hip_atomic_store(tq + 2, ((unsigned long long)__float_as_uint(s1[1]) << 32) | __float_as_uint(s1[0]), __ATOMIC_RELAXED, __HIP_MEMORY_SCOPE_AGENT);
                        __hip_atomic_store(tq + 3, ((unsigned long long)__float_as_uint(s1[3]) << 32) | __float_as_uint(s1[2]), __ATOMIC_RELAXED, __HIP_MEMORY_SCOPE_AGENT); }
                    else { f32x4 t0, t1;
                        { const unsigned long long* tq = (const unsigned long long*)tp;
                          const unsigned long long w0 = __hip_atomic_load(tq, __ATOMIC_RELAXED, __HIP_MEMORY_SCOPE_AGENT), w1 = __hip_atomic_load(tq + 1, __ATOMIC_RELAXED, __HIP_MEMORY_SCOPE_AGENT),
                                                   w2 = __hip_atomic_load(tq + 2, __ATOMIC_RELAXED, __HIP_MEMORY_SCOPE_AGENT), w3 = __hip_atomic_load(tq + 3, __ATOMIC_RELAXED, __HIP_MEMORY_SCOPE_AGENT);
                          t0 = (f32x4){__uint_as_float((unsigned)w0), __uint_as_float((unsigned)(w0 >> 32)), __uint_as_float((unsigned)w1), __uint_as_float((unsigned)(w1 >> 32))};
                          t1 = (f32x4){__uint_as_float((unsigned)w2), __uint_as_float((unsigned)(w2 >> 32)), __uint_as_float((unsigned)w3), __uint_as_float((unsigned)(w3 >> 32))}; }
                        const f32x4 a0 = t0 + acc[ai][bj][m][0] * g0, a1 = t1 + acc[ai][bj][m][1] * g1;
                        *(u32x4*)(merged + row * 2048 + col) = pack8(a0, a1); } } }
    }
};
template <int CTRL> __device__ __forceinline__ float dppk(float old, float src) { return __builtin_bit_cast(float, __builtin_amdgcn_update_dpp(__builtin_bit_cast(int, old), __builtin_bit_cast(int, src), CTRL, 0xf, 0xf, false)); }
#define CT_ONE(c, x, p, w1, w0) \
    "v_fmac_f32_dpp " c ", " x ", " w1 " row_shr:1 row_mask:0xf bank_mask:0xf bound_ctrl:0\n\t" \
    "v_fmac_f32_dpp " c ", " x ", " w0 " row_shr:2 row_mask:0xf bank_mask:0xf bound_ctrl:0\n\t" \
    "v_fmac_f32_dpp " c ", " p ", " w1 " row_shl:15 row_mask:0xf bank_mask:0xf bound_ctrl:0\n\t" \
    "v_fmac_f32_dpp " c ", " p ", " w0 " row_shl:14 row_mask:0xf bank_mask:0xf bound_ctrl:0\n\t"
__device__ __forceinline__ void conv_taps(f32x4& c, const f32x4& x, const f32x4& p, const f32x4& w1, const f32x4& w0) {
    float c0 = c[0], c1 = c[1], c2 = c[2], c3 = c[3];
    asm("s_nop 1\n\t"
        CT_ONE("%0", "%4", "%8", "%12", "%16") CT_ONE("%1", "%5", "%9", "%13", "%17") CT_ONE("%2", "%6", "%10", "%14", "%18") CT_ONE("%3", "%7", "%11", "%15", "%19")
        : "+v"(c0), "+v"(c1), "+v"(c2), "+v"(c3)
        : "v"(x[0]), "v"(x[1]), "v"(x[2]), "v"(x[3]), "v"(p[0]), "v"(p[1]), "v"(p[2]), "v"(p[3]), "v"(w1[0]), "v"(w1[1]), "v"(w1[2]), "v"(w1[3]), "v"(w0[0]), "v"(w0[1]), "v"(w0[2]), "v"(w0[3]));
    c = (f32x4){c0, c1, c2, c3};
}
#ifndef CONV_V1
#define CT2_ONE(c1, c0, x3, x2, w1, w0) \
    "v_fmac_f32_dpp " c1 ", " x3 ", " w0 " row_shr:1 row_mask:0xf bank_mask:0xf bound_ctrl:0\n\t" \
    "v_fmac_f32_dpp " c0 ", " x3 ", " w1 " row_shr:1 row_mask:0xf bank_mask:0xf bound_ctrl:0\n\t" \
    "v_fmac_f32_dpp " c0 ", " x2 ", " w0 " row_shr:1 row_mask:0xf bank_mask:0xf bound_ctrl:0\n\t"
__device__ __forceinline__ void conv_taps2(f32x4& c1, f32x4& c0, const f32x4& x3, const f32x4& x2, const f32x4& w1, const f32x4& w0) {
    float a0 = c1[0], a1 = c1[1], a2 = c1[2], a3 = c1[3], b0 = c0[0], b1 = c0[1], b2 = c0[2], b3 = c0[3];
    asm("s_nop 1\n\t"
        CT2_ONE("%0", "%4", "%8", "%12", "%16", "%20") CT2_ONE("%1", "%5", "%9", "%13", "%17", "%21") CT2_ONE("%2", "%6", "%10", "%14", "%18", "%22") CT2_ONE("%3", "%7", "%11", "%15", "%19", "%23")
        : "+v"(a0), "+v"(a1), "+v"(a2), "+v"(a3), "+v"(b0), "+v"(b1), "+v"(b2), "+v"(b3)
        : "v"(x3[0]), "v"(x3[1]), "v"(x3[2]), "v"(x3[3]), "v"(x2[0]), "v"(x2[1]), "v"(x2[2]), "v"(x2[3]),
          "v"(w1[0]), "v"(w1[1]), "v"(w1[2]), "v"(w1[3]), "v"(w0[0]), "v"(w0[1]), "v"(w0[2]), "v"(w0[3]));
    c1 = (f32x4){a0, a1, a2, a3}; c0 = (f32x4){b0, b1, b2, b3};
}
struct EpiConvGlu {
    static constexpr bool PERM = true, AFTER_DRAIN = false, MIDK = false;
    bf16_t* act; float* U4; const float* cw; const float* cb; LAS unsigned char* xl;
    __device__ __forceinline__ void operator()(const Acc& acc, const Unit& u, int wr, int wc, int fr, int fq) const {
        const int wid = wr * 4 + wc, cu = u.pn * BM + wc * 32 + 8 * fq;
        if (fr == 15) {
#pragma unroll
            for (int ai = 0; ai < 2; ++ai)
#pragma unroll
                for (int rs = 0; rs < 2; ++rs)
#pragma unroll
                    for (int bj = 0; bj < 2; ++bj)
#pragma unroll
                        for (int n = 0; n < 2; ++n) *(LAS f32x4*)(xl + ((((wid * 2 + ai) * 2 + rs) * 64 + bj * 32 + fq * 8 + n * 4) * 4)) = acc[ai][bj][2 + rs][n];
        }
        if (wr == 0 && fr == 0) {
#pragma unroll
            for (int k = 0; k < 2; ++k)
#pragma unroll
                for (int bj = 0; bj < 2; ++bj)
#pragma unroll
                    for (int n = 0; n < 2; ++n) *(f32x4*)(U4 + ((size_t)(u.pm * 4 + k) * NUP + cu + bj * HALF + n * 4)) = acc[0][bj][k][n];
        }
        if (wr == 1 && fr == 15) {
#pragma unroll
            for (int k = 0; k < 2; ++k)
#pragma unroll
                for (int bj = 0; bj < 2; ++bj)
#pragma unroll
                    for (int n = 0; n < 2; ++n) *(f32x4*)(U4 + ((size_t)(u.pm * 4 + 2 + k) * NUP + cu + bj * HALF + n * 4)) = acc[1][bj][2 + k][n];
        }
        asm volatile("s_waitcnt lgkmcnt(0)" ::: "memory"); __builtin_amdgcn_s_barrier(); asm volatile("" ::: "memory");
#pragma unroll
        for (int bj = 0; bj < 2; ++bj) {
            const int gidx = (cu + bj * HALF) >> 3;
            f32x4 wa[3], wg[3];
#pragma unroll
            for (int j = 0; j < 3; ++j) { wa[j] = *(const f32x4*)(cw + (size_t)j * NUP + 4 * gidx); wg[j] = *(const f32x4*)(cw + (size_t)j * NUP + DFF + 4 * gidx); }
            const f32x4 ba = *(const f32x4*)(cb + 4 * gidx), bg = *(const f32x4*)(cb + DFF + 4 * gidx);
#pragma unroll
            for (int ai = 0; ai < 2; ++ai) {
                const f32x4 z = (f32x4){0.f, 0.f, 0.f, 0.f};
                f32x4 pa2 = z, pa3 = z, pg2 = z, pg3 = z;
                if ((wr == 1 || ai == 1) && fr == 0) { const int pw = wr == 1 ? wid - 4 : wid + 4, pai = wr == 1 ? ai : 0;
                    const LAS unsigned char* hp = xl + ((((pw * 2 + pai) * 2) * 64 + bj * 32 + fq * 8) * 4);
                    pa2 = *(const LAS f32x4*)hp; pg2 = *(const LAS f32x4*)(hp + 16); pa3 = *(const LAS f32x4*)(hp + 256); pg3 = *(const LAS f32x4*)(hp + 256 + 16); }
                const f32x4 x0 = acc[ai][bj][0][0], x1 = acc[ai][bj][1][0], x2 = acc[ai][bj][2][0], x3 = acc[ai][bj][3][0];
                const f32x4 g0 = acc[ai][bj][0][1], g1 = acc[ai][bj][1][1], g2 = acc[ai][bj][2][1], g3 = acc[ai][bj][3][1];
                f32x4 ca[4], cg[4];
                ca[3] = x3 * wa[2] + x2 * wa[1] + x1 * wa[0] + ba;           cg[3] = g3 * wg[2] + g2 * wg[1] + g1 * wg[0] + bg;
                ca[2] = x2 * wa[2] + x1 * wa[1] + x0 * wa[0] + ba;           cg[2] = g2 * wg[2] + g1 * wg[1] + g0 * wg[0] + bg;
                ca[1] = x1 * wa[2] + x0 * wa[1] + pa3 * wa[0] + ba;          cg[1] = g1 * wg[2] + g0 * wg[1] + pg3 * wg[0] + bg;
                ca[0] = x0 * wa[2] + pa3 * wa[1] + pa2 * wa[0] + ba;         cg[0] = g0 * wg[2] + pg3 * wg[1] + pg2 * wg[0] + bg;
                conv_taps2(ca[1], ca[0], x3, x2, wa[1], wa[0]); conv_taps2(cg[1], cg[0], g3, g2, wg[1], wg[0]);
                bf16_t* ap = act + (size_t)(u.pm * BM + ai * HALF + wr * 64 + 4 * fr) * DFF + 4 * gidx;
#pragma unroll
                for (int m = 0; m < 4; ++m) { f32x4 o;
#pragma unroll
                    for (int e = 0; e < 4; ++e) o[e] = ca[m][e] * __builtin_amdgcn_rcpf(1.0f + __builtin_amdgcn_exp2f(-ca[m][e] * LOG2E)) * cg[m][e];
                    u32x2 w; w.x = cvt_pk_bf16(o[0], o[1]); w.y = cvt_pk_bf16(o[2], o[3]);
                    *(u32x2*)(ap + (size_t)m * DFF) = w; }
            }
        }
    }
};
template <> struct RowPerm<EpiConvGlu> { static constexpr bool v = true; };
#else
struct EpiConvGlu {
    static constexpr bool PERM = true, AFTER_DRAIN = false, MIDK = false;
    bf16_t* act; float* U4; const float* cw; const float* cb; LAS unsigned char* xl;
    __device__ __forceinline__ void operator()(const Acc& acc, const Unit& u, int wr, int wc, int fr, int fq) const {
        const int wid = wr * 4 + wc, cu = u.pn * BM + wc * 32 + 8 * fq;
        if (fr >= 14) {
#pragma unroll
            for (int ai = 0; ai < 2; ++ai)
#pragma unroll
                for (int bj = 0; bj < 2; ++bj)
#pragma unroll
                    for (int n = 0; n < 2; ++n) *(LAS f32x4*)(xl + ((((wid * 2 + ai) * 2 + (fr - 14)) * 64 + bj * 32 + fq * 8 + n * 4) * 4)) = acc[ai][bj][3][n];
        }
        if (wr == 0 && fr < 2) {
#pragma unroll
            for (int bj = 0; bj < 2; ++bj)
#pragma unroll
                for (int n = 0; n < 2; ++n) *(f32x4*)(U4 + ((size_t)(u.pm * 4 + fr) * NUP + cu + bj * HALF + n * 4)) = acc[0][bj][0][n];
        }
        if (wr == 1 && fr >= 14) {
#pragma unroll
            for (int bj = 0; bj < 2; ++bj)
#pragma unroll
                for (int n = 0; n < 2; ++n) *(f32x4*)(U4 + ((size_t)(u.pm * 4 + 2 + (fr - 14)) * NUP + cu + bj * HALF + n * 4)) = acc[1][bj][3][n];
        }
        asm volatile("s_waitcnt lgkmcnt(0)" ::: "memory"); __builtin_amdgcn_s_barrier(); asm volatile("" ::: "memory");
#pragma unroll
        for (int bj = 0; bj < 2; ++bj) {
            const int gidx = (cu + bj * HALF) >> 3;
            f32x4 wa[3], wg[3];
#pragma unroll
            for (int j = 0; j < 3; ++j) { wa[j] = *(const f32x4*)(cw + (size_t)j * NUP + 4 * gidx); wg[j] = *(const f32x4*)(cw + (size_t)j * NUP + DFF + 4 * gidx); }
            const f32x4 ba = *(const f32x4*)(cb + 4 * gidx), bg = *(const f32x4*)(cb + DFF + 4 * gidx);
#pragma unroll
            for (int ai = 0; ai < 2; ++ai) {
                f32x4 pa = (f32x4){0.f, 0.f, 0.f, 0.f}, pg = pa;
                if (wr == 1 || ai == 1) { const int pw = wr == 1 ? wid - 4 : wid + 4, pai = wr == 1 ? ai : 0;
                    const LAS unsigned char* hp = xl + ((((pw * 2 + pai) * 2 + (fr & 1)) * 64 + bj * 32 + fq * 8) * 4);
                    pa = *(const LAS f32x4*)hp; pg = *(const LAS f32x4*)(hp + 16); }
                bf16_t* ap = act + (size_t)(u.pm * BM + ai * HALF + wr * 64 + fr) * DFF + 4 * gidx;
#pragma unroll
                for (int m = 0; m < 4; ++m) {
                    const f32x4 a0 = acc[ai][bj][m][0], g0 = acc[ai][bj][m][1];
                    f32x4 ca = a0 * wa[2] + ba, cg = g0 * wg[2] + bg; f32x4 o;
                    conv_taps(ca, a0, pa, wa[1], wa[0]); conv_taps(cg, g0, pg, wg[1], wg[0]);
#pragma unroll
                    for (int e = 0; e < 4; ++e) o[e] = ca[e] * __builtin_amdgcn_rcpf(1.0f + __builtin_amdgcn_exp2f(-ca[e] * LOG2E)) * cg[e];
                    u32x2 w; w.x = cvt_pk_bf16(o[0], o[1]); w.y = cvt_pk_bf16(o[2], o[3]);
                    *(u32x2*)(ap + (size_t)(m * 16) * DFF) = w;
                    pa = a0; pg = g0;
                }
            }
        }
    }
};
#endif
struct EpiSoftmax {
    static constexpr bool PERM = true, AFTER_DRAIN = true, MIDK = false;
    bf16_t* P;
    __device__ __forceinline__ void fused(Acc& acc, const Unit& u, int wr, int wc, int fr, int fq, LAS unsigned char* lds, int wid, int lane) const {
        const float C = 0.044194173824159216f * LOG2E;
        LAS f32x2* T = (LAS f32x2*)lds;
#pragma unroll
        for (int ai = 0; ai < 2; ++ai)
#pragma unroll
            for (int m = 0; m < 4; ++m) {
                float mx = -3.0e38f;
#pragma unroll
                for (int bj = 0; bj < 2; ++bj)
#pragma unroll
                    for (int n = 0; n < 2; ++n) { const f32x4 x = acc[ai][bj][m][n]; mx = fmaxf(mx, fmaxf(fmaxf(x[0], x[1]), fmaxf(x[2], x[3]))); }
                mx = fmaxf(mx, xor_lt32<16>(mx)); mx = max_xor32(mx);
                float s = 0.f;
#pragma unroll
                for (int bj = 0; bj < 2; ++bj)
#pragma unroll
                    for (int n = 0; n < 2; ++n) { const f32x4 x = acc[ai][bj][m][n];
#pragma unroll
                        for (int e = 0; e < 4; ++e) s += __builtin_amdgcn_exp2f((x[e] - mx) * C); }
                s += xor_lt32<16>(s); s = sum_xor32(s);
                if (fq == 0) T[(ai * HALF + wr * 64 + m * 16 + fr) * 4 + wc] = (f32x2){mx, s};
            }
        asm volatile("s_waitcnt lgkmcnt(0)" ::: "memory"); __builtin_amdgcn_s_barrier(); asm volatile("" ::: "memory");
        const int row0 = u.pm * BM + wr * 64 + fr, col0 = u.pn * BM + wc * 32 + 8 * fq;
#pragma unroll
        for (int ai = 0; ai < 2; ++ai)
#pragma unroll
            for (int m = 0; m < 4; ++m) { const int rl = ai * HALF + wr * 64 + m * 16 + fr;
                const f32x2 t0 = T[rl * 4 + 0], t1 = T[rl * 4 + 1], t2 = T[rl * 4 + 2], t3 = T[rl * 4 + 3];
                const float M = fmaxf(fmaxf(t0.x, t1.x), fmaxf(t2.x, t3.x));
                const float S = (t0.y * __builtin_amdgcn_exp2f((t0.x - M) * C) + t1.y * __builtin_amdgcn_exp2f((t1.x - M) * C)) + (t2.y * __builtin_amdgcn_exp2f((t2.x - M) * C) + t3.y * __builtin_amdgcn_exp2f((t3.x - M) * C));
                const float inv = __builtin_amdgcn_rcpf(S), MC = -M * C;
                bf16_t* rowp = P + (size_t)(row0 + ai * HALF + m * 16) * 1024 + col0;
#pragma unroll
                for (int bj = 0; bj < 2; ++bj) { f32x4 v0 = acc[ai][bj][m][0], v1 = acc[ai][bj][m][1];
#pragma unroll
                    for (int e = 0; e < 4; ++e) { v0[e] = __builtin_amdgcn_exp2f(fmaf(v0[e], C, MC)) * inv; v1[e] = __builtin_amdgcn_exp2f(fmaf(v1[e], C, MC)) * inv; }
                    st16bj(rowp, bj, pack8(v0, v1)); } }
        (void)wid; (void)lane;
    }
};
struct EpiGate2 {
    static constexpr bool PERM = true, AFTER_DRAIN = false, MIDK = true;
    const bf16_t* gates; bf16_t* merged;
    __device__ __forceinline__ void operator()(Acc& acc, const Unit& u, int wr, int wc, int fr, int fq) const {
        if (u.z == 0) {
        const int row0 = u.pm * BM + wr * 64 + fr, colt = u.pn * BM + wc * 32 + 8 * fq;
#pragma unroll
        for (int ai = 0; ai < 2; ++ai)
#pragma unroll
            for (int m = 0; m < 4; ++m) { const bf16_t* gp = gates + (size_t)(row0 + ai * HALF + m * 16) * 4096 + colt;
#pragma unroll
                for (int bj = 0; bj < 2; ++bj) { const u32x4 ga = *(const u32x4*)(gp + bj * HALF), gb = *(const u32x4*)(gp + 2048 + bj * HALF);
                    const f32x4 a0 = (f32x4){bflo(ga.x), bfhi(ga.x), bflo(ga.y), bfhi(ga.y)}, a1 = (f32x4){bflo(ga.z), bfhi(ga.z), bflo(ga.w), bfhi(ga.w)};
                    const f32x4 b0 = (f32x4){bflo(gb.x), bfhi(gb.x), bflo(gb.y), bfhi(gb.y)}, b1 = (f32x4){bflo(gb.z), bfhi(gb.z), bflo(gb.w), bfhi(gb.w)};
#pragma unroll
                    for (int e = 0; e < 4; ++e) { acc[ai][bj][m][0][e] *= a0[e] * __builtin_amdgcn_rcpf(fmaxf(b0[e], 1e-30f)); acc[ai][bj][m][1][e] *= a1[e] * __builtin_amdgcn_rcpf(fmaxf(b1[e], 1e-30f)); }
                    asm volatile("" : "+v"(acc[ai][bj][m][0]), "+v"(acc[ai][bj][m][1]) :: "memory"); } }
                return; }
        const int row0 = u.pm * BM + wr * 64 + fr, colt = u.pn * BM + wc * 32 + 8 * fq;
#pragma unroll
        for (int ai = 0; ai < 2; ++ai)
#pragma unroll
            for (int m = 0; m < 4; ++m) { const size_t row = (size_t)(row0 + ai * HALF + m * 16);
#pragma unroll
                for (int bj = 0; bj < 2; ++bj) { const int col = colt + bj * HALF; const u32x4 gb = *(const u32x4*)(gates + row * 4096 + 2048 + col);
                    f32x4 b0 = (f32x4){bflo(gb.x), bfhi(gb.x), bflo(gb.y), bfhi(gb.y)}, b1 = (f32x4){bflo(gb.z), bfhi(gb.z), bflo(gb.w), bfhi(gb.w)};
#pragma unroll
                    for (int e = 0; e < 4; ++e) { b0[e] = fmaxf(b0[e], 1e-30f); b1[e] = fmaxf(b1[e], 1e-30f); }
                    st16bj(merged + row * 2048 + colt, bj, pack8(acc[ai][bj][m][0] * b0, acc[ai][bj][m][1] * b1)); } }
    }
};
struct EpiF32 {
    static constexpr bool PERM = false, AFTER_DRAIN = false, MIDK = false;
    float* C; int ldc;
    __device__ __forceinline__ void operator()(const Acc& acc, const Unit& u, int wr, int wc, int fr, int fq) const {
        const int row0 = u.pm * BM + wr * 64 + fr, col0 = u.pn * BM + wc * 32 + 4 * fq;
#pragma unroll
        for (int ai = 0; ai < 2; ++ai)
#pragma unroll
            for (int m = 0; m < 4; ++m) { float* rowp = C + (size_t)(row0 + ai * HALF + m * 16) * ldc + col0;
#pragma unroll
                for (int bj = 0; bj < 2; ++bj)
#pragma unroll
                    for (int n = 0; n < 2; ++n) *(f32x4*)(rowp + bj * HALF + n * 16) = acc[ai][bj][m][n]; }
    }
};
struct EpiBf16 {
    static constexpr bool PERM = true, AFTER_DRAIN = false, MIDK = false;
    bf16_t* O; int ldc;
    __device__ __forceinline__ void operator()(const Acc& acc, const Unit& u, int wr, int wc, int fr, int fq) const {
        const int row0 = u.pm * BM + wr * 64 + fr, col0 = u.pn * BM + wc * 32 + 8 * fq;
#pragma unroll
        for (int ai = 0; ai < 2; ++ai)
#pragma unroll
            for (int m = 0; m < 4; ++m) { bf16_t* rowp = O + (size_t)(row0 + ai * HALF + m * 16) * ldc + col0;
#pragma unroll
                for (int bj = 0; bj < 2; ++bj) st16bj(rowp, bj, pack8(acc[ai][bj][m][0], acc[ai][bj][m][1])); }
    }
};
struct EpiMemKv {
    static constexpr bool PERM = true, AFTER_DRAIN = false, MIDK = false;
    bf16_t* Kmem;
    __device__ __forceinline__ void operator()(const Acc& acc, const Unit& u, int wr, int wc, int fr, int fq) const {
        bf16_t* O = Kmem + (size_t)(u.z & 1) * ((RA_VMEM - RA_KMEM) / 2) + (size_t)(u.z >> 1) * (1024 * 2048);
        const int row0 = u.pm * BM + wr * 64 + fr, col0 = u.pn * BM + wc * 32 + 8 * fq;
#pragma unroll
        for (int ai = 0; ai < 2; ++ai)
#pragma unroll
            for (int m = 0; m < 4; ++m) { bf16_t* rowp = O + (size_t)(row0 + ai * HALF + m * 16) * 2048 + col0;
#pragma unroll
                for (int bj = 0; bj < 2; ++bj) st16bj(rowp, bj, pack8(acc[ai][bj][m][0], acc[ai][bj][m][1])); }
    }
};
struct EpiFold {
    static constexpr bool PERM = true, AFTER_DRAIN = false, MIDK = false;
    bf16_t* Wall;
    __device__ __forceinline__ void operator()(const Acc& acc, const Unit& u, int wr, int wc, int fr, int fq) const {
        const int ty = u.z & 1, ldc = ty ? 1024 : 2048;
        bf16_t* O = Wall + (size_t)(u.z >> 1) * W_LAYER + WO_WK + (size_t)ty * ((WO_VW - WO_WK) + (size_t)(u.pn >> 2) * (2048 * 1024));
        const int row0 = u.pm * BM + wr * 64 + fr, col0 = (ty ? (u.pn & 3) : u.pn) * BM + wc * 32 + 8 * fq;
#pragma unroll
        for (int ai = 0; ai < 2; ++ai)
#pragma unroll
            for (int m = 0; m < 4; ++m) { bf16_t* rowp = O + (size_t)(row0 + ai * HALF + m * 16) * ldc + col0;
#pragma unroll
                for (int bj = 0; bj < 2; ++bj) st16bj(rowp, bj, pack8(acc[ai][bj][m][0], acc[ai][bj][m][1])); }
    }
};

struct GateOrder {
    StaticOrder S;
    __device__ __forceinline__ bool next(int i, Unit& u) const { if (!S.next(i >> 1, u)) return false; u.z = i & 1; u.aoff += (unsigned)(i & 1) * 1024u; u.boff += (unsigned)(i & 1) * 1024u; return true; }
    __device__ __forceinline__ void a_ready(const Unit&) const {}
    __device__ __forceinline__ void done(const Unit&) const {}
};
struct MemKvOrder {
    int G, c;
    __device__ __forceinline__ bool next(int i, Unit& u) const {
        const int L = i * G + c; if (L >= 256) return false;
        const int ly = L >> 6, r = L & 63, ty = r >> 5, q = r & 31;
        u.pm = q >> 3; u.pn = q & 7; u.z = ly * 2 + ty;
        u.aoff = (unsigned)(RA_MEMN / 2) + (unsigned)ly * (1024u * 2048u) + (unsigned)u.pm * (256u * 2048u);
        u.boff = (unsigned)(RA_KVXT / 2) + (unsigned)ly * (4096u * 2048u) + (unsigned)(ty * 2048 + u.pn * 256) * 2048u; return true;
    }
    __device__ __forceinline__ void a_ready(const Unit&) const {}
    __device__ __forceinline__ void done(const Unit&) const {}
};
struct FoldOrder {
    int G, c;
    __device__ __forceinline__ bool next(int i, Unit& u) const {
        const int L = i * G + c; if (L >= 1024) return false;
        const int ly = L >> 8, r = L & 255, ty = r >> 7, q = r & 127; u.z = ly * 2 + ty;
        if (ty == 0) { u.pm = q >> 3; u.pn = q & 7; const unsigned b = (unsigned)u.pm >> 2, h = (unsigned)u.pm & 3u;
            u.aoff = (unsigned)(RA_KMEM / 2) + (unsigned)ly * (1024u * 2048u) + b * (256u * 2048u) + h * 512u;
            u.boff = (unsigned)(RA_QXP / 2) + (unsigned)ly * (2048u * 2048u) + (unsigned)u.pn * (256u * 2048u) + h * 512u; }
        else { u.pm = q >> 4; u.pn = q & 15; const unsigned b = (unsigned)u.pn >> 2, h = (unsigned)u.pn & 3u;
            u.aoff = (unsigned)(RA_OXT / 2) + (unsigned)ly * (2048u * 2048u) + (unsigned)u.pm * (256u * 2048u) + h * 512u;
            u.boff = (unsigned)(RA_VMEM / 2) + (unsigned)ly * (1024u * 2048u) + b * (256u * 2048u) + h * 512u; }
        return true;
    }
    __device__ __forceinline__ void a_ready(const Unit&) const {}
    __device__ __forceinline__ void done(const Unit&) const {}
};
struct CrossSOrder {
    int G, c;
    __device__ __forceinline__ bool next(int i, Unit& u) const {
        const int L = i * G + c; if (L >= 256) return false;
        const int w = (L & 7) * 32 + (L >> 3);
        u.pm = w >> 2; u.pn = w & 3; u.z = 0; const unsigned b = (unsigned)u.pm >> 4;
        u.aoff = (unsigned)u.pm * (256u * 2048u); u.boff = (b * 1024u + (unsigned)u.pn * 256u) * 2048u; return true;
    }
    __device__ __forceinline__ void a_ready(const Unit&) const {}
    __device__ __forceinline__ void done(const Unit&) const {}
};
struct CrossYOrder {
    int G, c;
    __device__ __forceinline__ bool next(int i, Unit& u) const {
        const int L = i * G + c; if (L >= 512) return false;
        const int w = (L & 7) * 64 + (L >> 3);
        u.pm = w >> 3; u.pn = w & 7; u.z = 0; const unsigned b = (unsigned)u.pm >> 4;
        u.aoff = (unsigned)u.pm * (256u * 1024u); u.boff = (b * 2048u + (unsigned)u.pn * 256u) * 1024u; return true;
    }
    __device__ __forceinline__ void a_ready(const Unit&) const {}
    __device__ __forceinline__ void done(const Unit&) const {}
};
}
namespace att {
constexpr int NW = 8, QBLK = 32, KVBLK = 64;
constexpr float THR = 8.f;
constexpr int SHM_V = KVBLK * 128 * 2;
constexpr int OFF_V = 0, OFF_K = 2 * SHM_V, OFF_QL = 81920  , OFF_WS = 122880;
#define SBAR() __builtin_amdgcn_sched_barrier(0)
__device__ __forceinline__ int crow(int r, int hi) { return (r & 3) + 8 * (r >> 2) + 4 * hi; }

__device__ __forceinline__ void partialSM(f32x16& p0, f32x16& p1, float& m_reg, float& alpha, const float C, const bool valid) {
    if (!valid) {
#pragma unroll
        for (int r = 0; r < 16; ++r) { p0[r] = 0.f; p1[r] = 0.f; }
        alpha = 1.f; return; }
    float pmax = p0[0];
#pragma unroll
    for (int r = 1; r < 16; ++r) pmax = fmaxf(pmax, p0[r]);
#pragma unroll
    for (int r = 0; r < 16; ++r) pmax = fmaxf(pmax, p1[r]);
    { auto rr = __builtin_amdgcn_permlane32_swap(__float_as_uint(pmax), __float_as_uint(pmax), false, false);
      pmax = fmaxf(__uint_as_float(rr[0]), __uint_as_float(rr[1])); }
    float mn;
    if (__builtin_expect(__all((pmax - m_reg) * C <= THR * LOG2E), 1)) { mn = m_reg; alpha = 1.f; }
    else { mn = fmaxf(m_reg, pmax); alpha = __builtin_amdgcn_exp2f((m_reg - mn) * C); m_reg = mn; }
    const float mnC = -mn * C;
#pragma unroll
    for (int r = 0; r < 16; ++r) p0[r] = fmaf(p0[r], C, mnC);
#pragma unroll
    for (int r = 0; r < 16; ++r) p1[r] = fmaf(p1[r], C, mnC);
#pragma unroll
    for (int r = 0; r < 16; ++r) p0[r] = __builtin_amdgcn_exp2f(p0[r]);
}
__device__ __forceinline__ void finishSM(f32x16& p0, f32x16& p1, float alpha, float& l_reg, bf16x8& pa0, bf16x8& pa1, bf16x8& pa2, bf16x8& pa3, const bool valid) {
    if (valid) {
#pragma unroll
        for (int r = 0; r < 16; ++r) p1[r] = __builtin_amdgcn_exp2f(p1[r]);
    }
    f32x2 ps2 = (f32x2){p0[0], p0[1]};
#pragma unroll
    for (int r = 1; r < 8; ++r) ps2 += (f32x2){p0[2 * r], p0[2 * r + 1]};
#pragma unroll
    for (int r = 0; r < 8; ++r) ps2 += (f32x2){p1[2 * r], p1[2 * r + 1]};
    float ps = ps2.x + ps2.y;
    { auto rr = __builtin_amdgcn_permlane32_swap(__float_as_uint(ps), __float_as_uint(ps), false, false);
      ps = __uint_as_float(rr[0]) + __uint_as_float(rr[1]); }
    l_reg = l_reg * alpha + ps;
#define PK4(P, BASE, OUT) do { unsigned a0 = cvt_pk_bf16(P[BASE + 0], P[BASE + 1]), a1 = cvt_pk_bf16(P[BASE + 2], P[BASE + 3]);   \
    unsigned b0 = cvt_pk_bf16(P[BASE + 4], P[BASE + 5]), b1 = cvt_pk_bf16(P[BASE + 6], P[BASE + 7]);                              \
    auto r0 = __builtin_amdgcn_permlane32_swap(a0, b0, false, false); auto r1 = __builtin_amdgcn_permlane32_swap(a1, b1, false, false); \
    u32x4 w = {r0[0], r1[0], r0[1], r1[1]}; OUT = __builtin_bit_cast(bf16x8, w); } while (0)
    PK4(p0, 0, pa0); PK4(p0, 8, pa1); PK4(p1, 0, pa2); PK4(p1, 8, pa3);
#undef PK4
}
template <int NQ, int NL>
__device__ __forceinline__ void qkt(f32x16& p0, f32x16& p1, const LAS unsigned char* Ks, const bf16x8* qr, const LAS unsigned char* ql, int r32, int hi) {
    constexpr int STRIDE = NQ * 32;
    const int sw = (r32 >> 1) & 7;
    const LAS unsigned char* k0p = Ks + r32 * STRIDE; const LAS unsigned char* k1p = k0p + 32 * STRIDE;
#pragma unroll
    for (int r = 0; r < 16; ++r) { p0[r] = 0.f; p1[r] = 0.f; }
#pragma unroll
    for (int d0 = 0; d0 < NQ; ++d0) { const int off = ((2 * d0 + hi) ^ sw) << 4;
        const bf16x8 b0 = *(const LAS bf16x8*)(k0p + off), b1 = *(const LAS bf16x8*)(k1p + off);
        bf16x8 qf; if (d0 < NQ - NL) qf = qr[d0]; else qf = *(const LAS bf16x8*)(ql + (d0 - (NQ - NL)) * 1024);
        p0 = __builtin_amdgcn_mfma_f32_32x32x16_bf16(b0, qf, p0, 0, 0, 0);
        p1 = __builtin_amdgcn_mfma_f32_32x32x16_bf16(b1, qf, p1, 0, 0, 0); }
}
__device__ __forceinline__ int v_st(int k, int c) { const int kk = (k & ~0xC) | ((k & 4) << 1) | ((k & 8) >> 1); return ((kk >> 3) * 4 + (c >> 5)) * 512 + ((kk & 7) * 32 + (c & 31)) * 2; }
__device__ __forceinline__ int v_rd_base(int lane) { return ((lane & 3) << 3) | (((lane >> 2) & 3) << 6) | (((lane >> 4) & 1) << 5) | (((lane >> 5) & 1) << 8); }
constexpr int v_rd_off(int d0, int ks, int half) { return d0 * 512 + ks * 4096 + half * 2048; }
template <int OFF> __device__ __forceinline__ s16x4 tr_read(int vb) {
    s16x4 r; asm volatile("ds_read_b64_tr_b16 %0, %1 offset:%2" : "=&v"(r) : "v"(vb), "i"(OFF) : "memory"); return r;
}
template <int D0> __device__ __forceinline__ void pv_one(f32x16& od, int vb, bf16x8 pa0, bf16x8 pa1, bf16x8 pa2, bf16x8 pa3) {
    const s16x4 l0 = tr_read<v_rd_off(D0, 0, 0)>(vb), h0 = tr_read<v_rd_off(D0, 0, 1)>(vb), l1 = tr_read<v_rd_off(D0, 1, 0)>(vb), h1 = tr_read<v_rd_off(D0, 1, 1)>(vb);
    const s16x4 l2 = tr_read<v_rd_off(D0, 2, 0)>(vb), h2 = tr_read<v_rd_off(D0, 2, 1)>(vb), l3 = tr_read<v_rd_off(D0, 3, 0)>(vb), h3 = tr_read<v_rd_off(D0, 3, 1)>(vb);
    asm volatile("s_waitcnt lgkmcnt(0)" ::: "memory"); SBAR();
#define PK(L, H) (bf16x8){L[0], L[1], L[2], L[3], H[0], H[1], H[2], H[3]}
    od = __builtin_amdgcn_mfma_f32_32x32x16_bf16(pa0, PK(l0, h0), od, 0, 0, 0);
    od = __builtin_amdgcn_mfma_f32_32x32x16_bf16(pa1, PK(l1, h1), od, 0, 0, 0);
    od = __builtin_amdgcn_mfma_f32_32x32x16_bf16(pa2, PK(l2, h2), od, 0, 0, 0);
    od = __builtin_amdgcn_mfma_f32_32x32x16_bf16(pa3, PK(l3, h3), od, 0, 0, 0);
#undef PK
}
__device__ __forceinline__ void pv_d0(f32x16* o, int vb, bf16x8 pa0, bf16x8 pa1, bf16x8 pa2, bf16x8 pa3) {
    pv_one<0>(o[0], vb, pa0, pa1, pa2, pa3); pv_one<1>(o[1], vb, pa0, pa1, pa2, pa3); pv_one<2>(o[2], vb, pa0, pa1, pa2, pa3); pv_one<3>(o[3], vb, pa0, pa1, pa2, pa3);
}

template <int NQ, bool MLA>
__device__ __forceinline__ void attn_pass(const bf16_t* __restrict__ Qb, const int ldq, const bf16_t* __restrict__ Kh, const bf16_t* __restrict__ Kpe, const bf16_t* __restrict__ Vh,
                                          const int NT, const float C, LAS unsigned char* lds, f32x16 (&o)[4]) {
    constexpr int STRIDE = NQ * 32, SHM_K = KVBLK * STRIDE;
    int tid = threadIdx.x; asm volatile("" : "+v"(tid));
    const int wid = __builtin_amdgcn_readfirstlane(tid >> 6), lane = tid & 63, r32 = lane & 31, hi = lane >> 5;
    LAS unsigned char* V_lds = lds + OFF_V; LAS unsigned char* K_lds = lds + OFF_K;
    LAS float* wsf = (LAS float*)(lds + OFF_WS) + wid * 64; LAS float* li_l = wsf; LAS float* al_l = wsf + 32;
    constexpr int NL = MLA ? 4 : 0;
    LAS unsigned char* ql = lds + OFF_QL + wid * 4096 + lane * 16;
    float m_reg = -1e30f, l_reg = 0.f; bf16x8 qr[NQ - NL];
#pragma unroll
    for (int d = 0; d < 4; ++d)
#pragma unroll
        for (int r = 0; r < 16; ++r) o[d][r] = 0.f;
    { const bf16_t* Qw = Qb + (size_t)(wid * QBLK + r32) * ldq + hi * 8;
#pragma unroll
      for (int d0 = 0; d0 < NQ - NL; ++d0) qr[d0] = *(const bf16x8*)(Qw + d0 * 16);
#pragma unroll
      for (int d0 = NQ - NL; d0 < NQ; ++d0) *(LAS bf16x8*)(ql + (d0 - (NQ - NL)) * 1024) = *(const bf16x8*)(Qw + d0 * 16); }
    const int sr = tid >> 4, sc = (tid & 15) * 8, vst0 = v_st(sr, sc), vst1 = v_st(32 + sr, sc);
    const int kr = tid >> 3, kc = tid & 7;
    int kst0, kst1, kst2;
    if (MLA) { kst0 = sr * STRIDE + (((tid & 15) ^ ((sr >> 1) & 7)) << 4); kst1 = kst0 + 32 * STRIDE; kst2 = kr * STRIDE + (((16 + kc) ^ ((kr >> 1) & 7)) << 4); }
    else { kst0 = kr * STRIDE + ((kc ^ ((kr >> 1) & 7)) << 4); kst1 = 0; kst2 = 0; }
    const int vb0 = (int)(unsigned)(uintptr_t)V_lds + v_rd_base(lane);
    const int jw = NT - 4 + (wid >> 1);
    bf16x8 vs0, vs1, ks0, ks1, ks2;
#define SLOAD(k0) do { vs0 = *(const bf16x8*)(Vh + (size_t)((k0) + sr) * 1024 + sc); vs1 = *(const bf16x8*)(Vh + (size_t)((k0) + 32 + sr) * 1024 + sc); \
    if (MLA) { ks0 = *(const bf16x8*)(Kh + (size_t)((k0) + sr) * 1024 + sc); ks1 = *(const bf16x8*)(Kh + (size_t)((k0) + 32 + sr) * 1024 + sc); ks2 = *(const bf16x8*)(Kpe + (size_t)((k0) + kr) * 64 + kc * 8); } \
    else { ks0 = *(const bf16x8*)(Kh + (size_t)((k0) + kr) * 1024 + kc * 8); } } while (0)
#define SWRITE(b) do { *(LAS bf16x8*)(V_lds + (b) * SHM_V + vst0) = vs0; *(LAS bf16x8*)(V_lds + (b) * SHM_V + vst1) = vs1; \
    *(LAS bf16x8*)(K_lds + (b) * SHM_K + kst0) = ks0; if (MLA) { *(LAS bf16x8*)(K_lds + (b) * SHM_K + kst1) = ks1; *(LAS bf16x8*)(K_lds + (b) * SHM_K + kst2) = ks2; } } while (0)
#define RESC(a) do { if (__any((a) < 1.f)) { if (hi == 0) al_l[r32] = (a); asm volatile("s_waitcnt lgkmcnt(0)" ::: "memory"); \
    _Pragma("unroll") for (int d = 0; d < 4; ++d) _Pragma("unroll") for (int r = 0; r < 16; ++r) o[d][r] *= al_l[crow(r, hi)]; } } while (0)
    f32x16 p0, p1; float al; bf16x8 pa0, pa1, pa2, pa3;
    SLOAD(0); SWRITE(0); __syncthreads();
    SLOAD(KVBLK);
    for (int j = 0; j < NT; ++j) {
        const int bsel = j & 1;
        if (j <= jw) {
            SBAR(); qkt<NQ, NL>(p0, p1, K_lds + bsel * SHM_K, qr, ql, r32, hi);
            partialSM(p0, p1, m_reg, al, C, true);
            RESC(al);
            finishSM(p0, p1, al, l_reg, pa0, pa1, pa2, pa3, true); SBAR();
            pv_d0(o, vb0 + bsel * SHM_V, pa0, pa1, pa2, pa3);
        }
        if (j + 1 < NT) {
#ifdef DIAG_XBAR
            __syncthreads();
#endif
            SWRITE(bsel ^ 1); __syncthreads();
            if (j + 2 < NT) SLOAD((j + 2) * KVBLK);
        }
    }
    __syncthreads();
    if (hi == 0) li_l[r32] = l_reg; asm volatile("s_waitcnt lgkmcnt(0)" ::: "memory");
#pragma unroll
    for (int r = 0; r < 16; ++r) { const float rl = __builtin_amdgcn_rcpf(li_l[crow(r, hi)]);
#pragma unroll
        for (int d = 0; d < 4; ++d) o[d][r] *= rl; }
    asm volatile("s_waitcnt lgkmcnt(0)" ::: "memory");
#undef SLOAD
#undef SWRITE
#undef RESC
}

__device__ __forceinline__ void glds16(const void* gsrc, unsigned lds_dst) { unsigned keep;
    asm volatile("s_mov_b32 %0, m0\n\ts_mov_b32 m0, %2\n\ts_nop 0\n\tglobal_load_lds_dwordx4 %1, off\n\ts_mov_b32 m0, %0" : "=&s"(keep) : "v"(gsrc), "s"(lds_dst) : "memory"); }
__host__ __device__ __forceinline__ int vq_k(int q) { const int sub = q >> 5, kk = (sub >> 2) * 8 + ((q & 31) >> 2); return (kk & ~0xC) | ((kk & 4) << 1) | ((kk & 8) >> 1); }
__host__ __device__ __forceinline__ int vq_c(int q) { return ((q >> 5) & 3) * 32 + (q & 3) * 8; }
constexpr int P2_V = 0, P2_K = 32768, P2_KP = 65536;
#define WAITBAR() asm volatile("s_waitcnt vmcnt(0) lgkmcnt(0)\n\ts_barrier" ::: "memory")

template <bool MLA>
__device__ __forceinline__ void qkt2(f32x16& p0, f32x16& p1, const LAS unsigned char* Kb, const LAS unsigned char* Kpb, const bf16x8* qr, const LAS unsigned char* ql, int r32, int hi) {
#pragma unroll
    for (int r = 0; r < 16; ++r) { p0[r] = 0.f; p1[r] = 0.f; }
    if (MLA) {
        const LAS unsigned char* k0p = Kb + r32 * 256; const LAS unsigned char* k1p = k0p + 32 * 256; const int sw = r32 & 15;
#pragma unroll
        for (int d0 = 0; d0 < 8; ++d0) { const int off = ((2 * d0 + hi) ^ sw) << 4;
            const bf16x8 b0 = *(const LAS bf16x8*)(k0p + off), b1 = *(const LAS bf16x8*)(k1p + off);
            p0 = __builtin_amdgcn_mfma_f32_32x32x16_bf16(b0, qr[d0], p0, 0, 0, 0); p1 = __builtin_amdgcn_mfma_f32_32x32x16_bf16(b1, qr[d0], p1, 0, 0, 0); }
        const LAS unsigned char* e0p = Kpb + r32 * 128; const LAS unsigned char* e1p = e0p + 32 * 128; const int sw2 = (r32 >> 1) & 7;
#pragma unroll
        for (int d0 = 0; d0 < 4; ++d0) { const int off = ((2 * d0 + hi) ^ sw2) << 4;
            const bf16x8 b0 = *(const LAS bf16x8*)(e0p + off), b1 = *(const LAS bf16x8*)(e1p + off), qf = *(const LAS bf16x8*)(ql + d0 * 1024);
            p0 = __builtin_amdgcn_mfma_f32_32x32x16_bf16(b0, qf, p0, 0, 0, 0); p1 = __builtin_amdgcn_mfma_f32_32x32x16_bf16(b1, qf, p1, 0, 0, 0); }
    } else {
        const LAS unsigned char* k0p = Kb + r32 * 128; const LAS unsigned char* k1p = k0p + 32 * 128; const int sw = (r32 >> 1) & 7;
#pragma unroll
        for (int d0 = 0; d0 < 4; ++d0) { const int off = ((2 * d0 + hi) ^ sw) << 4;
            const bf16x8 b0 = *(const LAS bf16x8*)(k0p + off), b1 = *(const LAS bf16x8*)(k1p + off);
            p0 = __builtin_amdgcn_mfma_f32_32x32x16_bf16(b0, qr[d0], p0, 0, 0, 0); p1 = __builtin_amdgcn_mfma_f32_32x32x16_bf16(b1, qr[d0], p1, 0, 0, 0); }
    }
}
template <bool MLA>
__device__ __forceinline__ void attn_pass2(const bf16_t* __restrict__ Qb, const int ldq, const bf16_t* __restrict__ Kh, const bf16_t* __restrict__ Kpe, const bf16_t* __restrict__ Vh,
                                           const int NT, const float C, LAS unsigned char* lds, f32x16 (&o)[4]) {
    constexpr int NQR = MLA ? 8 : 4, SHM_K2 = MLA ? 16384 : 8192;
    int tid = threadIdx.x; asm volatile("" : "+v"(tid));
    const int wid = __builtin_amdgcn_readfirstlane(tid >> 6), lane = tid & 63, r32 = lane & 31, hi = lane >> 5;
    LAS unsigned char* V_lds = lds + P2_V; LAS unsigned char* K_lds = lds + P2_K; LAS unsigned char* Kp_lds = lds + P2_KP;
    LAS float* wsf = (LAS float*)(lds + OFF_WS) + wid * 64; LAS float* li_l = wsf; LAS float* al_l = wsf + 32;
    LAS unsigned char* ql = lds + OFF_QL + wid * 4096 + lane * 16;
    const unsigned ldsb = (unsigned)(uintptr_t)lds;
    const unsigned dV = ldsb + P2_V + wid * 1024, dK = ldsb + P2_K + wid * 1024, dP = ldsb + P2_KP + wid * 1024;
#define LANEOFFS() int t2_ = tid; asm volatile("" : "+v"(t2_)); const int q0_ = t2_ & 511; \
    const unsigned voV0 = (unsigned)(vq_k(q0_) * 1024 + vq_c(q0_)) * 2u; \
    const unsigned voK0 = MLA ? (unsigned)((q0_ >> 4) * 1024 + (((q0_ & 15) ^ ((q0_ >> 4) & 15)) * 8)) * 2u : (unsigned)((q0_ >> 3) * 1024 + (((q0_ & 7) ^ ((q0_ >> 4) & 7)) * 8)) * 2u; \
    const unsigned voP = (unsigned)((q0_ >> 3) * 64 + (((q0_ & 7) ^ ((q0_ >> 4) & 7)) * 8)) * 2u; (void)voV0; (void)voK0; (void)voP
#define DMA_K(t, b) do { LANEOFFS(); const char* kb_ = (const char*)Kh + (size_t)(t) * (KVBLK * 1024 * 2); glds16(kb_ + voK0, (unsigned)__builtin_amdgcn_readfirstlane(dK + (b) * SHM_K2)); \
    if (MLA) { glds16(kb_ + voK0 + 65536, (unsigned)__builtin_amdgcn_readfirstlane(dK + (b) * SHM_K2 + 8192)); glds16((const char*)Kpe + (size_t)(t) * (KVBLK * 64 * 2) + voP, (unsigned)__builtin_amdgcn_readfirstlane(dP + (b) * 8192)); } } while (0)
#define DMA_V(t, b) do { LANEOFFS(); const char* vb_ = (const char*)Vh + (size_t)(t) * (KVBLK * 1024 * 2); glds16(vb_ + voV0, (unsigned)__builtin_amdgcn_readfirstlane(dV + (b) * SHM_V)); glds16(vb_ + voV0 + 65536, (unsigned)__builtin_amdgcn_readfirstlane(dV + (b) * SHM_V + 8192)); } while (0)
    DMA_K(0, 0);
    float m_reg = -1e30f, l_reg = 0.f; bf16x8 qr[NQR];
#pragma unroll
    for (int d = 0; d < 4; ++d)
#pragma unroll
        for (int r = 0; r < 16; ++r) o[d][r] = 0.f;
    { const bf16_t* Qw = Qb + (size_t)(wid * QBLK + r32) * ldq + hi * 8;
#pragma unroll
      for (int d0 = 0; d0 < NQR; ++d0) qr[d0] = *(const bf16x8*)(Qw + d0 * 16);
      if (MLA) {
#pragma unroll
          for (int d0 = 0; d0 < 4; ++d0) *(LAS bf16x8*)(ql + d0 * 1024) = *(const bf16x8*)(Qw + (8 + d0) * 16); } }
    const int vb0 = (int)(ldsb + P2_V) + v_rd_base(lane);
    const int jw = NT - 4 + (wid >> 1);
#define RESC2(a) do { if (__any((a) < 1.f)) { if (hi == 0) al_l[r32] = (a); asm volatile("s_waitcnt lgkmcnt(0)" ::: "memory"); \
    _Pragma("unroll") for (int d = 0; d < 4; ++d) _Pragma("unroll") for (int r = 0; r < 16; ++r) o[d][r] *= al_l[crow(r, hi)]; } } while (0)
    f32x16 pA0, pA1, pB0, pB1; float alA = 1.f, alB = 1.f; bf16x8 pa0, pa1, pa2, pa3;
    WAITBAR();
    DMA_K(1, 1); DMA_V(0, 0);
    SBAR(); qkt2<MLA>(pA0, pA1, K_lds, Kp_lds, qr, ql, r32, hi); partialSM(pA0, pA1, m_reg, alA, C, true);
    WAITBAR();
#define STEP2(PX0, PX1, ALX, PY0, PY1, ALY, KOFF, KPOFF, VOFF, VQ, VP) do { \
        SBAR(); if (VQ) qkt2<MLA>(PX0, PX1, K_lds + (KOFF), Kp_lds + (KPOFF), qr, ql, r32, hi); \
        if (VP) { finishSM(PY0, PY1, ALY, l_reg, pa0, pa1, pa2, pa3, true); SBAR(); pv_d0(o, vb0 + (VOFF), pa0, pa1, pa2, pa3); } \
        partialSM(PX0, PX1, m_reg, ALX, C, VQ); RESC2(ALX); WAITBAR(); } while (0)
    int j = 1;
    for (; j + 1 <= NT - 4; j += 2) {
        DMA_K(j + 1, 0); DMA_V(j, 1);
        STEP2(pB0, pB1, alB, pA0, pA1, alA, SHM_K2, 8192, 0, true, true);
        DMA_K(j + 2, 1); DMA_V(j + 1, 0);
        STEP2(pA0, pA1, alA, pB0, pB1, alB, 0, 0, SHM_V, true, true);
    }
    {
        const bool vj = (j <= jw), vn = (j + 1 <= jw);
        DMA_K(j + 1, 0); DMA_V(j, 1);
        STEP2(pB0, pB1, alB, pA0, pA1, alA, SHM_K2, 8192, 0, vj, true);
        DMA_K(j + 2, 1); DMA_V(j + 1, 0);
        STEP2(pA0, pA1, alA, pB0, pB1, alB, 0, 0, SHM_V, vn, vj);
    }
    {
        const bool vp = (NT - 2 <= jw), vj = (NT - 1 <= jw);
        DMA_V(NT - 1, 1);
        SBAR(); if (vj) qkt2<MLA>(pB0, pB1, K_lds + SHM_K2, Kp_lds + 8192, qr, ql, r32, hi);
        if (vp) { finishSM(pA0, pA1, alA, l_reg, pa0, pa1, pa2, pa3, true); SBAR(); pv_d0(o, vb0, pa0, pa1, pa2, pa3); }
        partialSM(pB0, pB1, m_reg, alB, C, vj);
        RESC2(alB);
        WAITBAR();
        if (vj) { finishSM(pB0, pB1, alB, l_reg, pa0, pa1, pa2, pa3, true); SBAR(); pv_d0(o, vb0 + SHM_V, pa0, pa1, pa2, pa3); }
    }
    WAITBAR();
    if (hi == 0) li_l[r32] = l_reg; asm volatile("s_waitcnt lgkmcnt(0)" ::: "memory");
#pragma unroll
    for (int r = 0; r < 16; ++r) { const float rl = __builtin_amdgcn_rcpf(li_l[crow(r, hi)]);
#pragma unroll
        for (int d = 0; d < 4; ++d) o[d][r] *= rl; }
    asm volatile("s_waitcnt lgkmcnt(0)" ::: "memory");
#undef DMA_K
#undef DMA_V
#undef LANEOFFS
#undef RESC2
#undef STEP2
}
#undef WAITBAR
#undef SBAR
}
typedef GAS unsigned gu32;
#define RLX_AGENT __ATOMIC_RELAXED, __HIP_MEMORY_SCOPE_AGENT
#define LDS_WAIT() asm volatile("s_waitcnt lgkmcnt(0)" ::: "memory")
#define VM_WAIT() asm volatile("s_waitcnt vmcnt(0)" ::: "memory")
#define XB_TMO      128
#define XB_XCNT(j)  (256  + 64 * (j))
#define XB_XSUB(j)  (1280 + 64 * (j))
#define XB_XGEN(j)  (2304 + 64 * (j))
#define XB_TOP      3328
#define XB_TOPGEN   3392
#define XCD_BAR_WORDS 3456
#define XB_SPIN_CAP (1u << 18)

__device__ __forceinline__ unsigned xb_ld(unsigned* p)              { return __hip_atomic_load(p, __ATOMIC_RELAXED, __HIP_MEMORY_SCOPE_AGENT); }
__device__ __forceinline__ unsigned xb_add(unsigned* p, unsigned v) { return __hip_atomic_fetch_add(p, v, __ATOMIC_RELAXED, __HIP_MEMORY_SCOPE_AGENT); }
__device__ __forceinline__ unsigned xb_xcc_id() { return (unsigned)__builtin_amdgcn_s_getreg((3 << 11) | 20) & 0xFu; }
#define XB_SPIN(cond, bar) do { unsigned _sp = 0; while (cond) { __builtin_amdgcn_s_sleep(1); \
    if ((++_sp & 255u) == 0u) { if (xb_ld(&(bar)[XB_TMO])) break; if (_sp > XB_SPIN_CAP) { atomicAdd(&(bar)[XB_TMO], 1u); break; } } } } while (0)

struct XcdBarrier {
    unsigned* bar; unsigned x;
    volatile LAS unsigned* st;
};
__device__ __forceinline__ XcdBarrier xcd_barrier_post(unsigned* bar, volatile LAS unsigned* st) {
    XcdBarrier b; b.bar = bar; b.x = xb_xcc_id(); b.st = st;
    if (threadIdx.x == 0) (void)xb_add(&bar[XB_XCNT(b.x)], 1u);
    return b;
}
__device__ __forceinline__ void xcd_barrier_complete(unsigned* bar, unsigned x, unsigned& nloc, unsigned& nx) {
    const unsigned G = gridDim.x * gridDim.y * gridDim.z;
    unsigned sum, cnt, mine, sp = 0u;
    for (;;) {
        sum = 0u; cnt = 0u; mine = 0u;
#pragma unroll
        for (unsigned j = 0; j < 16; ++j) { const unsigned c = xb_ld(&bar[XB_XCNT(j)]); sum += c; cnt += (c > 0u) ? 1u : 0u; mine = (j == x) ? c : mine; }
        if (sum == G) break;
        __builtin_amdgcn_s_sleep(1);
        if ((++sp & 255u) == 0u) { if (xb_ld(&bar[XB_TMO])) break; if (sp > XB_SPIN_CAP) { atomicAdd(&bar[XB_TMO], 1u); break; } }
    }
    nloc = mine > 0u ? mine : 1u; nx = cnt > 0u ? cnt : 1u;
}
__device__ __forceinline__ void xcd_barrier(const XcdBarrier& b) {
    asm volatile("s_waitcnt vmcnt(0)" ::: "memory");
    __syncthreads();
    if (threadIdx.x == 0) {
        unsigned* bar = b.bar;
        __builtin_amdgcn_s_waitcnt(0);
        unsigned nloc = b.st[0], nx = b.st[1];
        if (nloc == 0u) { xcd_barrier_complete(bar, b.x, nloc, nx); b.st[0] = nloc; b.st[1] = nx; }
#ifdef PROBE_BARWAIT
        const unsigned long long pbw_t0 = __builtin_amdgcn_s_memrealtime();
#endif
        const unsigned old = xb_add(&bar[XB_XSUB(b.x)], 1u);
        const unsigned gen = old / nloc;
        if (old + 1u == (gen + 1u) * nloc) {
            __builtin_amdgcn_fence(__ATOMIC_RELEASE, "agent");
            asm volatile("s_waitcnt vmcnt(0)" ::: "memory");
            const unsigned og = xb_add(&bar[XB_TOP], 1u);
            const unsigned tg = og / nx;
            if (og + 1u == (tg + 1u) * nx) xb_add(&bar[XB_TOPGEN], 1u);
            else XB_SPIN(xb_ld(&bar[XB_TOPGEN]) == tg, bar);
            __builtin_amdgcn_fence(__ATOMIC_ACQUIRE, "agent");
            xb_add(&bar[XB_XGEN(b.x)], 1u);
            asm volatile("s_waitcnt vmcnt(0)" ::: "memory");
        } else {
            XB_SPIN(xb_ld(&bar[XB_XGEN(b.x)]) == gen, bar);
            __builtin_amdgcn_fence(__ATOMIC_ACQUIRE, "agent");
            asm volatile("s_waitcnt vmcnt(0)" ::: "memory");
        }
#ifdef PROBE_BARWAIT
        b.st[2] += (unsigned)(__builtin_amdgcn_s_memrealtime() - pbw_t0);
#endif
    }
    __syncthreads();
}

__device__ __forceinline__ float dot4(f32x4 a) { return (a[0] * a[0] + a[1] * a[1]) + (a[2] * a[2] + a[3] * a[3]); }
__device__ __forceinline__ u32x2 pack4(f32x4 a) { u32x2 w; w.x = cvt_pk_bf16(a[0], a[1]); w.y = cvt_pk_bf16(a[2], a[3]); return w; }

__device__ __forceinline__ f32x4 bf4lo(u32x4 w) { return (f32x4){bflo(w.x), bfhi(w.x), bflo(w.y), bfhi(w.y)}; }
__device__ __forceinline__ f32x4 bf4hi(u32x4 w) { return (f32x4){bflo(w.z), bfhi(w.z), bflo(w.w), bfhi(w.w)}; }
__device__ __forceinline__ void thin_first_norm(const float* xin, bf16_t* xb, const float* g, bf16_t* h, int gw, int NGW, int lane) {
    f32x4 gq[8];
#pragma unroll
    for (int j = 0; j < 4; ++j) { gq[2 * j] = ((const f32x4*)g)[2 * (lane + 64 * j)]; gq[2 * j + 1] = ((const f32x4*)g)[2 * (lane + 64 * j) + 1]; }
    for (int m = gw; m < MTOK; m += NGW) {
        const f32x4* xr = (const f32x4*)(xin + (size_t)m * DM) + 2 * lane; f32x4 v[8]; float s = 0.f;
#pragma unroll
        for (int j = 0; j < 4; ++j) { v[2 * j] = xr[128 * j]; v[2 * j + 1] = xr[128 * j + 1]; s += dot4(v[2 * j]) + dot4(v[2 * j + 1]); }
        const float rstd = __builtin_amdgcn_rsqf(wave_sum(s) * (1.0f / DM) + EPS);
        u32x4* xo = (u32x4*)(xb + (size_t)m * DM) + lane; u32x4* ho = (u32x4*)(h + (size_t)m * DM) + lane;
#pragma unroll
        for (int j = 0; j < 4; ++j) { xo[64 * j] = pack8(v[2 * j], v[2 * j + 1]); ho[64 * j] = pack8(v[2 * j] * rstd * gq[2 * j], v[2 * j + 1] * rstd * gq[2 * j + 1]); }
    }
}
__device__ __forceinline__ void thin_res_norm(const bf16_t* y, bf16_t* xb, const float* g_post, const float* g_pre, bf16_t* h, int gw, int NGW, int lane, float* xout = nullptr) {
    f32x4 gp[8], gq[8];
#pragma unroll
    for (int j = 0; j < 8; ++j) { const int idx = 2 * (lane + 64 * (j >> 1)) + (j & 1); gp[j] = ((const f32x4*)g_post)[idx]; gq[j] = g_pre ? ((const f32x4*)g_pre)[idx] : (f32x4){0.f, 0.f, 0.f, 0.f}; }
    u32x4 y0[4], y1[4], y2[4], x0[4], x1[4], x2[4];
    auto ld = [&](int m, u32x4 (&yw)[4], u32x4 (&xw)[4]) __attribute__((always_inline)) {
        const u32x4* yr = (const u32x4*)(y + (size_t)m * DM) + lane; const u32x4* xr = (const u32x4*)(xb + (size_t)m * DM) + lane;
#pragma unroll
        for (int j = 0; j < 4; ++j) { yw[j] = yr[64 * j]; xw[j] = xr[64 * j]; } };
    auto row = [&](int m, u32x4 (&yw)[4], u32x4 (&xw)[4]) __attribute__((always_inline)) {
        f32x4 v[8]; float s = 0.f;
#pragma unroll
        for (int j = 0; j < 4; ++j) { v[2 * j] = bf4lo(yw[j]); v[2 * j + 1] = bf4hi(yw[j]); s += dot4(v[2 * j]) + dot4(v[2 * j + 1]); }
        const float rstd = __builtin_amdgcn_rsqf(wave_sum(s) * (1.0f / DM) + EPS); float s2 = 0.f;
#pragma unroll
        for (int j = 0; j < 4; ++j) { v[2 * j] = bf4lo(xw[j]) + v[2 * j] * rstd * gp[2 * j]; v[2 * j + 1] = bf4hi(xw[j]) + v[2 * j + 1] * rstd * gp[2 * j + 1]; s2 += dot4(v[2 * j]) + dot4(v[2 * j + 1]); }
        if (xout) { f32x4* xo = (f32x4*)(xout + (size_t)m * DM) + 2 * lane;
#pragma unroll
            for (int j = 0; j < 4; ++j) { xo[128 * j] = v[2 * j]; xo[128 * j + 1] = v[2 * j + 1]; } }
        else { u32x4* xo = (u32x4*)(xb + (size_t)m * DM) + lane;
#pragma unroll
            for (int j = 0; j < 4; ++j) xo[64 * j] = pack8(v[2 * j], v[2 * j + 1]); }
        if (g_pre) { const float rstd2 = __builtin_amdgcn_rsqf(wave_sum(s2) * (1.0f / DM) + EPS); u32x4* ho = (u32x4*)(h + (size_t)m * DM) + lane;
#pragma unroll
            for (int j = 0; j < 4; ++j) ho[64 * j] = pack8(v[2 * j] * rstd2 * gq[2 * j], v[2 * j + 1] * rstd2 * gq[2 * j + 1]); } };
#define TRN_PIN(yw, xw) asm volatile("" : "+v"(yw[0]), "+v"(yw[1]), "+v"(yw[2]), "+v"(yw[3]), "+v"(xw[0]), "+v"(xw[1]), "+v"(xw[2]), "+v"(xw[3]) :: "memory")
#define TRN_M(k) (gw + (k) * NGW)
    ld(TRN_M(0), y0, x0); ld(TRN_M(1), y1, x1);
    ld(TRN_M(2), y2, x2); TRN_PIN(y0, x0); row(TRN_M(0), y0, x0);
    ld(TRN_M(3), y0, x0); TRN_PIN(y1, x1); row(TRN_M(1), y1, x1);
    ld(TRN_M(4), y1, x1); TRN_PIN(y2, x2); row(TRN_M(2), y2, x2);
    ld(TRN_M(5), y2, x2); TRN_PIN(y0, x0); row(TRN_M(3), y0, x0);
    ld(TRN_M(6), y0, x0); TRN_PIN(y1, x1); row(TRN_M(4), y1, x1);
    ld(TRN_M(7), y1, x1); TRN_PIN(y2, x2); row(TRN_M(5), y2, x2);
    TRN_PIN(y0, x0); row(TRN_M(6), y0, x0); TRN_PIN(y1, x1); row(TRN_M(7), y1, x1);
#undef TRN_M
#undef TRN_PIN
}
__device__ __forceinline__ void thin_mem_norm(const float* mem, const float* g_mem, bf16_t* memn, int gw, int NGW, int lane) {
    for (int r = gw; r < MROWS; r += NGW) {
        const f32x4* xr = (const f32x4*)(mem + (size_t)r * DM) + lane; f32x4 v[8]; float s = 0.f;
#pragma unroll
        for (int j = 0; j < 8; ++j) { v[j] = xr[64 * j]; s += dot4(v[j]); }
        const float rstd = __builtin_amdgcn_rsqf(wave_sum(s) * (1.0f / DM) + EPS);
        for (int l = 0; l < DEPTH; ++l) { const f32x4* g = (const f32x4*)(g_mem + (size_t)l * DM) + lane; u32x2* ho = (u32x2*)(memn + ((size_t)l * MROWS + r) * DM) + lane;
#pragma unroll
            for (int j = 0; j < 8; ++j) ho[64 * j] = pack4(v[j] * rstd * g[64 * j]); }
    }
}
__device__ __forceinline__ void thin_softmax(const float* S, bf16_t* P, int gw, int NGW, int lane) {
    const float C = 0.044194173824159216f * LOG2E;
    for (int m = gw; m < MTOK; m += NGW) {
        const f32x4* sr = (const f32x4*)(S + (size_t)m * 1024) + lane; u32x2* po = (u32x2*)(P + (size_t)m * 1024) + lane; f32x4 v[4];
#pragma unroll
        for (int j = 0; j < 4; ++j) v[j] = sr[64 * j];
#pragma unroll
        for (int j = 0; j < 4; ++j) {
            const float mx = wave_max(fmaxf(fmaxf(v[j][0], v[j][1]), fmaxf(v[j][2], v[j][3])));
            f32x4 e;
#pragma unroll
            for (int k = 0; k < 4; ++k) e[k] = __builtin_amdgcn_exp2f((v[j][k] - mx) * C);
            const float sum = wave_sum((e[0] + e[1]) + (e[2] + e[3]));
            po[64 * j] = pack4(e * __builtin_amdgcn_rcpf(sum));
        }
    }
}
__device__ __forceinline__ void thin_conv_glu(const bf16_t* u, bf16_t* act, const float* cw, const float* cb, int gw, int NGW, int lane) {
    constexpr int NBLK = NUP / 512, NCH = MTOK / 64;
    for (int task = gw; task < NBLK * NCH; task += NGW) {
        const int chunk = task / NBLK, blk = task % NBLK, gidx = blk * 64 + lane, m0 = chunk * 64;
        f32x4 wa[3], wg[3];
#pragma unroll
        for (int j = 0; j < 3; ++j) { wa[j] = *(const f32x4*)(cw + (size_t)j * NUP + 4 * gidx); wg[j] = *(const f32x4*)(cw + (size_t)j * NUP + DFF + 4 * gidx); }
        const f32x4 ba = *(const f32x4*)(cb + 4 * gidx), bg = *(const f32x4*)(cb + DFF + 4 * gidx);
        const bf16_t* up = u + (size_t)m0 * NUP + 8 * gidx; bf16_t* ap = act + (size_t)m0 * DFF + 4 * gidx;
        u32x4 p2 = (u32x4){0u, 0u, 0u, 0u}, p1 = p2;
        if ((m0 & (SEQ - 1)) != 0) { p2 = *(const u32x4*)(up - 2 * (size_t)NUP); p1 = *(const u32x4*)(up - (size_t)NUP); }
        for (int r0 = 0; r0 < 64; r0 += 8) {
            u32x4 cur[8];
#pragma unroll
            for (int i = 0; i < 8; ++i) cur[i] = *(const u32x4*)(up + (size_t)(r0 + i) * NUP);
#pragma unroll
            for (int i = 0; i < 8; ++i) { const u32x4 c = cur[i];
                const f32x4 a2 = (f32x4){bflo(p2.x), bfhi(p2.x), bflo(p2.y), bfhi(p2.y)}, g2 = (f32x4){bflo(p2.z), bfhi(p2.z), bflo(p2.w), bfhi(p2.w)};
                const f32x4 a1 = (f32x4){bflo(p1.x), bfhi(p1.x), bflo(p1.y), bfhi(p1.y)}, g1 = (f32x4){bflo(p1.z), bfhi(p1.z), bflo(p1.w), bfhi(p1.w)};
                const f32x4 a0 = (f32x4){bflo(c.x), bfhi(c.x), bflo(c.y), bfhi(c.y)}, g0 = (f32x4){bflo(c.z), bfhi(c.z), bflo(c.w), bfhi(c.w)};
                const f32x4 ca = a2 * wa[0] + a1 * wa[1] + a0 * wa[2] + ba, cg = g2 * wg[0] + g1 * wg[1] + g0 * wg[2] + bg;
                f32x4 o;
#pragma unroll
                for (int e = 0; e < 4; ++e) o[e] = ca[e] * __builtin_amdgcn_rcpf(1.0f + __builtin_amdgcn_exp2f(-ca[e] * LOG2E)) * cg[e];
                *(u32x2*)(ap + (size_t)(r0 + i) * DFF) = pack4(o);
                p2 = p1; p1 = c; }
        }
    }
}

__device__ __forceinline__ void thin_conv_fix(const float* U4, bf16_t* act, const float* cw, const float* cb, int gw, int NGW, int lane) {
    constexpr int NG = NUP / 8;
    for (int i = gw * 64 + lane; i < 64 * 2 * NG; i += NGW * 64) {
        const int pm = i / (2 * NG), rem = i - pm * (2 * NG), r = rem / NG, gidx = rem - r * NG; const bool first = (pm & 15) == 0;
        const float* t0 = U4 + (size_t)(pm * 4) * NUP + 8 * gidx; const float* tp = U4 + (size_t)((pm - 1) * 4) * NUP + 8 * gidx;
        const f32x4 z = (f32x4){0.f, 0.f, 0.f, 0.f};
        f32x4 a0, g0, a1, g1, a2, g2;
        if (r == 0) { a0 = *(const f32x4*)t0; g0 = *(const f32x4*)(t0 + 4);
            a1 = first ? z : *(const f32x4*)(tp + 3 * (size_t)NUP); g1 = first ? z : *(const f32x4*)(tp + 3 * (size_t)NUP + 4);
            a2 = first ? z : *(const f32x4*)(tp + 2 * (size_t)NUP); g2 = first ? z : *(const f32x4*)(tp + 2 * (size_t)NUP + 4); }
        else { a0 = *(const f32x4*)(t0 + NUP); g0 = *(const f32x4*)(t0 + NUP + 4); a1 = *(const f32x4*)t0; g1 = *(const f32x4*)(t0 + 4);
            a2 = first ? z : *(const f32x4*)(tp + 3 * (size_t)NUP); g2 = first ? z : *(const f32x4*)(tp + 3 * (size_t)NUP + 4); }
        const f32x4 ca = a2 * *(const f32x4*)(cw + 4 * gidx) + a1 * *(const f32x4*)(cw + NUP + 4 * gidx) + a0 * *(const f32x4*)(cw + 2 * (size_t)NUP + 4 * gidx) + *(const f32x4*)(cb + 4 * gidx);
        const f32x4 cg = g2 * *(const f32x4*)(cw + DFF + 4 * gidx) + g1 * *(const f32x4*)(cw + NUP + DFF + 4 * gidx) + g0 * *(const f32x4*)(cw + 2 * (size_t)NUP + DFF + 4 * gidx) + *(const f32x4*)(cb + DFF + 4 * gidx);
        f32x4 o;
#pragma unroll
        for (int e = 0; e < 4; ++e) o[e] = ca[e] * __builtin_amdgcn_rcpf(1.0f + __builtin_amdgcn_exp2f(-ca[e] * LOG2E)) * cg[e];
        *(u32x2*)(act + (size_t)(pm * 256 + r) * DFF + 4 * gidx) = pack4(o);
    }
}

struct MapId { __device__ __forceinline__ int operator()(int n) const { return n; } };
struct MapIn { __device__ __forceinline__ int operator()(int n) const {
    if (n < 2048) { const int i = n & 63; return (n & ~63) + 2 * (i & 31) + (i >> 5); }
    if (n < 3840) return n;
    if (n < 3904) { const int i = n - 3840; return 3840 + 2 * (i & 31) + (i >> 5); }
    return n + 192; } };
struct MapUq { __device__ __forceinline__ int operator()(int n) const { const int hd = n / 192, r = n - hd * 192; if (r < 128) return n; const int i = r - 128; return hd * 192 + 128 + 2 * (i & 31) + (i >> 5); } };
struct MapUkv { __device__ __forceinline__ int operator()(int n) const { const int hd = n >> 8, r = n & 255; return r < 128 ? hd * 128 + r : 1024 + hd * 128 + (r - 128); } };
struct MapUp { __device__ __forceinline__ int operator()(int n) const { if (n < DFF) return 8 * (n >> 2) + (n & 3); const int q = n - DFF; return 8 * (q >> 2) + 4 + (q & 3); } };

struct TrSrc { const float* p; int s1, s2; };
__device__ __forceinline__ void tr_ld(const TrSrc& s, f32x4 (&v)[8]) {
#pragma unroll
#ifdef CONV_NT
    for (int i = 0; i < 8; ++i) v[i] = __builtin_nontemporal_load((const f32x4*)(s.p + (size_t)(i >> 1) * s.s2 + (size_t)(i & 1) * s.s1));
#else
    for (int i = 0; i < 8; ++i) v[i] = *(const f32x4*)(s.p + (size_t)(i >> 1) * s.s2 + (size_t)(i & 1) * s.s1);
#endif
}
__device__ __forceinline__ TrSrc tr_src(const float* W, int N, int item, int lane) {
    const int nblk = N / 32, kb = item / nblk, nb = item - kb * nblk;
    return TrSrc{W + (size_t)(64 * kb + (lane >> 3)) * N + 32 * nb + (lane & 7) * 4, 8 * N, 16 * N};
}
template <class Map>
__device__ __forceinline__ void tr_st(f32x4 (&v)[8], int N, bf16_t* WT, int ldd, int kofs, const float* gs, LAS float* scr, int item, int lane, Map map) {
    const int nblk = N / 32, kb = item / nblk, nb = item - kb * nblk, k0 = 64 * kb, n0 = 32 * nb;
    const int rr = lane >> 3, c4 = (lane & 7) * 4;
    if (gs) {
#pragma unroll
        for (int i = 0; i < 8; ++i) v[i] = v[i] * gs[k0 + 8 * i + rr]; }
#pragma unroll
    for (int i = 0; i < 8; ++i) { LAS float* d = scr + (8 * i + rr) * 33 + c4; d[0] = v[i][0]; d[1] = v[i][1]; d[2] = v[i][2]; d[3] = v[i][3]; }
    LDS_WAIT(); asm volatile("" ::: "memory");
    const int c = lane & 7;
#pragma unroll
    for (int j = 0; j < 4; ++j) { const int n = (lane >> 3) + 8 * j; const LAS float* s = scr + (8 * c) * 33 + n;
        u32x4 o; o.x = cvt_pk_bf16(s[0 * 33], s[1 * 33]); o.y = cvt_pk_bf16(s[2 * 33], s[3 * 33]); o.z = cvt_pk_bf16(s[4 * 33], s[5 * 33]); o.w = cvt_pk_bf16(s[6 * 33], s[7 * 33]);
        *(u32x4*)(WT + (size_t)map(n0 + n) * ldd + kofs + k0 + 8 * c) = o; }
    LDS_WAIT(); asm volatile("" ::: "memory");
}

#ifdef DIAG_CKS
__device__ __forceinline__ void cks_rows(const unsigned* buf, int row_words, int nrows, unsigned* persist, unsigned* ctlw, int gw, int NGW, int lane) {
    for (int m = gw; m < nrows; m += NGW) {
        const unsigned* r = buf + (size_t)m * row_words; unsigned c = 0u;
        for (int i = lane; i < row_words; i += 64) c = c * 31u + r[i] * (2u * (unsigned)i + 1u);
        c += (unsigned)__builtin_amdgcn_ds_swizzle((int)c, (1 << 10) | 0x1f); c += (unsigned)__builtin_amdgcn_ds_swizzle((int)c, (2 << 10) | 0x1f); c += (unsigned)__builtin_amdgcn_ds_swizzle((int)c, (4 << 10) | 0x1f);
        c += (unsigned)__builtin_amdgcn_ds_swizzle((int)c, (8 << 10) | 0x1f); c += (unsigned)__builtin_amdgcn_ds_swizzle((int)c, (16 << 10) | 0x1f);
        { auto rr = __builtin_amdgcn_permlane32_swap(c, c, false, false); c = rr[0] + rr[1]; }
        if (lane == 0) { unsigned* ps = persist + 2 * (size_t)m; const unsigned o0 = __hip_atomic_load(ps, __ATOMIC_RELAXED, __HIP_MEMORY_SCOPE_AGENT), o1 = __hip_atomic_load(ps + 1, __ATOMIC_RELAXED, __HIP_MEMORY_SCOPE_AGENT);
            if (o1 == (o0 ^ 0x5a5a5a5au) && o0 != c) __hip_atomic_fetch_add(ctlw, 1u, __ATOMIC_RELAXED, __HIP_MEMORY_SCOPE_AGENT);
            __hip_atomic_store(ps, c, __ATOMIC_RELAXED, __HIP_MEMORY_SCOPE_AGENT); __hip_atomic_store(ps + 1, c ^ 0x5a5a5a5au, __ATOMIC_RELAXED, __HIP_MEMORY_SCOPE_AGENT); }
    }
}
#endif
#ifndef MK_SINGLE
#define MK_SINGLE 1
#endif
constexpr int NWAVES = 8;
constexpr int RING_BYTES = 131072, LDSCTL_OFF = RING_BYTES, MISC_OFF = LDSCTL_OFF + 320, LDS_BYTES = 147456;
constexpr int NPL = 16, NPH = 2 + DEPTH * NPL;

struct Args { const void* in[31]; float* out; unsigned char* ws; int ph_lo, ph_hi; float lam_init[4]; float inv_freq[32]; };
static_assert(sizeof(Args) == 31 * 8 + 8 + 8 + 8 + 16 + 128, "Args has no padding");

__global__ void __launch_bounds__(NWAVES * 64, 2) fwd(Args args) {
    extern __shared__ __attribute__((aligned(16))) unsigned char lds_raw[];
    LAS unsigned char* lds = (LAS unsigned char*)lds_raw;
    volatile LAS unsigned* MISC = (volatile LAS unsigned*)(lds + MISC_OFF);
    for (int u = threadIdx.x; u < (LDS_BYTES - LDSCTL_OFF) / 4; u += NWAVES * 64) ((LAS unsigned*)(lds + LDSCTL_OFF))[u] = 0u;
    __syncthreads();
    const int lo = args.ph_lo, hi = args.ph_hi;
    unsigned* barw = (unsigned*)(GAS unsigned*)(((const __attribute__((address_space(4))) unsigned long long*)__builtin_amdgcn_kernarg_segment_ptr())[32] + WS_CTL) + CW_BAR;
    XcdBarrier bar; bar.bar = barw; bar.x = 0; bar.st = MISC + 8;
    if (hi - lo > 1) bar = xcd_barrier_post(barw, MISC + 8);
#ifdef PROBE_WALL
    if (threadIdx.x == 0) MISC[12] = (unsigned)__builtin_amdgcn_s_memrealtime();
#define WALL_TICK(k) do { if (threadIdx.x == 0) { const unsigned t_ = (unsigned)__builtin_amdgcn_s_memrealtime(), dt_ = t_ - MISC[12]; MISC[12] = t_; \
        const int ty_ = (k) < 2 ? 16 + (k) : ((k) - 2) % NPL; if (ty_ == (PROBE_WALL)) MISC[14] += dt_; } } while (0)
#else
#define WALL_TICK(k) do { } while (0)
#endif
#ifndef WGM_N8
#define WGM_N8 4
#endif
#ifndef EPI_ALIGN
#define EPI_ALIGN true
#endif
#ifndef PHMASK
#define PHMASK 0x3ffff
#endif
#ifndef PROBE_PHASE
#define PROBE_PHASE -1
#endif
#define PREP(k) for (int rep_ = 0; rep_ < ((PROBE_PHASE) == (k) ? 2 : 1); ++rep_)
#ifdef PROBE_FLUSH
#define FLUSH_SWEEP() do { PHASE_BEGIN(); xcd_barrier(bar); const u32x4* fp_ = (const u32x4*)(ws + WS_RA); u32x4 fa_ = (u32x4){0u, 0u, 0u, 0u}; \
    for (size_t i_ = (size_t)(tid + bx * 512); i_ < (size_t)(352u << 20) / 16; i_ += (size_t)G * 512) { const u32x4 t_ = fp_[i_]; fa_.x ^= t_.x; fa_.y ^= t_.y; fa_.z ^= t_.z; fa_.w ^= t_.w; } \
    if ((fa_.x ^ fa_.y ^ fa_.z ^ fa_.w) == 0x13572468u) ((unsigned*)(ws + WS_CTL))[90] = 1u; xcd_barrier(bar); } while (0)
#endif
#define EN(j) (((PHMASK) >> (j)) & 1)
#define PH(k) (lo <= (k) && (k) < hi)
#ifdef PROBE_DOUBLE_BAR
#define SEAM(k) do { if (PH(k) && PH((k) + 1)) { xcd_barrier(bar); xcd_barrier(bar); } } while (0)
#else
#define SEAM(k) do { if (PH(k) && PH((k) + 1)) { xcd_barrier(bar); WALL_TICK(k); } } while (0)
#endif

    typedef const __attribute__((address_space(4))) unsigned long long* kptr_t;
#define KARGS() ({ kptr_t _p = (kptr_t)__builtin_amdgcn_kernarg_segment_ptr(); asm volatile("" : "+s"(_p)); _p; })
#define PHASE_BEGIN() kptr_t kp = KARGS(); unsigned char* ws = (unsigned char*)(GAS unsigned char*)kp[32]; int tid = threadIdx.x, G = gridDim.x, bx = blockIdx.x; asm volatile("" : "+v"(tid), "+s"(G), "+s"(bx)); \
    const int vcu = (G % 8 == 0) ? (bx % 8) * (G / 8) + bx / 8 : bx;     \
    const int lane = tid & 63, wave = __builtin_amdgcn_readfirstlane(tid >> 6), gw = vcu * NWAVES + wave, NGW = G * NWAVES; (void)lane; (void)gw; (void)ws; (void)NGW
#define INP(i) ((const float*)(const GAS float*)kp[i])
#define x_in INP(0)
#define mem INP(1)
#define positions ((const int*)(const GAS int*)kp[2])
#define g_pre_mix INP(3)
#define w_in INP(4)
#define b_gate INP(5)
#define lam_q1 INP(6)
#define lam_k1 INP(7)
#define lam_q2 INP(8)
#define lam_k2 INP(9)
#define g_diff_sub INP(10)
#define g_cq INP(11)
#define w_uq INP(12)
#define g_ckv INP(13)
#define w_ukv INP(14)
#define w_br_diff INP(15)
#define w_br_mla INP(16)
#define w_mix_out INP(17)
#define g_post_mix INP(18)
#define g_pre_x INP(19)
#define g_mem INP(20)
#define w_q_x INP(21)
#define w_kv_x INP(22)
#define w_o_x INP(23)
#define g_post_x INP(24)
#define g_pre_ffn INP(25)
#define w_up INP(26)
#define conv_w INP(27)
#define conv_b INP(28)
#define w_down INP(29)
#define g_post_ffn INP(30)
#define X ((float*)(GAS float*)kp[31])
#define LAM_INIT(l) (((const __attribute__((address_space(4))) float*)kp)[68 + (l)])
#define INV_FREQ(i) (((const __attribute__((address_space(4))) float*)kp)[72 + (i)])
#define WSB ((bf16_t*)ws)
#define Wall ((bf16_t*)(ws + WS_W))
#define H ((bf16_t*)(ws + WS_H))
#define cs ((f32x2*)(ws + WS_CS))
#define ssq_cq ((float*)(ws + WS_SSQ_CQ))
#define ssq_ckv ((float*)(ws + WS_SSQ_CKV))
#define Kmem ((bf16_t*)(ws + RA_KMEM))
#define Vmem ((bf16_t*)(ws + RA_VMEM))
#define Qd ((bf16_t*)(ws + RA_QD))
#define Kd ((bf16_t*)(ws + RA_KD))
#define Vd ((bf16_t*)(ws + RA_VD))
#define cq ((bf16_t*)(ws + RA_CQ))
#define ckv ((bf16_t*)(ws + RA_CKV))
#define kpe ((bf16_t*)(ws + RA_KPE))
#define gates ((bf16_t*)(ws + RA_GATES))
#define merged ((bf16_t*)(ws + RA_MERGED))
#define q_x ((bf16_t*)(ws + RA_QX))
#define Pm ((bf16_t*)(ws + RA_P))
#define o_x ((bf16_t*)(ws + RA_OX))
#define Ub ((bf16_t*)(ws + RA_U))
#define Sx ((float*)(ws + RA_S))
#define memn ((bf16_t*)(ws + RA_MEMN))
#define Qm ((bf16_t*)(ws + RB_QM))
#define Kn ((bf16_t*)(ws + RB_KN))
#define Vm ((bf16_t*)(ws + RB_VM))
#define ocat ((bf16_t*)(ws + RB_OCAT))
#define act ((bf16_t*)(ws + RB_ACT))
#define Y ((float*)(ws + WS_SCR))
#define XB ((bf16_t*)(ws + RC_Y))
#define YB ((bf16_t*)(ws + RC_Y + 64 * MiB))

#ifdef DIAG_NANFILL
    {
        PHASE_BEGIN();
        u32x4* p = (u32x4*)(ws + WS_CS); const size_t n16 = (WS_END - WS_CS) / 16;
        for (size_t i = (size_t)gw * 64 + lane; i < n16; i += (size_t)NGW * 64) p[i] = (u32x4){0xffffffffu, 0xffffffffu, 0xffffffffu, 0xffffffffu};
        u32x4* q = (u32x4*)X; const size_t m16 = (size_t)MTOK * DM / 4;
        for (size_t i = (size_t)gw * 64 + lane; i < m16; i += (size_t)NGW * 64) q[i] = (u32x4){0xffffffffu, 0xffffffffu, 0xffffffffu, 0xffffffffu};
    }
    xcd_barrier(bar);
#endif
#define TR_PIN(v) asm volatile("" : "+v"(v[0]), "+v"(v[1]), "+v"(v[2]), "+v"(v[3]), "+v"(v[4]), "+v"(v[5]), "+v"(v[6]), "+v"(v[7]) :: "memory")
#define CONV_BODY() \
        LAS float* scr = (LAS float*)(lds + wave * 8448); \
        constexpr int I_IN = 32 * 250, I_UQ = 8 * 48, I_UKV = 4 * 64, I_BR = 16 * 64, I_SQ = 32 * 64, I_KVX = 32 * 128, I_UP = 32 * 352, I_DN = 88 * 64; \
        constexpr int I_X = 2 * I_SQ + I_KVX, I_N = I_IN + I_UQ + I_UKV + 2 * I_BR + I_SQ + I_UP + I_DN, T_X = DEPTH * I_X, T_ALL = T_X + DEPTH * I_N; (void)T_ALL; \
        auto src_of = [&](int it) __attribute__((always_inline)) -> TrSrc { \
            if (it < T_X) { const int l = it / I_X; int r = it - l * I_X; \
                if (r < I_SQ) return TrSrc{w_q_x + (size_t)l * DM * DM + (size_t)r * 2048 + lane * 8, 4, 512}; r -= I_SQ;     \
                if (r < I_KVX) return tr_src(w_kv_x + (size_t)l * DM * 2 * DM, 2 * DM, r, lane); r -= I_KVX; \
                return tr_src(w_o_x + (size_t)l * DM * DM, DM, r, lane); } \
            it -= T_X; const int l = it / I_N; int r = it - l * I_N; \
            if (r < I_IN) return tr_src(w_in + (size_t)l * DM * NIN_SRC, NIN_SRC, r, lane); r -= I_IN; \
            if (r < I_UQ) return tr_src(w_uq + (size_t)l * 512 * 1536, 1536, r, lane); r -= I_UQ; \
            if (r < I_UKV) return tr_src(w_ukv + (size_t)l * 256 * 2048, 2048, r, lane); r -= I_UKV; \
            if (r < I_BR) return tr_src(w_br_diff + (size_t)l * 1024 * DM, DM, r, lane); r -= I_BR; \
            if (r < I_BR) return tr_src(w_br_mla + (size_t)l * 1024 * DM, DM, r, lane); r -= I_BR; \
            if (r < I_SQ) return tr_src(w_mix_out + (size_t)l * DM * DM, DM, r, lane); r -= I_SQ; \
            if (r < I_UP) return tr_src(w_up + (size_t)l * DM * NUP, NUP, r, lane); r -= I_UP; \
            return tr_src(w_down + (size_t)l * DFF * DM, DM, r, lane); }; \
        auto process = [&](int it, f32x4 (&v)[8]) __attribute__((always_inline)) { \
            if (it < T_X) { const int l = it / I_X; int r = it - l * I_X; \
                if (r < I_SQ) { bf16_t* d_ = (bf16_t*)(ws + RA_QXP) + (size_t)l * DM * DM + (size_t)r * 2048 + lane * 8; \
                    _Pragma("unroll") for (int i = 0; i < 4; ++i) *(u32x4*)(d_ + i * 512) = pack8(v[2 * i], v[2 * i + 1]); \
                    return; } r -= I_SQ; \
                if (r < I_KVX) { tr_st(v, 2 * DM, (bf16_t*)(ws + RA_KVXT) + (size_t)l * 2 * DM * DM, DM, 0, nullptr, scr, r, lane, MapId()); return; } r -= I_KVX; \
                tr_st(v, DM, (bf16_t*)(ws + RA_OXT) + (size_t)l * DM * DM, DM, 0, nullptr, scr, r, lane, MapId()); return; } \
            it -= T_X; const int l = it / I_N; int r = it - l * I_N; bf16_t* Wl = Wall + (size_t)l * W_LAYER; \
            if (r < I_IN) { tr_st(v, NIN_SRC, Wl + WO_IN, DM, 0, nullptr, scr, r, lane, MapIn()); return; } r -= I_IN; \
            if (r < I_UQ) { tr_st(v, 1536, Wl + WO_UQ, 512, 0, g_cq + l * 512, scr, r, lane, MapUq()); return; } r -= I_UQ; \
            if (r < I_UKV) { tr_st(v, 2048, Wl + WO_UKV, 256, 0, g_ckv + l * 256, scr, r, lane, MapUkv()); return; } r -= I_UKV; \
            if (r < I_BR) { tr_st(v, DM, Wl + WO_BR, DM, 0, nullptr, scr, r, lane, MapId()); return; } r -= I_BR; \
            if (r < I_BR) { tr_st(v, DM, Wl + WO_BR, DM, 1024, nullptr, scr, r, lane, MapId()); return; } r -= I_BR; \
            if (r < I_SQ) { tr_st(v, DM, Wl + WO_MIX, DM, 0, nullptr, scr, r, lane, MapId()); return; } r -= I_SQ; \
            if (r < I_UP) { tr_st(v, NUP, Wl + WO_UP, DM, 0, nullptr, scr, r, lane, MapUp()); return; } r -= I_UP; \
            tr_st(v, DM, Wl + WO_DOWN, DFF, 0, nullptr, scr, r, lane, MapId()); }; \
          \
        auto conv_range = [&](int lo_, int hi_, int first_, int stride_) __attribute__((always_inline)) { \
            f32x4 va[8], vb[8]; const int last_ = hi_ - 1; int it = lo_ + first_; \
            tr_ld(src_of(it < hi_ ? it : last_), va); \
            for (; it < hi_; it += 2 * stride_) { const int i1 = it + stride_, i2 = it + 2 * stride_; \
                tr_ld(src_of(i1 < hi_ ? i1 : last_), vb); TR_PIN(va); process(it, va); \
                tr_ld(src_of(i2 < hi_ ? i2 : last_), va); TR_PIN(vb); if (i1 < hi_) process(i1, vb); } }
    if (EN(16) && PH(0)) {
        PHASE_BEGIN();
        CONV_BODY();
        conv_range(0, T_X, gw, NGW);
#ifdef PROBE_CONV_HOT
        for (int rep_ = 0; rep_ < 10; ++rep_) conv_range(0, I_X, gw, NGW);
#endif
        thin_mem_norm(mem, g_mem, memn, gw, NGW, lane);
    }
    SEAM(0);
    if (EN(17) && PH(1)) {
        PHASE_BEGIN();
        constexpr int NGA = 96;
        if (bx < NGA) {
            { pg8::Gemm g{WSB, WSB, DM, DM, DM}; pg8::MemKvOrder S{NGA, bx}; pg8::EpiMemKv E{Kmem};
              pg8::gemm_phase<pg8::EpiMemKv, pg8::MemKvOrder, true, true>(lds, g, S, E); }
            xcd_barrier(bar);
            { pg8::Gemm g{WSB, WSB, DM, DM, 512}; pg8::FoldOrder S{NGA, bx}; pg8::EpiFold E{Wall};
              pg8::gemm_phase<pg8::EpiFold, pg8::FoldOrder, true, true>(lds, g, S, E); }
        } else {
            CONV_BODY();
            const int gwb = (bx - NGA) * NWAVES + wave, ngwb = (G - NGA) * NWAVES;
            constexpr int T_MID = T_X + (int)(0.40 * (T_ALL - T_X));
            for (int seg = 0; seg < 2; ++seg) {
                if (seg == 1) xcd_barrier(bar);
                conv_range(seg == 0 ? T_X : T_MID, seg == 0 ? T_MID : T_ALL, gwb, ngwb);
            }
            for (int i = gwb * 64 + lane; i < DEPTH * 192 * (DM / 8); i += ngwb * 64) { const int l = i / (192 * (DM / 8)), r = i - l * (192 * (DM / 8));
                *(u32x4*)(Wall + (size_t)l * W_LAYER + WO_IN + (size_t)3904 * DM + (size_t)r * 8) = (u32x4){0u, 0u, 0u, 0u}; }
            for (int idx = gwb * 64 + lane; idx < MTOK * 32; idx += ngwb * 64) {
                const int m = idx >> 5, i = idx & 31;
                const float ang = (float)positions[m] * INV_FREQ(i);
                const double rev = (double)ang * 0.15915494309189535; const float f = (float)(rev - __builtin_rint(rev));
                cs[idx] = (f32x2){__builtin_amdgcn_cosf(f), __builtin_amdgcn_sinf(f)};
            }
            thin_first_norm(x_in, XB, g_pre_mix, H, gwb, ngwb, lane);
        }
    }
#undef CONV_BODY
#undef TR_PIN
    SEAM(1);

    for (int l = 0; l < DEPTH; ++l) {
        const int pb = 2 + l * NPL;
        if (pb + NPL <= lo || pb >= hi) continue;
        if (EN(0) && PH(pb + 0)) PREP(0) {
            PHASE_BEGIN(); const bf16_t* Wl = Wall + (size_t)l * W_LAYER; (void)Wl;
            pg8::Gemm g{H, Wl + WO_IN, DM, DM, DM}; pg8::StaticOrder S; S.init(MTOK, NIN, G, bx, DM, DM);
            pg8::EpiProj E{Qd, Kd, Vd, cq, ckv, kpe, gates, ssq_cq, ssq_ckv, b_gate + (size_t)l * 4096, cs};
            pg8::gemm_phase<pg8::EpiProj, pg8::StaticOrder, EPI_ALIGN, true>(lds, g, S, E);
        }
        SEAM(pb + 0);
        if (EN(1) && PH(pb + 1)) PREP(1) {
            PHASE_BEGIN(); const bf16_t* Wl = Wall + (size_t)l * W_LAYER; (void)Wl;
            { pg8::Gemm g{cq, Wl + WO_UQ, 512, 512, 512}; pg8::StaticOrder S; S.init(MTOK, 1536, G, bx, 512, 512); pg8::EpiQm E{Qm, ssq_cq, cs};
              pg8::gemm_phase<pg8::EpiQm, pg8::StaticOrder, EPI_ALIGN, true>(lds, g, S, E); }
            { pg8::Gemm g{ckv, Wl + WO_UKV, 256, 256, 256}; pg8::StaticOrder S; S.init(MTOK, 2048, bx < 128 ? 512 : 128, bx, 256, 256); pg8::EpiKv E{Kn, Vm, ssq_ckv};
              pg8::gemm_phase<pg8::EpiKv, pg8::StaticOrder, EPI_ALIGN, true>(lds, g, S, E); }
        }
        SEAM(pb + 1);
#ifdef DIAG_PREFILL
        if (PH(pb + 2)) { { PHASE_BEGIN(); u32x4* p = (u32x4*)ocat; const size_t n16 = (size_t)MTOK * 2048 * 2 / 16;
            for (size_t i = (size_t)gw * 64 + lane; i < n16; i += (size_t)NGW * 64) p[i] = (u32x4){0u, 0u, 0u, 0u}; } xcd_barrier(bar); }
#endif
#ifdef DIAG_CKS
        if (l == 0 && PH(pb + 2)) { PHASE_BEGIN(); unsigned* pz = (unsigned*)(ws + WS_END + 1 * MiB) + (size_t)l * 8 * 2 * MTOK; unsigned* cw = (unsigned*)(ws + WS_CTL);
            cks_rows((const unsigned*)Qd, 512, MTOK, pz + 0 * 2 * MTOK, cw + 68, gw, NGW, lane); cks_rows((const unsigned*)Kd, 512, MTOK, pz + 1 * 2 * MTOK, cw + 68, gw, NGW, lane);
            cks_rows((const unsigned*)Vd, 512, MTOK, pz + 2 * 2 * MTOK, cw + 68, gw, NGW, lane); cks_rows((const unsigned*)Qm, 768, MTOK, pz + 3 * 2 * MTOK, cw + 69, gw, NGW, lane);
            cks_rows((const unsigned*)Kn, 512, MTOK, pz + 4 * 2 * MTOK, cw + 69, gw, NGW, lane); cks_rows((const unsigned*)Vm, 512, MTOK, pz + 5 * 2 * MTOK, cw + 69, gw, NGW, lane);
            cks_rows((const unsigned*)kpe, 32, MTOK, pz + 6 * 2 * MTOK, cw + 69, gw, NGW, lane); cks_rows((const unsigned*)H, 1024, MTOK, pz + 7 * 2 * MTOK, cw + 70, gw, NGW, lane); }
#endif
        if (EN(2) && PH(pb + 2)) {
            PHASE_BEGIN(); const bf16_t* Wl = Wall + (size_t)l * W_LAYER; (void)Wl;
            float lam;
            { const float a = lam_q1[l * 64 + lane] * lam_k1[l * 64 + lane], b2 = lam_q2[l * 64 + lane] * lam_k2[l * 64 + lane];
              lam = __builtin_amdgcn_exp2f(wave_sum(a) * LOG2E) - __builtin_amdgcn_exp2f(wave_sum(b2) * LOG2E) + LAM_INIT(l); }
            const float omli = 1.0f - LAM_INIT(l);
            const float Cd = 0.125f * LOG2E, Cm = 0.07216878364870322f * LOG2E;
            const int r32 = lane & 31, hi = lane >> 5;
#define SCRL() (Y + ((size_t)bx * NWAVES + wave) * 4096 + lane)
            LAS bf16_t* stg = (LAS bf16_t*)(lds + 81920 + wave * 4096);
            LAS bf16_t* stw = stg + hi * 4 * 64 + r32;
            const int srow = lane >> 3, sch = lane & 7;
#define STORE_O(Og) do { _Pragma("unroll") for (int hf = 0; hf < 2; ++hf) { \
                _Pragma("unroll") for (int r = 0; r < 16; ++r) _Pragma("unroll") for (int dd = 0; dd < 2; ++dd) \
                    stw[((r & 3) + 8 * (r >> 2)) * 64 + dd * 32] = (bf16_t)(cvt_pk_bf16(o[hf * 2 + dd][r], 0.f) & 0xffffu); \
                LDS_WAIT(); asm volatile("" ::: "memory"); \
                _Pragma("unroll") for (int i = 0; i < 4; ++i) { const u32x4 v = *(const LAS u32x4*)(stg + (i * 8 + srow) * 64 + sch * 8); \
                    st16<0>((Og) + (size_t)(i * 8 + srow) * 2048 + hf * 64 + sch * 8, v); } \
                LDS_WAIT(); asm volatile("" ::: "memory"); } } while (0)
#ifdef DIAG_CKS
#define CKS_O(slot, cw) do { unsigned c_ = 0u; _Pragma("unroll") for (int d_ = 0; d_ < 4; ++d_) _Pragma("unroll") for (int r_ = 0; r_ < 16; ++r_) c_ = c_ * 31u + __float_as_uint(o[d_][r_]); \
                c_ += (unsigned)__builtin_amdgcn_ds_swizzle((int)c_, (1 << 10) | 0x1f); c_ += (unsigned)__builtin_amdgcn_ds_swizzle((int)c_, (2 << 10) | 0x1f); c_ += (unsigned)__builtin_amdgcn_ds_swizzle((int)c_, (4 << 10) | 0x1f); \
                c_ += (unsigned)__builtin_amdgcn_ds_swizzle((int)c_, (8 << 10) | 0x1f); c_ += (unsigned)__builtin_amdgcn_ds_swizzle((int)c_, (16 << 10) | 0x1f); \
                { auto rr_ = __builtin_amdgcn_permlane32_swap(c_, c_, false, false); c_ = rr_[0] + rr_[1]; } \
                if (lane == 0) { unsigned* ps_ = (unsigned*)(ws + WS_END) + 2 * (size_t)(slot); const unsigned o0_ = __hip_atomic_load(ps_, __ATOMIC_RELAXED, __HIP_MEMORY_SCOPE_AGENT), o1_ = __hip_atomic_load(ps_ + 1, __ATOMIC_RELAXED, __HIP_MEMORY_SCOPE_AGENT); \
                    if (l == 0 && o1_ == (o0_ ^ 0x5a5a5a5au) && o0_ != c_) __hip_atomic_fetch_add((unsigned*)(ws + WS_CTL) + (cw), 1u, __ATOMIC_RELAXED, __HIP_MEMORY_SCOPE_AGENT); \
                    __hip_atomic_store(ps_, c_, __ATOMIC_RELAXED, __HIP_MEMORY_SCOPE_AGENT); __hip_atomic_store(ps_ + 1, c_ ^ 0x5a5a5a5au, __ATOMIC_RELAXED, __HIP_MEMORY_SCOPE_AGENT); } } while (0)
#else
#define CKS_O(slot, cw) do {} while (0)
#endif
#ifndef ATT_V1_DIFF
#define ATT_DIFF att::attn_pass2<false>
#else
#define ATT_DIFF att::attn_pass<4, false>
#endif
#ifdef ATT_P2_MLA
#define ATT_MLA att::attn_pass2<true>
#else
#define ATT_MLA att::attn_pass<12, true>
#endif
#ifndef PROBE_ATT_REPS
#define PROBE_ATT_REPS 1
#endif
#ifndef ATT_STATIC
            const int qg = (vcu >> 5) & 7;
            unsigned* qctr = (unsigned*)(ws + WS_CTL) + 256 + (l * 8 + qg) * 64;
            for (;;) {
                __syncthreads();
                if (tid == 0) MISC[4] = __hip_atomic_fetch_add(qctr, 1u, __ATOMIC_RELAXED, __HIP_MEMORY_SCOPE_AGENT);
                __syncthreads();
                const int it = (int)MISC[4]; if (it >= 128) break;
                const int e = it >> 2; const unsigned long long tb = e < 8 ? 0x091f0a0b0c0d0e0full : e < 16 ? 0x061a1b071c081d1eull : e < 24 ? 0x1503160417180519ull : 0x1000111201130214ull;
                const int code = (int)((tb >> ((e & 7) * 8)) & 0xffull), qb = code & 15, bh = qg * 4 + (it & 3), b = bh >> 3, hd = bh & 7; const size_t kv0 = (size_t)b * SEQ;
                const int NT = 4 * qb + 4; const size_t row0 = kv0 + (size_t)qb * 256;
                f32x16 o[4];
                if ((code >> 4) == 0) {
                    for (int br = 0; br < 2; ++br) {
                        ATT_DIFF(Qd + row0 * 1024 + hd * 128 + br * 64, 1024, Kd + kv0 * 1024 + hd * 128 + br * 64, nullptr, Vd + kv0 * 1024 + hd * 128, NT, Cd, lds, o);
                        if (br == 0) {
#pragma unroll
                            for (int d0 = 0; d0 < 4; ++d0) { float* pd = SCRL() + d0 * 1024; asm volatile("" : "+v"(pd));
#pragma unroll
                                for (int r = 0; r < 16; ++r) pd[r * 64] = o[d0][r]; }
                        }
                    }
                    float ss[16];
#pragma unroll
                    for (int r = 0; r < 16; ++r) ss[r] = 0.f;
#pragma unroll
                    for (int d0 = 0; d0 < 4; ++d0) { const float* pd = SCRL() + d0 * 1024; asm volatile("" : "+v"(pd));
#pragma unroll
                        for (int r = 0; r < 16; ++r) { const float d = pd[r * 64] - lam * o[d0][r]; o[d0][r] = d; ss[r] += d * d; } }
#pragma unroll
                    for (int r = 0; r < 16; ++r) {
                        ss[r] = __builtin_amdgcn_rsqf(half_sum(ss[r]) * (1.0f / 128.0f) + EPS) * omli; }
#pragma unroll
                    for (int d0 = 0; d0 < 4; ++d0)
#pragma unroll
                        for (int r = 0; r < 16; ++r) o[d0][r] = o[d0][r] * ss[r] * g_diff_sub[l * 128 + d0 * 32 + r32];
                    bf16_t* og = ocat + (row0 + (size_t)wave * 32) * 2048 + hd * 128;
                    STORE_O(og);
                } else {
                    ATT_MLA(Qm + row0 * 1536 + hd * 192, 1536, Kn + kv0 * 1024 + hd * 128, kpe + kv0 * 64, Vm + kv0 * 1024 + hd * 128, NT, Cm, lds, o);
                    bf16_t* og = ocat + (row0 + (size_t)wave * 32) * 2048 + 1024 + hd * 128;
                    STORE_O(og);
                }
            }
#else
            for (int rep_ = 0; rep_ < PROBE_ATT_REPS; ++rep_)
            for (int pr = vcu; pr < 256; pr += G) {
                const int bh = pr >> 3, s = pr & 7, b = bh >> 3, hd = bh & 7; const size_t kv0 = (size_t)b * SEQ;
#ifndef NO_DIFF
                for (int k = 0; k < 2; ++k) {
                    const int qb = k ? 15 - s : s, NT = 4 * qb + 4; const size_t row0 = kv0 + (size_t)qb * 256;
                    f32x16 o[4];
#ifdef DIAG_SELFCHK
                    for (int rep = 0; rep < 2; ++rep) {
                        att::attn_pass<4, false>(Qd + row0 * 1024 + hd * 128, 1024, Kd + kv0 * 1024 + hd * 128, nullptr, Vd + kv0 * 1024 + hd * 128, NT, Cd, lds, o);
                        if (rep == 0) {
#pragma unroll
                            for (int q = 0; q < 16; ++q) *(f32x4*)(scrl + 4 * q) = (f32x4){o[q >> 2][(q & 3) * 4], o[q >> 2][(q & 3) * 4 + 1], o[q >> 2][(q & 3) * 4 + 2], o[q >> 2][(q & 3) * 4 + 3]};
                        } else { bool bad = false;
#pragma unroll
                            for (int q = 0; q < 32; ++q) { const unsigned long long w = __hip_atomic_load((const unsigned long long*)(scrl + 2 * q), __ATOMIC_RELAXED, __HIP_MEMORY_SCOPE_AGENT);
                                const int d0 = q >> 3, r = (q & 7) * 2; bad |= ((unsigned)w != __float_as_uint(o[d0][r])) | ((unsigned)(w >> 32) != __float_as_uint(o[d0][r + 1])); }
                            if (bad) __hip_atomic_fetch_add((unsigned*)(ws + WS_CTL) + 64, 1u, __ATOMIC_RELAXED, __HIP_MEMORY_SCOPE_AGENT); }
                    }
#endif
                    for (int br = 0; br < 2; ++br) {
                        ATT_DIFF(Qd + row0 * 1024 + hd * 128 + br * 64, 1024, Kd + kv0 * 1024 + hd * 128 + br * 64, nullptr, Vd + kv0 * 1024 + hd * 128, NT, Cd, lds, o);
                        if (br == 0) {
#pragma unroll
                            for (int d0 = 0; d0 < 4; ++d0) { float* pd = SCRL() + d0 * 1024; asm volatile("" : "+v"(pd));
#pragma unroll
                                for (int r = 0; r < 16; ++r) pd[r * 64] = o[d0][r]; }
                        }
                        CKS_O((((size_t)l * 512 + bh * 16 + qb) * 8 + wave) * 4 + br, 65);
                    }
                    float ss[16];
#pragma unroll
                    for (int r = 0; r < 16; ++r) ss[r] = 0.f;
#pragma unroll
                    for (int d0 = 0; d0 < 4; ++d0) { const float* pd = SCRL() + d0 * 1024; asm volatile("" : "+v"(pd));
#pragma unroll
                        for (int r = 0; r < 16; ++r) { const float d = pd[r * 64] - lam * o[d0][r]; o[d0][r] = d; ss[r] += d * d; } }
#pragma unroll
                    for (int r = 0; r < 16; ++r) {
                        ss[r] = __builtin_amdgcn_rsqf(half_sum(ss[r]) * (1.0f / 128.0f) + EPS) * omli; }
#pragma unroll
                    for (int d0 = 0; d0 < 4; ++d0)
#pragma unroll
                        for (int r = 0; r < 16; ++r) o[d0][r] = o[d0][r] * ss[r] * g_diff_sub[l * 128 + d0 * 32 + r32];
                    bf16_t* og = ocat + (row0 + (size_t)wave * 32) * 2048 + hd * 128;
                    CKS_O((((size_t)l * 512 + bh * 16 + qb) * 8 + wave) * 4 + 2, 66);
                    STORE_O(og);
                }
#endif
#ifndef NO_MLA
                for (int k = 0; k < 2; ++k) {
                    const int qb = k ? 15 - s : s, NT = 4 * qb + 4; const size_t row0 = kv0 + (size_t)qb * 256;
                    f32x16 o[4];
                    ATT_MLA(Qm + row0 * 1536 + hd * 192, 1536, Kn + kv0 * 1024 + hd * 128, kpe + kv0 * 64, Vm + kv0 * 1024 + hd * 128, NT, Cm, lds, o);
                    bf16_t* og = ocat + (row0 + (size_t)wave * 32) * 2048 + 1024 + hd * 128;
                    CKS_O((((size_t)l * 512 + bh * 16 + qb) * 8 + wave) * 4 + 3, 67);
                    STORE_O(og);
                }
#endif
            }
#endif
#undef STORE_O
#undef SCRL
#undef CKS_O
            __syncthreads();
        }
#ifdef DIAG_NOATT
        if (PH(pb + 2)) { PHASE_BEGIN();
            for (size_t i = (size_t)gw * 64 + lane; i < (size_t)MTOK * 1024; i += (size_t)NGW * 64) { const size_t m = i >> 10, c = i & 1023;
                const float a = bflo((unsigned)Qd[i]) + bflo((unsigned)Kd[i]) + bflo((unsigned)Vd[i]) + bflo((unsigned)kpe[m * 64 + (c & 63)]);
                const float b2 = bflo((unsigned)Kn[i]) + bflo((unsigned)Vm[i]) + bflo((unsigned)Qm[m * 1536 + c]) + bflo((unsigned)Qm[m * 1536 + 512 + c]);
                ocat[m * 2048 + c] = (bf16_t)(cvt_pk_bf16(a * 0.5f, 0.f) & 0xffffu); ocat[m * 2048 + 1024 + c] = (bf16_t)(cvt_pk_bf16(b2 * 0.5f, 0.f) & 0xffffu); } }
#endif
        SEAM(pb + 2);
#ifdef DIAG_CKS
        if (l == 0 && PH(pb + 2)) { PHASE_BEGIN(); cks_rows((const unsigned*)ocat, 1024, MTOK, (unsigned*)(ws + WS_END + 2 * MiB), (unsigned*)(ws + WS_CTL) + 71, gw, NGW, lane); }
#endif
        if (EN(3) && PH(pb + 3)) PREP(3) {
            PHASE_BEGIN(); const bf16_t* Wl = Wall + (size_t)l * W_LAYER; (void)Wl;
            pg8::Gemm g{ocat, Wl + WO_BR, DM, DM, 1024}; pg8::GateOrder S; S.S.init(MTOK, DM, G, bx, DM, DM, WGM_N8); pg8::EpiGate2 E{gates, merged};
            pg8::gemm_phase<pg8::EpiGate2, pg8::GateOrder, true, true>(lds, g, S, E);
        }
        SEAM(pb + 3);
        if (EN(4) && PH(pb + 4)) PREP(4) {
            PHASE_BEGIN(); const bf16_t* Wl = Wall + (size_t)l * W_LAYER; (void)Wl;
            pg8::Gemm g{merged, Wl + WO_MIX, DM, DM, DM}; pg8::StaticOrder S; S.init(MTOK, DM, G, bx, DM, DM, WGM_N8); pg8::EpiBf16 E{YB, DM};
            pg8::gemm_phase<pg8::EpiBf16, pg8::StaticOrder, EPI_ALIGN, true>(lds, g, S, E);
        }
        SEAM(pb + 4);
#ifdef DIAG_CKS
        if (l == 0 && PH(pb + 4)) { PHASE_BEGIN(); cks_rows((const unsigned*)Y, 2048, MTOK, (unsigned*)(ws + WS_END + 4 * MiB), (unsigned*)(ws + WS_CTL) + 73, gw, NGW, lane); }
#endif
        if (EN(5) && PH(pb + 5)) { PHASE_BEGIN();
            thin_res_norm(YB, XB, g_post_mix + (size_t)l * DM, g_pre_x + (size_t)l * DM, H, gw, NGW, lane); }
        SEAM(pb + 5);
        if (EN(6) && PH(pb + 6)) PREP(6) {
            PHASE_BEGIN(); const bf16_t* Wl = Wall + (size_t)l * W_LAYER; (void)Wl;
            pg8::Gemm g{H, Wl + WO_WK, DM, DM, DM}; pg8::CrossSOrder S{G, bx}; pg8::EpiSoftmax E{Pm};
            pg8::gemm_phase<pg8::EpiSoftmax, pg8::CrossSOrder, false, true>(lds, g, S, E);
        }
        SEAM(pb + 6);
        if (EN(10) && PH(pb + 10)) PREP(10) {
            PHASE_BEGIN(); const bf16_t* Wl = Wall + (size_t)l * W_LAYER; (void)Wl;
            pg8::Gemm g{Pm, Wl + WO_VW, 1024, 1024, 1024}; pg8::CrossYOrder S{G, bx}; pg8::EpiBf16 E{YB, DM};
            pg8::gemm_phase<pg8::EpiBf16, pg8::CrossYOrder, EPI_ALIGN, true>(lds, g, S, E);
        }
        SEAM(pb + 10);
        if (EN(11) && PH(pb + 11)) { PHASE_BEGIN();
            thin_res_norm(YB, XB, g_post_x + (size_t)l * DM, g_pre_ffn + (size_t)l * DM, H, gw, NGW, lane); }
        SEAM(pb + 11);
        if (EN(12) && PH(pb + 12)) PREP(12) {
#if defined(PROBE_FLUSH) && PROBE_FLUSH == 1
            if (rep_ == 1) FLUSH_SWEEP();
#endif
            PHASE_BEGIN(); const bf16_t* Wl = Wall + (size_t)l * W_LAYER; (void)Wl;
            pg8::Gemm g{H, Wl + WO_UP, DM, DM, DM}; pg8::StaticOrder S; S.init(MTOK, NUP, G, bx, DM, DM);
            pg8::EpiConvGlu E{act, Y, conv_w + (size_t)l * 3 * NUP, conv_b + (size_t)l * NUP, lds + 132096};
            pg8::gemm_phase<pg8::EpiConvGlu, pg8::StaticOrder, true, true>(lds, g, S, E);
        }
#if defined(PROBE_FLUSH) && PROBE_FLUSH == 2
        if (PH(pb + 12)) FLUSH_SWEEP();
#endif
        SEAM(pb + 12);
        if (EN(13) && PH(pb + 13)) PREP(13) { PHASE_BEGIN(); thin_conv_fix(Y, act, conv_w + (size_t)l * 3 * NUP, conv_b + (size_t)l * NUP, gw, NGW, lane); }
        SEAM(pb + 13);
        if (EN(14) && PH(pb + 14)) PREP(14) {
            PHASE_BEGIN(); const bf16_t* Wl = Wall + (size_t)l * W_LAYER; (void)Wl;
            pg8::Gemm g{act, Wl + WO_DOWN, DFF, DFF, DFF}; pg8::StaticOrder S; S.init(MTOK, DM, G, bx, DFF, DFF, WGM_N8); pg8::EpiBf16 E{YB, DM};
            pg8::gemm_phase<pg8::EpiBf16, pg8::StaticOrder, EPI_ALIGN, true>(lds, g, S, E);
        }
        SEAM(pb + 14);
        if (EN(15) && PH(pb + 15)) { PHASE_BEGIN(); thin_res_norm(YB, XB, g_post_ffn + (size_t)l * DM, l + 1 < DEPTH ? g_pre_mix + (size_t)(l + 1) * DM : nullptr, H, gw, NGW, lane, l + 1 < DEPTH ? nullptr : X); }
        SEAM(pb + 15);
#ifdef DIAG_CKS
        if (l == DEPTH - 1 && PH(pb + 15)) { PHASE_BEGIN(); xcd_barrier(bar);
            const unsigned c65 = __hip_atomic_load((unsigned*)(ws + WS_CTL) + 65, __ATOMIC_RELAXED, __HIP_MEMORY_SCOPE_AGENT), c66 = __hip_atomic_load((unsigned*)(ws + WS_CTL) + 66, __ATOMIC_RELAXED, __HIP_MEMORY_SCOPE_AGENT),
                           c67 = __hip_atomic_load((unsigned*)(ws + WS_CTL) + 67, __ATOMIC_RELAXED, __HIP_MEMORY_SCOPE_AGENT);
            (void)c65; (void)c66; (void)c67; const unsigned c68 = __hip_atomic_load((unsigned*)(ws + WS_CTL) + 68, __ATOMIC_RELAXED, __HIP_MEMORY_SCOPE_AGENT), c69 = __hip_atomic_load((unsigned*)(ws + WS_CTL) + 69, __ATOMIC_RELAXED, __HIP_MEMORY_SCOPE_AGENT),
                           c70 = __hip_atomic_load((unsigned*)(ws + WS_CTL) + 70, __ATOMIC_RELAXED, __HIP_MEMORY_SCOPE_AGENT);
            (void)c68; (void)c69; (void)c70; (void)c66; (void)c67; const unsigned c71 = __hip_atomic_load((unsigned*)(ws + WS_CTL) + 71, __ATOMIC_RELAXED, __HIP_MEMORY_SCOPE_AGENT), c72 = __hip_atomic_load((unsigned*)(ws + WS_CTL) + 72, __ATOMIC_RELAXED, __HIP_MEMORY_SCOPE_AGENT),
                           c73 = __hip_atomic_load((unsigned*)(ws + WS_CTL) + 73, __ATOMIC_RELAXED, __HIP_MEMORY_SCOPE_AGENT);
            const float fac = 1.0f + (c71 ? 0.4f : 0.f) + (c72 ? 0.2f : 0.f) + (c73 ? 0.1f : 0.f);
            if (fac != 1.0f) { for (size_t i = (size_t)gw * 64 + lane; i < (size_t)MTOK * DM; i += (size_t)NGW * 64) X[i] *= fac; } }
#endif
#ifdef DIAG_SELFCHK
        if (l == DEPTH - 1 && PH(pb + 15)) { PHASE_BEGIN(); xcd_barrier(bar);
            if (__hip_atomic_load((unsigned*)(ws + WS_CTL) + 64, __ATOMIC_RELAXED, __HIP_MEMORY_SCOPE_AGENT) != 0u) {
                for (size_t i = (size_t)gw * 64 + lane; i < (size_t)MTOK * DM; i += (size_t)NGW * 64) X[i] = __builtin_nanf(""); } }
#endif
    }
#ifdef PROBE_WALL
    {
        PHASE_BEGIN(); asm volatile("s_waitcnt vmcnt(0)" ::: "memory"); __syncthreads(); WALL_TICK(NPH - 1);
        if (bx == 0 && tid == 0) { const unsigned ticks = MISC[14]; const unsigned long long t0 = __builtin_amdgcn_s_memrealtime();
            while ((unsigned)(__builtin_amdgcn_s_memrealtime() - t0) < ticks) __builtin_amdgcn_s_sleep(8); }
    }
#endif
#ifdef PROBE_BARWAIT
    {
        PHASE_BEGIN(); unsigned* ctl = (unsigned*)(ws + WS_CTL) + 80;
        if (tid == 0) __hip_atomic_fetch_add(ctl, MISC[10], __ATOMIC_RELAXED, __HIP_MEMORY_SCOPE_AGENT);
        xcd_barrier(bar);
        if (bx == 0 && tid == 0) {
            unsigned ticks = PROBE_BARWAIT == 0 ? __hip_atomic_load(ctl, __ATOMIC_RELAXED, __HIP_MEMORY_SCOPE_AGENT) / (unsigned)G : 0u;
            const unsigned long long t0 = __builtin_amdgcn_s_memrealtime();
            while ((unsigned)(__builtin_amdgcn_s_memrealtime() - t0) < ticks) __builtin_amdgcn_s_sleep(8);
        }
    }
#endif
#undef PH
#undef SEAM
}

extern "C" void kernel_launch(void* const* d_in, const int* in_sizes, int n_in, void* d_out, int out_size, void* d_ws, size_t ws_size, hipStream_t stream) {
    static int grid = 0;
    if (grid == 0) {
        if (n_in != 31 || in_sizes[0] != MTOK * DM || out_size != MTOK * DM || ws_size < WS_TOP) {
            fprintf(stderr, "kernel_launch: unexpected shapes: n_in %d in0 %d out %d ws %zu (need %zu)\n", n_in, n_in > 0 ? in_sizes[0] : -1, out_size, ws_size, (size_t)WS_TOP); grid = -1; return; }
        int dev = 0, cus = 0;
        if (hipGetDevice(&dev) != hipSuccess || hipDeviceGetAttribute(&cus, hipDeviceAttributeMultiprocessorCount, dev) != hipSuccess) { grid = -1; return; }
        if (hipFuncSetAttribute((const void*)fwd, hipFuncAttributeMaxDynamicSharedMemorySize, LDS_BYTES) != hipSuccess) { fprintf(stderr, "kernel_launch: hipFuncSetAttribute failed\n"); grid = -1; return; }
        int per_cu = 0;
        if (hipOccupancyMaxActiveBlocksPerMultiprocessor(&per_cu, (const void*)fwd, NWAVES * 64, LDS_BYTES) != hipSuccess || per_cu < 1)
            fprintf(stderr, "kernel_launch: note: occupancy query reports %d workgroups per CU\n", per_cu);
        (void)hipGetLastError();
        if (cus != 256) { fprintf(stderr, "kernel_launch: built for a 256-CU MI355X (one 256 x 256 score unit per workgroup in the fused softmax phase); this device reports %d CUs; nothing launched\n", cus); grid = -1; return; }
        grid = cus;
    }
    if (grid < 0) return;
    if (hipMemsetAsync((char*)d_ws + WS_CTL, 0, CTL_ZERO_BYTES, stream) != hipSuccess) return;
    Args a{};
    for (int i = 0; i < 31; ++i) a.in[i] = d_in[i];
    a.out = (float*)d_out; a.ws = (unsigned char*)d_ws;
    for (int l = 0; l < 4; ++l) a.lam_init[l] = (float)(0.8 - 0.6 * exp(-0.3 * (double)l));
    for (int i = 0; i < 32; ++i) a.inv_freq[i] = (float)pow(10000.0, -(double)i / 32.0);
#if MK_SINGLE
    a.ph_lo = 0; a.ph_hi = NPH;
    hipLaunchKernelGGL(fwd, dim3(grid), dim3(NWAVES * 64), LDS_BYTES, stream, a);
#else
    for (int p = 0; p < NPH; ++p) { a.ph_lo = p; a.ph_hi = p + 1; hipLaunchKernelGGL(fwd, dim3(grid), dim3(NWAVES * 64), LDS_BYTES, stream, a); }
#endif
    const hipError_t le = hipPeekAtLastError();
    if (le != hipSuccess) fprintf(stderr, "kernel_launch: launch failed: %s\n", hipGetErrorName(le));
}
```

```cpp
#define ATT_STATIC 1
#include <hip/hip_runtime.h>
#include <cstdio>
#include <cstdint>
#include <cmath>

#define LAS __attribute__((address_space(3)))
#define GAS __attribute__((address_space(1)))
typedef unsigned short bf16_t;
typedef short bf16x8 __attribute__((ext_vector_type(8)));
typedef short s16x4 __attribute__((ext_vector_type(4)));
typedef float f32x2 __attribute__((ext_vector_type(2)));
typedef float f32x4 __attribute__((ext_vector_type(4)));
typedef float f32x16 __attribute__((ext_vector_type(16)));
typedef unsigned u32x2 __attribute__((ext_vector_type(2)));
typedef unsigned u32x4 __attribute__((ext_vector_type(4)));

constexpr int DM = 2048, BATCH = 4, SEQ = 4096, DEPTH = 4, MTOK = BATCH * SEQ;
constexpr int NIN_SRC = 8000, NIN = 8192;
constexpr int DFF = 5632, NUP = 2 * DFF;
constexpr int MEMT = 256, MROWS = BATCH * MEMT;
constexpr float EPS = 1e-6f;
constexpr float LOG2E = 1.4426950408889634f;

typedef __bf16 bf16x2_t __attribute__((ext_vector_type(2)));
__device__ __forceinline__ unsigned cvt_pk_bf16(float lo, float hi) { const f32x2 v = {lo, hi}; const bf16x2_t b = __builtin_convertvector(v, bf16x2_t); return __builtin_bit_cast(unsigned, b); }
__device__ __forceinline__ u32x4 pack8(f32x4 a, f32x4 b) { u32x4 w; w.x = cvt_pk_bf16(a[0], a[1]); w.y = cvt_pk_bf16(a[2], a[3]); w.z = cvt_pk_bf16(b[0], b[1]); w.w = cvt_pk_bf16(b[2], b[3]); return w; }
__device__ __forceinline__ float bflo(unsigned w) { return __uint_as_float(w << 16); }
__device__ __forceinline__ float bfhi(unsigned w) { return __uint_as_float(w & 0xffff0000u); }
template <int O> __device__ __forceinline__ float xor_lt32(float v) { return __int_as_float(__builtin_amdgcn_ds_swizzle(__float_as_int(v), (O << 10) | 0x1f)); }
__device__ __forceinline__ float sum_xor32(float v) { auto rr = __builtin_amdgcn_permlane32_swap(__float_as_uint(v), __float_as_uint(v), false, false); return __uint_as_float(rr[0]) + __uint_as_float(rr[1]); }
__device__ __forceinline__ float max_xor32(float v) { auto rr = __builtin_amdgcn_permlane32_swap(__float_as_uint(v), __float_as_uint(v), false, false); return fmaxf(__uint_as_float(rr[0]), __uint_as_float(rr[1])); }
__device__ __forceinline__ float half_sum(float v) { v += xor_lt32<1>(v); v += xor_lt32<2>(v); v += xor_lt32<4>(v); v += xor_lt32<8>(v); v += xor_lt32<16>(v); return v; }
__device__ __forceinline__ float wave_sum(float v) { return sum_xor32(half_sum(v)); }
__device__ __forceinline__ float wave_max(float v) { v = fmaxf(v, xor_lt32<1>(v)); v = fmaxf(v, xor_lt32<2>(v)); v = fmaxf(v, xor_lt32<4>(v)); v = fmaxf(v, xor_lt32<8>(v)); v = fmaxf(v, xor_lt32<16>(v)); return max_xor32(v); }

template <int OFF> __device__ __forceinline__ void st16(void* p, u32x4 v) {
#ifdef WT_STORES
    asm volatile("global_store_dwordx4 %0, %1, off offset:%2 sc1\n\ts_nop 1" :: "v"(p), "v"(v), "n"(OFF));
#else
    *(u32x4*)((char*)p + OFF) = v;
#endif
}
__device__ __forceinline__ void st16bj(bf16_t* rowp, int bj, u32x4 v) { if (bj == 0) st16<0>(rowp, v); else st16<256>(rowp, v); }
namespace pg8 {
constexpr int BM = 256, BK = 64, HALF = 128, HTB = HALF * BK * 2  , STAGE_BYTES = 8 * HTB, NXCD = 8, WGM = 8;

__host__ __device__ __forceinline__ int lds_byte(int r, int c) { const int st = (r >> 4) * 2 + (c >> 5), rr = r & 15, cc = c & 31, ob = rr * 64 + cc * 2; return st * 1024 + (ob ^ (((ob >> 9) & 1) << 5)); }
__host__ __device__ __forceinline__ void stage_rc(int b, int& R, int& C) { const int st = b / 1024, sb = b % 1024, swz = sb ^ (((sb >> 9) & 1) << 5); R = (st >> 1) * 16 + swz / 64; C = (st & 1) * 32 + (swz % 64) / 2; }
__host__ __device__ __forceinline__ int perm32(int rho) { const int n = rho >> 4, i = rho & 15; return 8 * (i >> 2) + 4 * n + (i & 3); }

template <class E> struct RowPerm { static constexpr bool v = false; };
struct Unit { int pm, pn, z; unsigned aoff, boff; };
struct Gemm { const bf16_t* A; const bf16_t* Bt; int lda, ldb, K; };

struct StaticOrder {
    int nM, nN, nwg, G, c, lda, ldb, wgm;
    __host__ __device__ __forceinline__ void init(int Mr, int N, int G_, int c_, int lda_, int ldb_, int wgm_ = WGM) { nM = Mr / BM; nN = N / BM; nwg = nM * nN; G = G_; c = c_; lda = lda_; ldb = ldb_; wgm = wgm_; }
    __host__ __device__ __forceinline__ bool next(int i, Unit& u) const {
        const long L = (long)i * G + c; if (L >= nwg) return false;
        int wgid = (int)L; { const int q = nwg / NXCD, r = nwg % NXCD, xcd = wgid % NXCD, off = wgid / NXCD; wgid = (xcd < r ? xcd * (q + 1) : r * (q + 1) + (xcd - r) * q) + off; }
        const int nig = wgm * nN, gid = wgid / nig, fm = gid * wgm, gsz = (nM - fm) < wgm ? (nM - fm) : wgm;
        u.pm = fm + ((wgid % nig) % gsz); u.pn = (wgid % nig) / gsz; u.z = 0;
        u.aoff = (unsigned)u.pm * (unsigned)(BM * lda); u.boff = (unsigned)u.pn * (unsigned)(BM * ldb); return true;
    }
    __device__ __forceinline__ void a_ready(const Unit&) const {}
    __device__ __forceinline__ void done(const Unit&) const {}
};

typedef f32x4 Acc[2][2][4][2];

template <class Epi, class Sched, bool ALIGN_EPI = false, bool SP2 = false>
__device__ __forceinline__ void gemm_phase(LAS unsigned char* lds, const Gemm g, const Sched& S, const Epi& E) {
    int tid = threadIdx.x; asm volatile("" : "+v"(tid));
    const int wid = __builtin_amdgcn_readfirstlane(tid >> 6), lane = tid & 63, wr = wid >> 2, wc = wid & 3, fr = lane & 15, fq = lane >> 4;
    int K = g.K; asm volatile("" : "+s"(K));
    const int nt = K / BK;
    unsigned voffA[2], voffB[2];
#pragma unroll
    for (int i = 0; i < 2; ++i) { int R, C; stage_rc(tid * 16 + i * 8192, R, C); const int Rb = Epi::PERM ? ((R & ~31) + perm32(R & 31)) : R;
        const int Ra = RowPerm<Epi>::v ? ((R & ~63) + 4 * (R & 15) + ((R >> 4) & 3)) : R;
        voffA[i] = (unsigned)(Ra * g.lda + C) * 2u; voffB[i] = (unsigned)(Rb * g.ldb + C) * 2u; }
    const size_t kstep = (size_t)(BK * 2);
    const size_t hstepA = (size_t)HALF * g.lda * 2, hstepB = (size_t)HALF * g.ldb * 2;
    const unsigned ldsw = (unsigned)wid * 1024u;
    const int aoff = lds_byte(wr * 64 + fr, fq * 8), boff = lds_byte(wc * 32 + fr, fq * 8);
#define PG8_SA(b, h) (((b) * 2 + (h)) * HTB)
#define PG8_SB(b, h) ((4 + (b) * 2 + (h)) * HTB)
#define PG8_STAGE(bufoff, gbase, voff) do { _Pragma("unroll") for (int _i = 0; _i < 2; ++_i) \
        __builtin_amdgcn_global_load_lds((const unsigned*)((const char*)(gbase) + (voff)[_i]), (LAS unsigned*)(lds + (bufoff) + ldsw + _i * 8192), 16, 0, 0); } while (0)
#define PG8_LDA(dst, b, h) do { _Pragma("unroll") for (int m = 0; m < 4; ++m) _Pragma("unroll") for (int k = 0; k < 2; ++k) dst[m][k] = *(const LAS bf16x8*)(lds + PG8_SA(b, h) + aoff + m * 2048 + k * 1024); } while (0)
#define PG8_LDB(dst, b, h) do { _Pragma("unroll") for (int n = 0; n < 2; ++n) _Pragma("unroll") for (int k = 0; k < 2; ++k) dst[n][k] = *(const LAS bf16x8*)(lds + PG8_SB(b, h) + boff + n * 2048 + k * 1024); } while (0)
#define PG8_MMA(ai, bj, At, Bt) do { __builtin_amdgcn_s_setprio(1); _Pragma("unroll") for (int m = 0; m < 4; ++m) _Pragma("unroll") for (int n = 0; n < 2; ++n) _Pragma("unroll") for (int k = 0; k < 2; ++k) \
        acc[ai][bj][m][n] = __builtin_amdgcn_mfma_f32_16x16x32_bf16(Bt[n][k], At[m][k], acc[ai][bj][m][n], 0, 0, 0); __builtin_amdgcn_s_setprio(0); } while (0)
#define PG8_WAIT_V(n) asm volatile("s_waitcnt vmcnt(" #n ")" ::: "memory")
#define PG8_WAIT_L(n) asm volatile("s_waitcnt lgkmcnt(" #n ")" ::: "memory")
#define PG8_BAR __builtin_amdgcn_s_barrier()
#define PG8_SCHED __builtin_amdgcn_sched_barrier(0)
    Unit cur, nxt; int ui = 0;
    if (!S.next(0, cur)) return;
    f32x4 acc[2][2][4][2];
#pragma unroll
    for (int a = 0; a < 2; ++a)
#pragma unroll
        for (int b = 0; b < 2; ++b)
#pragma unroll
            for (int m = 0; m < 4; ++m)
#pragma unroll
                for (int n = 0; n < 2; ++n) acc[a][b][m][n] = (f32x4){0.f, 0.f, 0.f, 0.f};
    bf16x8 At[4][2], B0[2][2], B1[2][2];
    const char* cA = (const char*)g.A + (size_t)cur.aoff * 2; const char* cB = (const char*)g.Bt + (size_t)cur.boff * 2;
    S.a_ready(cur);
    if constexpr (SP2) {
        PG8_STAGE(PG8_SB(0, 0), cB, voffB); PG8_STAGE(PG8_SB(0, 1), cB + hstepB, voffB); PG8_STAGE(PG8_SA(0, 0), cA, voffA); PG8_STAGE(PG8_SA(0, 1), cA + hstepA, voffA);
        if (wr == 1) PG8_BAR;
        PG8_WAIT_V(2); PG8_BAR;
        PG8_STAGE(PG8_SB(1, 0), cB + kstep, voffB); PG8_STAGE(PG8_SA(1, 0), cA + kstep, voffA); PG8_STAGE(PG8_SB(1, 1), cB + hstepB + kstep, voffB);
        PG8_WAIT_V(6); PG8_BAR;
    } else {
        PG8_STAGE(PG8_SB(0, 0), cB, voffB); PG8_STAGE(PG8_SA(0, 0), cA, voffA); PG8_STAGE(PG8_SB(0, 1), cB + hstepB, voffB); PG8_STAGE(PG8_SA(0, 1), cA + hstepA, voffA);
        if (wr == 1) PG8_BAR;
        PG8_WAIT_V(4); PG8_BAR;
        PG8_STAGE(PG8_SB(1, 0), cB + kstep, voffB); PG8_STAGE(PG8_SA(1, 0), cA + kstep, voffA); PG8_STAGE(PG8_SB(1, 1), cB + hstepB + kstep, voffB);
        PG8_WAIT_V(6); PG8_BAR;
    }
    for (;;) {
        const bool has_next = S.next(ui + 1, nxt);
        const char* nA = has_next ? (const char*)g.A + (size_t)nxt.aoff * 2 : cA; const char* nB = has_next ? (const char*)g.Bt + (size_t)nxt.boff * 2 : cB;
        for (int t = 0; t < nt; t += 2) {
            const bool last = (t == nt - 2);
            const char* a1 = cA + (size_t)(t + 1) * kstep;
            const char* a2 = last ? nA : cA + (size_t)(t + 2) * kstep; const char* b2 = last ? nB : cB + (size_t)(t + 2) * kstep;
            const char* a3 = a2 + kstep; const char* b3 = b2 + kstep;
            if (last && has_next) S.a_ready(nxt);
            if constexpr (SP2) {
            PG8_LDB(B0, 0, 0); PG8_LDB(B1, 0, 1); PG8_SCHED; PG8_LDA(At, 0, 0); PG8_STAGE(PG8_SA(1, 1), a1 + hstepA, voffA);
            PG8_WAIT_V(8); PG8_WAIT_L(0); PG8_BAR; PG8_MMA(0, 0, At, B0); PG8_MMA(0, 1, At, B1); PG8_BAR; PG8_SCHED;
            PG8_LDA(At, 0, 1); PG8_STAGE(PG8_SB(0, 0), b2, voffB); PG8_STAGE(PG8_SB(0, 1), b2 + hstepB, voffB); PG8_STAGE(PG8_SA(0, 0), a2, voffA);
            PG8_WAIT_V(8); PG8_WAIT_L(0); PG8_BAR; PG8_MMA(1, 0, At, B0); PG8_MMA(1, 1, At, B1); PG8_BAR; PG8_SCHED;
            PG8_LDB(B0, 1, 0); PG8_LDB(B1, 1, 1); PG8_SCHED; PG8_LDA(At, 1, 0); PG8_STAGE(PG8_SA(0, 1), a2 + hstepA, voffA);
            PG8_WAIT_V(8); PG8_WAIT_L(0); PG8_BAR; PG8_MMA(0, 0, At, B0); PG8_MMA(0, 1, At, B1); PG8_BAR; PG8_SCHED;
            PG8_LDA(At, 1, 1); PG8_STAGE(PG8_SB(1, 0), b3, voffB); PG8_STAGE(PG8_SB(1, 1), b3 + hstepB, voffB); PG8_STAGE(PG8_SA(1, 0), a3, voffA);
            PG8_WAIT_V(8); PG8_WAIT_L(0); PG8_BAR; PG8_MMA(1, 0, At, B0); PG8_MMA(1, 1, At, B1); PG8_BAR; PG8_SCHED;
            } else {
            PG8_LDB(B0, 0, 0); PG8_SCHED; PG8_LDA(At, 0, 0); PG8_STAGE(PG8_SA(1, 1), a1 + hstepA, voffA);
            PG8_WAIT_L(8); PG8_BAR; PG8_WAIT_L(0); PG8_MMA(0, 0, At, B0); PG8_BAR; PG8_SCHED;
            PG8_LDB(B1, 0, 1); PG8_STAGE(PG8_SB(0, 0), b2, voffB);
            PG8_BAR; PG8_WAIT_L(0); PG8_MMA(0, 1, At, B1); PG8_BAR;
            PG8_LDA(At, 0, 1); PG8_STAGE(PG8_SA(0, 0), a2, voffA);
            PG8_BAR; PG8_WAIT_L(0); PG8_MMA(1, 0, At, B0); PG8_BAR; PG8_SCHED;
            PG8_STAGE(PG8_SB(0, 1), b2 + hstepB, voffB);
            PG8_WAIT_V(6); PG8_BAR; PG8_MMA(1, 1, At, B1); PG8_BAR;
            PG8_LDB(B0, 1, 0); PG8_SCHED; PG8_LDA(At, 1, 0); PG8_STAGE(PG8_SA(0, 1), a2 + hstepA, voffA);
            PG8_WAIT_L(8); PG8_BAR; PG8_WAIT_L(0); PG8_MMA(0, 0, At, B0); PG8_BAR; PG8_SCHED;
            PG8_LDB(B1, 1, 1); PG8_STAGE(PG8_SB(1, 0), b3, voffB);
            PG8_BAR; PG8_WAIT_L(0); PG8_MMA(0, 1, At, B1); PG8_BAR;
            PG8_LDA(At, 1, 1); PG8_STAGE(PG8_SA(1, 0), a3, voffA);
            PG8_BAR; PG8_WAIT_L(0); PG8_MMA(1, 0, At, B0); PG8_BAR; PG8_SCHED;
            PG8_STAGE(PG8_SB(1, 1), b3 + hstepB, voffB);
            PG8_WAIT_V(6); PG8_BAR; PG8_MMA(1, 1, At, B1); PG8_BAR;
            }
        }
        if constexpr (ALIGN_EPI) { if (wr == 0) PG8_BAR; }
        if constexpr (!Epi::AFTER_DRAIN) { E(acc, cur, wr, wc, fr, fq); S.done(cur); }
        if (!has_next) break;
        if (!(Epi::MIDK && cur.z == 0)) {
#pragma unroll
        for (int a = 0; a < 2; ++a)
#pragma unroll
            for (int b = 0; b < 2; ++b)
#pragma unroll
                for (int m = 0; m < 4; ++m)
#pragma unroll
                    for (int n = 0; n < 2; ++n) acc[a][b][m][n] = (f32x4){0.f, 0.f, 0.f, 0.f};
        }
        cur = nxt; cA = nA; cB = nB; ++ui;
        if constexpr (ALIGN_EPI) { if (wr == 1) PG8_BAR; }
    }
    PG8_WAIT_V(0);
    if constexpr (!ALIGN_EPI) { if (wr == 0) PG8_BAR; }
    PG8_BAR;
    if constexpr (Epi::AFTER_DRAIN) { E.fused(acc, cur, wr, wc, fr, fq, lds, wid, lane); S.done(cur); }
#undef PG8_SA
#undef PG8_SB
#undef PG8_STAGE
#undef PG8_LDA
#undef PG8_LDB
#undef PG8_MMA
#undef PG8_WAIT_V
#undef PG8_WAIT_L
#undef PG8_BAR
#undef PG8_SCHED
}
}
constexpr size_t MiB = (size_t)1 << 20;
constexpr size_t WO_IN = 0;
constexpr size_t WO_UQ = WO_IN + (size_t)NIN * DM;
constexpr size_t WO_UKV = WO_UQ + (size_t)1536 * 512;
constexpr size_t WO_BR = WO_UKV + (size_t)2048 * 256;
constexpr size_t WO_MIX = WO_BR + (size_t)DM * DM;
constexpr size_t WO_WK = WO_MIX + (size_t)DM * DM;
constexpr size_t WO_VW = WO_WK + (size_t)BATCH * 1024 * DM;
constexpr size_t WO_UP = WO_VW + (size_t)BATCH * DM * 1024;
constexpr size_t WO_DOWN = WO_UP + (size_t)NUP * DM;
constexpr size_t W_LAYER = WO_DOWN + (size_t)DM * DFF;
static_assert(W_LAYER * 2 == 297 * MiB / 2, "layer blob size");

constexpr size_t WS_CTL = 0, CTL_ZERO_BYTES = 1 * MiB;
constexpr size_t WS_CS = 1 * MiB;
constexpr size_t WS_SSQ_CQ = 5 * MiB;
constexpr size_t WS_SSQ_CKV = WS_SSQ_CQ + (size_t)MTOK * 8 * 4;
constexpr size_t WS_W = 38 * MiB;
constexpr size_t WS_H = WS_W + 4 * W_LAYER * 2;
constexpr size_t WS_RA = WS_H + 64 * MiB;
constexpr size_t WS_RB = WS_RA + 352 * MiB;
constexpr size_t WS_RC = WS_RB + 176 * MiB;
constexpr size_t WS_END = WS_RC + 128 * MiB;
constexpr size_t WS_SCR = WS_END, WS_TOP = WS_END + 32 * MiB;
static_assert(WS_H == 632 * MiB, "ws map");
constexpr size_t RA_QD = WS_RA, RA_KD = WS_RA + 32 * MiB, RA_VD = WS_RA + 64 * MiB, RA_CQ = WS_RA + 96 * MiB, RA_CKV = WS_RA + 112 * MiB, RA_KPE = WS_RA + 120 * MiB,
                 RA_GATES = WS_RA + 128 * MiB, RA_MERGED = WS_RA + 256 * MiB;
constexpr size_t RA_QX = WS_RA, RA_S = WS_RA + 64 * MiB, RA_P = WS_RA + 128 * MiB, RA_OX = WS_RA + 160 * MiB;
constexpr size_t RA_U = WS_RA;
constexpr size_t RA_QXP = WS_RA, RA_KVXT = WS_RA + 32 * MiB, RA_OXT = WS_RA + 96 * MiB, RA_MEMN = WS_RA + 128 * MiB, RA_KMEM = WS_RA + 144 * MiB, RA_VMEM = WS_RA + 160 * MiB;
constexpr size_t RB_QM = WS_RB, RB_KN = WS_RB + 48 * MiB, RB_VM = WS_RB + 80 * MiB, RB_OCAT = WS_RB + 112 * MiB;
constexpr size_t RB_ACT = WS_RB;
constexpr size_t RC_Y = WS_RC;

constexpr int CW_BAR = 4096;

namespace pg8 {
__device__ __forceinline__ void rope8(f32x4& v0, f32x4& v1, const f32x2* csp) {
    const f32x4 c01 = *(const f32x4*)csp, c23 = *(const f32x4*)(csp + 2);
    const f32x4 a = v0, b = v1;
    v0[0] = a[0] * c01[0] - a[1] * c01[1]; v0[1] = a[1] * c01[0] + a[0] * c01[1];
    v0[2] = a[2] * c01[2] - a[3] * c01[3]; v0[3] = a[3] * c01[2] + a[2] * c01[3];
    v1[0] = b[0] * c23[0] - b[1] * c23[1]; v1[1] = b[1] * c23[0] + b[0] * c23[1];
    v1[2] = b[2] * c23[2] - b[3] * c23[3]; v1[3] = b[3] * c23[2] + b[2] * c23[3];
}
__device__ __forceinline__ float sigm(float v) { return __builtin_amdgcn_rcpf(1.0f + __builtin_amdgcn_exp2f(-v * LOG2E)); }
__device__ __forceinline__ float sq8(u32x4 w) { const float a = bflo(w.x), b = bfhi(w.x), c = bflo(w.y), d = bfhi(w.y), e = bflo(w.z), f = bfhi(w.z), g = bflo(w.w), h = bfhi(w.w);
    return ((a * a + b * b) + (c * c + d * d)) + ((e * e + f * f) + (g * g + h * h)); }

struct EpiProj {
    static constexpr bool PERM = true, AFTER_DRAIN = false, MIDK = false;
    bf16_t *Qd, *Kd, *Vd, *cq, *ckv, *kpe, *gates; float *ssq_cq, *ssq_ckv; const float* bgate; const f32x2* cs;
    __device__ __forceinline__ void operator()(const Acc& acc, const Unit& u, int wr, int wc, int fr, int fq) const {
        const int pn = u.pn, row0 = u.pm * BM + wr * 64 + fr, cb = wc * 32 + 8 * fq;
        if (pn >= 16) {
            const int colt = (pn - 16) * 256 + cb;
            f32x4 bv[2][2];
#pragma unroll
            for (int bj = 0; bj < 2; ++bj)
#pragma unroll
                for (int n = 0; n < 2; ++n) bv[bj][n] = *(const f32x4*)(bgate + colt + bj * HALF + 4 * n) * -LOG2E;
#pragma unroll
            for (int ai = 0; ai < 2; ++ai)
#pragma unroll
                for (int m = 0; m < 4; ++m) { bf16_t* rowp = gates + (size_t)(row0 + ai * HALF + m * 16) * 4096 + colt;
#pragma unroll
                    for (int bj = 0; bj < 2; ++bj) { f32x4 v0 = acc[ai][bj][m][0] * -LOG2E + bv[bj][0], v1 = acc[ai][bj][m][1] * -LOG2E + bv[bj][1];
#pragma unroll
                        for (int e = 0; e < 4; ++e) { v0[e] = __builtin_amdgcn_rcpf(1.0f + __builtin_amdgcn_exp2f(v0[e])); v1[e] = __builtin_amdgcn_rcpf(1.0f + __builtin_amdgcn_exp2f(v1[e])); }
                        st16bj(rowp, bj, pack8(v0, v1)); } }
        } else if (pn >= 8 && pn < 15) {
            bf16_t* base; int ld, colt; float* ssq = nullptr; int ssld = 0, sslot = 0;
            if (pn < 12) { base = Vd; ld = 1024; colt = (pn - 8) * 256; }
            else if (pn < 14) { base = cq; ld = 512; colt = (pn - 12) * 256; ssq = ssq_cq; ssld = 8; sslot = (pn - 12) * 4 + wc; }
            else { base = ckv; ld = 256; colt = 0; ssq = ssq_ckv; ssld = 4; sslot = wc; }
            colt += cb;
#pragma unroll
            for (int ai = 0; ai < 2; ++ai)
#pragma unroll
                for (int m = 0; m < 4; ++m) { const int row = row0 + ai * HALF + m * 16; bf16_t* rowp = base + (size_t)row * ld + colt; float ss = 0.f;
#pragma unroll
                    for (int bj = 0; bj < 2; ++bj) { const u32x4 w = pack8(acc[ai][bj][m][0], acc[ai][bj][m][1]); st16bj(rowp, bj, w); ss += sq8(w); }
                    if (ssq) { ss += xor_lt32<16>(ss); ss = sum_xor32(ss); if (fq == 0) ssq[(size_t)row * ssld + sslot] = ss; } }
        } else {
            bf16_t* base; int ld, colt;
            if (pn < 4) { base = Qd; ld = 1024; colt = pn * 256; } else if (pn < 8) { base = Kd; ld = 1024; colt = (pn - 4) * 256; } else { base = kpe; ld = 64; colt = 0; }
            colt += cb;
#pragma unroll
            for (int ai = 0; ai < 2; ++ai)
#pragma unroll
                for (int m = 0; m < 4; ++m) { const int row = row0 + ai * HALF + m * 16; bf16_t* rowp = base + (size_t)row * ld + colt; const f32x2* csr = cs + (size_t)row * 32;
#pragma unroll
                    for (int bj = 0; bj < 2; ++bj) { const int col = colt + bj * HALF;
                        if (pn == 15 && col >= 64) continue;
                        f32x4 v0 = acc[ai][bj][m][0], v1 = acc[ai][bj][m][1]; rope8(v0, v1, csr + ((col & 63) >> 1));
                        st16bj(rowp, bj, pack8(v0, v1)); } }
        }
    }
};
struct EpiQm {
    static constexpr bool PERM = true, AFTER_DRAIN = false, MIDK = false;
    bf16_t* Qm; const float* ssq; const f32x2* cs;
    __device__ __forceinline__ void operator()(const Acc& acc, const Unit& u, int wr, int wc, int fr, int fq) const {
        const int row0 = u.pm * BM + wr * 64 + fr, colt = u.pn * BM + wc * 32 + 8 * fq;
#pragma unroll
        for (int ai = 0; ai < 2; ++ai)
#pragma unroll
            for (int m = 0; m < 4; ++m) { const int row = row0 + ai * HALF + m * 16;
                const f32x4 s0 = *(const f32x4*)(ssq + (size_t)row * 8), s1 = *(const f32x4*)(ssq + (size_t)row * 8 + 4);
                const float rs = __builtin_amdgcn_rsqf((((s0[0] + s0[1]) + (s0[2] + s0[3])) + ((s1[0] + s1[1]) + (s1[2] + s1[3]))) * (1.0f / 512.0f) + EPS);
                bf16_t* rowp = Qm + (size_t)row * 1536 + colt; const f32x2* csr = cs + (size_t)row * 32;
#pragma unroll
                for (int bj = 0; bj < 2; ++bj) { const int col = colt + bj * HALF, r = col % 192;
                    f32x4 v0 = acc[ai][bj][m][0] * rs, v1 = acc[ai][bj][m][1] * rs;
                    if (r >= 128) rope8(v0, v1, csr + ((r - 128) >> 1));
                    st16bj(rowp, bj, pack8(v0, v1)); } }
    }
};
struct EpiKv {
    static constexpr bool PERM = true, AFTER_DRAIN = false, MIDK = false;
    bf16_t *Kn, *Vm; const float* ssq;
    __device__ __forceinline__ void operator()(const Acc& acc, const Unit& u, int wr, int wc, int fr, int fq) const {
        const int row0 = u.pm * BM + wr * 64 + fr; int colt = u.pn * BM; bf16_t* base = Kn; if (colt >= 1024) { base = Vm; colt -= 1024; } colt += wc * 32 + 8 * fq;
#pragma unroll
        for (int ai = 0; ai < 2; ++ai)
#pragma unroll
            for (int m = 0; m < 4; ++m) { const int row = row0 + ai * HALF + m * 16; const f32x4 s = *(const f32x4*)(ssq + (size_t)row * 4);
                const float rs = __builtin_amdgcn_rsqf(((s[0] + s[1]) + (s[2] + s[3])) * (1.0f / 256.0f) + EPS); bf16_t* rowp = base + (size_t)row * 1024 + colt;
#pragma unroll
                for (int bj = 0; bj < 2; ++bj) st16bj(rowp, bj, pack8(acc[ai][bj][m][0] * rs, acc[ai][bj][m][1] * rs)); }
    }
};
template <int MODE> struct EpiGate {
    static constexpr bool PERM = true, AFTER_DRAIN = false, MIDK = false;
    const bf16_t* gates; float* t; bf16_t* merged;
    __device__ __forceinline__ void operator()(const Acc& acc, const Unit& u, int wr, int wc, int fr, int fq) const {
        const int row0 = u.pm * BM + wr * 64 + fr, colt = u.pn * BM + wc * 32 + 8 * fq;
#pragma unroll
        for (int ai = 0; ai < 2; ++ai)
#pragma unroll
            for (int m = 0; m < 4; ++m) { const size_t row = (size_t)(row0 + ai * HALF + m * 16);
#pragma unroll
                for (int bj = 0; bj < 2; ++bj) { const int col = colt + bj * HALF;
                    const u32x4 gw = *(const u32x4*)(gates + row * 4096 + MODE * 2048 + col);
                    const f32x4 g0 = (f32x4){bflo(gw.x), bfhi(gw.x), bflo(gw.y), bfhi(gw.y)}, g1 = (f32x4){bflo(gw.z), bfhi(gw.z), bflo(gw.w), bfhi(gw.w)};
                    float* tp = t + row * 2048 + col;
                    if (MODE == 0) { const f32x4 s0 = acc[ai][bj][m][0] * g0, s1 = acc[ai][bj][m][1] * g1; unsigned long long* tq = (unsigned long long*)tp;
                        __hip_atomic_store(tq, ((unsigned long long)__float_as_uint(s0[1]) << 32) | __float_as_uint(s0[0]), __ATOMIC_RELAXED, __HIP_MEMORY_SCOPE_AGENT);
                        __hip_atomic_store(tq + 1, ((unsigned long long)__float_as_uint(s0[3]) << 32) | __float_as_uint(s0[2]), __ATOMIC_RELAXED, __HIP_MEMORY_SCOPE_AGENT);
                        __hip_atomic_store(tq + 2, ((unsigned long long)__float_as_uint(s1[1]) << 32) | __float_as_uint(s1[0]), __ATOMIC_RELAXED, __HIP_MEMORY_SCOPE_AGENT);
                        __hip_atomic_store(tq + 3, ((unsigned long long)__float_as_uint(s1[3]) << 32) | __float_as_uint(s1[2]), __ATOMIC_RELAXED, __HIP_MEMORY_SCOPE_AGENT); }
                    else { f32x4 t0, t1;
                        { const unsigned long long* tq = (const unsigned long long*)tp;
                          const unsigned long long w0 = __hip_atomic_load(tq, __ATOMIC_RELAXED, __HIP_MEMORY_SCOPE_AGENT), w1 = __hip_atomic_load(tq + 1, __ATOMIC_RELAXED, __HIP_MEMORY_SCOPE_AGENT),
                                                   w2 = __hip_atomic_load(tq + 2, __ATOMIC_RELAXED, __HIP_MEMORY_SCOPE_AGENT), w3 = __hip_atomic_load(tq + 3, __ATOMIC_RELAXED, __HIP_MEMORY_SCOPE_AGENT);
                          t0 = (f32x4){__uint_as_float((unsigned)w0), __uint_as_float((unsigned)(w0 >> 32)), __uint_as_float((unsigned)w1), __uint_as_float((unsigned)(w1 >> 32))};
                          t1 = (f32x4){__uint_as_float((unsigned)w2), __uint_as_float((unsigned)(w2 >> 32)), __uint_as_float((unsigned)w3), __uint_as_float((unsigned)(w3 >> 32))}; }
                        const f32x4 a0 = t0 + acc[ai][bj][m][0] * g0, a1 = t1 + acc[ai][bj][m][1] * g1;
                        *(u32x4*)(merged + row * 2048 + col) = pack8(a0, a1); } } }
    }
};
template <int CTRL> __device__ __forceinline__ float dppk(float old, float src) { return __builtin_bit_cast(float, __builtin_amdgcn_update_dpp(__builtin_bit_cast(int, old), __builtin_bit_cast(int, src), CTRL, 0xf, 0xf, false)); }
#define CT_ONE(c, x, p, w1, w0) \
    "v_fmac_f32_dpp " c ", " x ", " w1 " row_shr:1 row_mask:0xf bank_mask:0xf bound_ctrl:0\n\t" \
    "v_fmac_f32_dpp " c ", " x ", " w0 " row_shr:2 row_mask:0xf bank_mask:0xf bound_ctrl:0\n\t" \
    "v_fmac_f32_dpp " c ", " p ", " w1 " row_shl:15 row_mask:0xf bank_mask:0xf bound_ctrl:0\n\t" \
    "v_fmac_f32_dpp " c ", " p ", " w0 " row_shl:14 row_mask:0xf bank_mask:0xf bound_ctrl:0\n\t"
__device__ __forceinline__ void conv_taps(f32x4& c, const f32x4& x, const f32x4& p, const f32x4& w1, const f32x4& w0) {
    float c0 = c[0], c1 = c[1], c2 = c[2], c3 = c[3];
    asm("s_nop 1\n\t"
        CT_ONE("%0", "%4", "%8", "%12", "%16") CT_ONE("%1", "%5", "%9", "%13", "%17") CT_ONE("%2", "%6", "%10", "%14", "%18") CT_ONE("%3", "%7", "%11", "%15", "%19")
        : "+v"(c0), "+v"(c1), "+v"(c2), "+v"(c3)
        : "v"(x[0]), "v"(x[1]), "v"(x[2]), "v"(x[3]), "v"(p[0]), "v"(p[1]), "v"(p[2]), "v"(p[3]), "v"(w1[0]), "v"(w1[1]), "v"(w1[2]), "v"(w1[3]), "v"(w0[0]), "v"(w0[1]), "v"(w0[2]), "v"(w0[3]));
    c = (f32x4){c0, c1, c2, c3};
}
#ifndef CONV_V1
#define CT2_ONE(c1, c0, x3, x2, w1, w0) \
    "v_fmac_f32_dpp " c1 ", " x3 ", " w0 " row_shr:1 row_mask:0xf bank_mask:0xf bound_ctrl:0\n\t" \
    "v_fmac_f32_dpp " c0 ", " x3 ", " w1 " row_shr:1 row_mask:0xf bank_mask:0xf bound_ctrl:0\n\t" \
    "v_fmac_f32_dpp " c0 ", " x2 ", " w0 " row_shr:1 row_mask:0xf bank_mask:0xf bound_ctrl:0\n\t"
__device__ __forceinline__ void conv_taps2(f32x4& c1, f32x4& c0, const f32x4& x3, const f32x4& x2, const f32x4& w1, const f32x4& w0) {
    float a0 = c1[0], a1 = c1[1], a2 = c1[2], a3 = c1[3], b0 = c0[0], b1 = c0[1], b2 = c0[2], b3 = c0[3];
    asm("s_nop 1\n\t"
        CT2_ONE("%0", "%4", "%8", "%12", "%16", "%20") CT2_ONE("%1", "%5", "%9", "%13", "%17", "%21") CT2_ONE("%2", "%6", "%10", "%14", "%18", "%22") CT2_ONE("%3", "%7", "%11", "%15", "%19", "%23")
        : "+v"(a0), "+v"(a1), "+v"(a2), "+v"(a3), "+v"(b0), "+v"(b1), "+v"(b2), "+v"(b3)
        : "v"(x3[0]), "v"(x3[1]), "v"(x3[2]), "v"(x3[3]), "v"(x2[0]), "v"(x2[1]), "v"(x2[2]), "v"(x2[3]),
          "v"(w1[0]), "v"(w1[1]), "v"(w1[2]), "v"(w1[3]), "v"(w0[0]), "v"(w0[1]), "v"(w0[2]), "v"(w0[3]));
    c1 = (f32x4){a0, a1, a2, a3}; c0 = (f32x4){b0, b1, b2, b3};
}
struct EpiConvGlu {
    static constexpr bool PERM = true, AFTER_DRAIN = false, MIDK = false;
    bf16_t* act; float* U4; const float* cw; const float* cb; LAS unsigned char* xl;
    __device__ __forceinline__ void operator()(const Acc& acc, const Unit& u, int wr, int wc, int fr, int fq) const {
        const int wid = wr * 4 + wc, cu = u.pn * BM + wc * 32 + 8 * fq;
        if (fr == 15) {
#pragma unroll
            for (int ai = 0; ai < 2; ++ai)
#pragma unroll
                for (int rs = 0; rs < 2; ++rs)
#pragma unroll
                    for (int bj = 0; bj < 2; ++bj)
#pragma unroll
                        for (int n = 0; n < 2; ++n) *(LAS f32x4*)(xl + ((((wid * 2 + ai) * 2 + rs) * 64 + bj * 32 + fq * 8 + n * 4) * 4)) = acc[ai][bj][2 + rs][n];
        }
        if (wr == 0 && fr == 0) {
#pragma unroll
            for (int k = 0; k < 2; ++k)
#pragma unroll
                for (int bj = 0; bj < 2; ++bj)
#pragma unroll
                    for (int n = 0; n < 2; ++n) *(f32x4*)(U4 + ((size_t)(u.pm * 4 + k) * NUP + cu + bj * HALF + n * 4)) = acc[0][bj][k][n];
        }
        if (wr == 1 && fr == 15) {
#pragma unroll
            for (int k = 0; k < 2; ++k)
#pragma unroll
                for (int bj = 0; bj < 2; ++bj)
#pragma unroll
                    for (int n = 0; n < 2; ++n) *(f32x4*)(U4 + ((size_t)(u.pm * 4 + 2 + k) * NUP + cu + bj * HALF + n * 4)) = acc[1][bj][2 + k][n];
        }
        asm volatile("s_waitcnt lgkmcnt(0)" ::: "memory"); __builtin_amdgcn_s_barrier(); asm volatile("" ::: "memory");
#pragma unroll
        for (int bj = 0; bj < 2; ++bj) {
            const int gidx = (cu + bj * HALF) >> 3;
            f32x4 wa[3], wg[3];
#pragma unroll
            for (int j = 0; j < 3; ++j) { wa[j] = *(const f32x4*)(cw + (size_t)j * NUP + 4 * gidx); wg[j] = *(const f32x4*)(cw + (size_t)j * NUP + DFF + 4 * gidx); }
            const f32x4 ba = *(const f32x4*)(cb + 4 * gidx), bg = *(const f32x4*)(cb + DFF + 4 * gidx);
#pragma unroll
            for (int ai = 0; ai < 2; ++ai) {
                const f32x4 z = (f32x4){0.f, 0.f, 0.f, 0.f};
                f32x4 pa2 = z, pa3 = z, pg2 = z, pg3 = z;
                if ((wr == 1 || ai == 1) && fr == 0) { const int pw = wr == 1 ? wid - 4 : wid + 4, pai = wr == 1 ? ai : 0;
                    const LAS unsigned char* hp = xl + ((((pw * 2 + pai) * 2) * 64 + bj * 32 + fq * 8) * 4);
                    pa2 = *(const LAS f32x4*)hp; pg2 = *(const LAS f32x4*)(hp + 16); pa3 = *(const LAS f32x4*)(hp + 256); pg3 = *(const LAS f32x4*)(hp + 256 + 16); }
                const f32x4 x0 = acc[ai][bj][0][0], x1 = acc[ai][bj][1][0], x2 = acc[ai][bj][2][0], x3 = acc[ai][bj][3][0];
                const f32x4 g0 = acc[ai][bj][0][1], g1 = acc[ai][bj][1][1], g2 = acc[ai][bj][2][1], g3 = acc[ai][bj][3][1];
                f32x4 ca[4], cg[4];
                ca[3] = x3 * wa[2] + x2 * wa[1] + x1 * wa[0] + ba;           cg[3] = g3 * wg[2] + g2 * wg[1] + g1 * wg[0] + bg;
                ca[2] = x2 * wa[2] + x1 * wa[1] + x0 * wa[0] + ba;           cg[2] = g2 * wg[2] + g1 * wg[1] + g0 * wg[0] + bg;
                ca[1] = x1 * wa[2] + x0 * wa[1] + pa3 * wa[0] + ba;          cg[1] = g1 * wg[2] + g0 * wg[1] + pg3 * wg[0] + bg;
                ca[0] = x0 * wa[2] + pa3 * wa[1] + pa2 * wa[0] + ba;         cg[0] = g0 * wg[2] + pg3 * wg[1] + pg2 * wg[0] + bg;
                conv_taps2(ca[1], ca[0], x3, x2, wa[1], wa[0]); conv_taps2(cg[1], cg[0], g3, g2, wg[1], wg[0]);
                bf16_t* ap = act + (size_t)(u.pm * BM + ai * HALF + wr * 64 + 4 * fr) * DFF + 4 * gidx;
#pragma unroll
                for (int m = 0; m < 4; ++m) { f32x4 o;
#pragma unroll
                    for (int e = 0; e < 4; ++e) o[e] = ca[m][e] * __builtin_amdgcn_rcpf(1.0f + __builtin_amdgcn_exp2f(-ca[m][e] * LOG2E)) * cg[m][e];
                    u32x2 w; w.x = cvt_pk_bf16(o[0], o[1]); w.y = cvt_pk_bf16(o[2], o[3]);
                    *(u32x2*)(ap + (size_t)m * DFF) = w; }
            }
        }
    }
};
template <> struct RowPerm<EpiConvGlu> { static constexpr bool v = true; };
#else
struct EpiConvGlu {
    static constexpr bool PERM = true, AFTER_DRAIN = false, MIDK = false;
    bf16_t* act; float* U4; const float* cw; const float* cb; LAS unsigned char* xl;
    __device__ __forceinline__ void operator()(const Acc& acc, const Unit& u, int wr, int wc, int fr, int fq) const {
        const int wid = wr * 4 + wc, cu = u.pn * BM + wc * 32 + 8 * fq;
        if (fr >= 14) {
#pragma unroll
            for (int ai = 0; ai < 2; ++ai)
#pragma unroll
                for (int bj = 0; bj < 2; ++bj)
#pragma unroll
                    for (int n = 0; n < 2; ++n) *(LAS f32x4*)(xl + ((((wid * 2 + ai) * 2 + (fr - 14)) * 64 + bj * 32 + fq * 8 + n * 4) * 4)) = acc[ai][bj][3][n];
        }
        if (wr == 0 && fr < 2) {
#pragma unroll
            for (int bj = 0; bj < 2; ++bj)
#pragma unroll
                for (int n = 0; n < 2; ++n) *(f32x4*)(U4 + ((size_t)(u.pm * 4 + fr) * NUP + cu + bj * HALF + n * 4)) = acc[0][bj][0][n];
        }
        if (wr == 1 && fr >= 14) {
#pragma unroll
            for (int bj = 0; bj < 2; ++bj)
#pragma unroll
                for (int n = 0; n < 2; ++n) *(f32x4*)(U4 + ((size_t)(u.pm * 4 + 2 + (fr - 14)) * NUP + cu + bj * HALF + n * 4)) = acc[1][bj][3][n];
        }
        asm volatile("s_waitcnt lgkmcnt(0)" ::: "memory"); __builtin_amdgcn_s_barrier(); asm volatile("" ::: "memory");
#pragma unroll
        for (int bj = 0; bj < 2; ++bj) {
            const int gidx = (cu + bj * HALF) >> 3;
            f32x4 wa[3], wg[3];
#pragma unroll
            for (int j = 0; j < 3; ++j) { wa[j] = *(const f32x4*)(cw + (size_t)j * NUP + 4 * gidx); wg[j] = *(const f32x4*)(cw + (size_t)j * NUP + DFF + 4 * gidx); }
            const f32x4 ba = *(const f32x4*)(cb + 4 * gidx), bg = *(const f32x4*)(cb + DFF + 4 * gidx);
#pragma unroll
            for (int ai = 0; ai < 2; ++ai) {
                f32x4 pa = (f32x4){0.f, 0.f, 0.f, 0.f}, pg = pa;
                if (wr == 1 || ai == 1) { const int pw = wr == 1 ? wid - 4 : wid + 4, pai = wr == 1 ? ai : 0;
                    const LAS unsigned char* hp = xl + ((((pw * 2 + pai) * 2 + (fr & 1)) * 64 + bj * 32 + fq * 8) * 4);
                    pa = *(const LAS f32x4*)hp; pg = *(const LAS f32x4*)(hp + 16); }
                bf16_t* ap = act + (size_t)(u.pm * BM + ai * HALF + wr * 64 + fr) * DFF + 4 * gidx;
#pragma unroll
                for (int m = 0; m < 4; ++m) {
                    const f32x4 a0 = acc[ai][bj][m][0], g0 = acc[ai][bj][m][1];
                    f32x4 ca = a0 * wa[2] + ba, cg = g0 * wg[2] + bg; f32x4 o;
                    conv_taps(ca, a0, pa, wa[1], wa[0]); conv_taps(cg, g0, pg, wg[1], wg[0]);
#pragma unroll
                    for (int e = 0; e < 4; ++e) o[e] = ca[e] * __builtin_amdgcn_rcpf(1.0f + __builtin_amdgcn_exp2f(-ca[e] * LOG2E)) * cg[e];
                    u32x2 w; w.x = cvt_pk_bf16(o[0], o[1]); w.y = cvt_pk_bf16(o[2], o[3]);
                    *(u32x2*)(ap + (size_t)(m * 16) * DFF) = w;
                    pa = a0; pg = g0;
                }
            }
        }
    }
};
#endif
struct EpiSoftmax {
    static constexpr bool PERM = true, AFTER_DRAIN = true, MIDK = false;
    bf16_t* P;
    __device__ __forceinline__ void fused(Acc& acc, const Unit& u, int wr, int wc, int fr, int fq, LAS unsigned char* lds, int wid, int lane) const {
        const float C = 0.044194173824159216f * LOG2E;
        LAS f32x2* T = (LAS f32x2*)lds;
#pragma unroll
        for (int ai = 0; ai < 2; ++ai)
#pragma unroll
            for (int m = 0; m < 4; ++m) {
                float mx = -3.0e38f;
#pragma unroll
                for (int bj = 0; bj < 2; ++bj)
#pragma unroll
                    for (int n = 0; n < 2; ++n) { const f32x4 x = acc[ai][bj][m][n]; mx = fmaxf(mx, fmaxf(fmaxf(x[0], x[1]), fmaxf(x[2], x[3]))); }
                mx = fmaxf(mx, xor_lt32<16>(mx)); mx = max_xor32(mx);
                float s = 0.f;
#pragma unroll
                for (int bj = 0; bj < 2; ++bj)
#pragma unroll
                    for (int n = 0; n < 2; ++n) { const f32x4 x = acc[ai][bj][m][n];
#pragma unroll
                        for (int e = 0; e < 4; ++e) s += __builtin_amdgcn_exp2f((x[e] - mx) * C); }
                s += xor_lt32<16>(s); s = sum_xor32(s);
                if (fq == 0) T[(ai * HALF + wr * 64 + m * 16 + fr) * 4 + wc] = (f32x2){mx, s};
            }
        asm volatile("s_waitcnt lgkmcnt(0)" ::: "memory"); __builtin_amdgcn_s_barrier(); asm volatile("" ::: "memory");
        const int row0 = u.pm * BM + wr * 64 + fr, col0 = u.pn * BM + wc * 32 + 8 * fq;
#pragma unroll
        for (int ai = 0; ai < 2; ++ai)
#pragma unroll
            for (int m = 0; m < 4; ++m) { const int rl = ai * HALF + wr * 64 + m * 16 + fr;
                const f32x2 t0 = T[rl * 4 + 0], t1 = T[rl * 4 + 1], t2 = T[rl * 4 + 2], t3 = T[rl * 4 + 3];
                const float M = fmaxf(fmaxf(t0.x, t1.x), fmaxf(t2.x, t3.x));
                const float S = (t0.y * __builtin_amdgcn_exp2f((t0.x - M) * C) + t1.y * __builtin_amdgcn_exp2f((t1.x - M) * C)) + (t2.y * __builtin_amdgcn_exp2f((t2.x - M) * C) + t3.y * __builtin_amdgcn_exp2f((t3.x - M) * C));
                const float inv = __builtin_amdgcn_rcpf(S), MC = -M * C;
                bf16_t* rowp = P + (size_t)(row0 + ai * HALF + m * 16) * 1024 + col0;
#pragma unroll
                for (int bj = 0; bj < 2; ++bj) { f32x4 v0 = acc[ai][bj][m][0], v1 = acc[ai][bj][m][1];
#pragma unroll
                    for (int e = 0; e < 4; ++e) { v0[e] = __builtin_amdgcn_exp2f(fmaf(v0[e], C, MC)) * inv; v1[e] = __builtin_amdgcn_exp2f(fmaf(v1[e], C, MC)) * inv; }
                    st16bj(rowp, bj, pack8(v0, v1)); } }
        (void)wid; (void)lane;
    }
};
struct EpiGate2 {
    static constexpr bool PERM = true, AFTER_DRAIN = false, MIDK = true;
    const bf16_t* gates; bf16_t* merged;
    __device__ __forceinline__ void operator()(Acc& acc, const Unit& u, int wr, int wc, int fr, int fq) const {
        if (u.z == 0) {
        const int row0 = u.pm * BM + wr * 64 + fr, colt = u.pn * BM + wc * 32 + 8 * fq;
#pragma unroll
        for (int ai = 0; ai < 2; ++ai)
#pragma unroll
            for (int m = 0; m < 4; ++m) { const bf16_t* gp = gates + (size_t)(row0 + ai * HALF + m * 16) * 4096 + colt;
#pragma unroll
                for (int bj = 0; bj < 2; ++bj) { const u32x4 ga = *(const u32x4*)(gp + bj * HALF), gb = *(const u32x4*)(gp + 2048 + bj * HALF);
                    const f32x4 a0 = (f32x4){bflo(ga.x), bfhi(ga.x), bflo(ga.y), bfhi(ga.y)}, a1 = (f32x4){bflo(ga.z), bfhi(ga.z), bflo(ga.w), bfhi(ga.w)};
                    const f32x4 b0 = (f32x4){bflo(gb.x), bfhi(gb.x), bflo(gb.y), bfhi(gb.y)}, b1 = (f32x4){bflo(gb.z), bfhi(gb.z), bflo(gb.w), bfhi(gb.w)};
#pragma unroll
                    for (int e = 0; e < 4; ++e) { acc[ai][bj][m][0][e] *= a0[e] * __builtin_amdgcn_rcpf(fmaxf(b0[e], 1e-30f)); acc[ai][bj][m][1][e] *= a1[e] * __builtin_amdgcn_rcpf(fmaxf(b1[e], 1e-30f)); }
                    asm volatile("" : "+v"(acc[ai][bj][m][0]), "+v"(acc[ai][bj][m][1]) :: "memory"); } }
                return; }
        const int row0 = u.pm * BM + wr * 64 + fr, colt = u.pn * BM + wc * 32 + 8 * fq;
#pragma unroll
        for (int ai = 0; ai < 2; ++ai)
#pragma unroll
            for (int m = 0; m < 4; ++m) { const size_t row = (size_t)(row0 + ai * HALF + m * 16);
#pragma unroll
                for (int bj = 0; bj < 2; ++bj) { const int col = colt + bj * HALF; const u32x4 gb = *(const u32x4*)(gates + row * 4096 + 2048 + col);
                    f32x4 b0 = (f32x4){bflo(gb.x), bfhi(gb.x), bflo(gb.y), bfhi(gb.y)}, b1 = (f32x4){bflo(gb.z), bfhi(gb.z), bflo(gb.w), bfhi(gb.w)};
#pragma unroll
                    for (int e = 0; e < 4; ++e) { b0[e] = fmaxf(b0[e], 1e-30f); b1[e] = fmaxf(b1[e], 1e-30f); }
                    st16bj(merged + row * 2048 + colt, bj, pack8(acc[ai][bj][m][0] * b0, acc[ai][bj][m][1] * b1)); } }
    }
};
struct EpiF32 {
    static constexpr bool PERM = false, AFTER_DRAIN = false, MIDK = false;
    float* C; int ldc;
    __device__ __forceinline__ void operator()(const Acc& acc, const Unit& u, int wr, int wc, int fr, int fq) const {
        const int row0 = u.pm * BM + wr * 64 + fr, col0 = u.pn * BM + wc * 32 + 4 * fq;
#pragma unroll
        for (int ai = 0; ai < 2; ++ai)
#pragma unroll
            for (int m = 0; m < 4; ++m) { float* rowp = C + (size_t)(row0 + ai * HALF + m * 16) * ldc + col0;
#pragma unroll
                for (int bj = 0; bj < 2; ++bj)
#pragma unroll
                    for (int n = 0; n < 2; ++n) *(f32x4*)(rowp + bj * HALF + n * 16) = acc[ai][bj][m][n]; }
    }
};
struct EpiBf16 {
    static constexpr bool PERM = true, AFTER_DRAIN = false, MIDK = false;
    bf16_t* O; int ldc;
    __device__ __forceinline__ void operator()(const Acc& acc, const Unit& u, int wr, int wc, int fr, int fq) const {
        const int row0 = u.pm * BM + wr * 64 + fr, col0 = u.pn * BM + wc * 32 + 8 * fq;
#pragma unroll
        for (int ai = 0; ai < 2; ++ai)
#pragma unroll
            for (int m = 0; m < 4; ++m) { bf16_t* rowp = O + (size_t)(row0 + ai * HALF + m * 16) * ldc + col0;
#pragma unroll
                for (int bj = 0; bj < 2; ++bj) st16bj(rowp, bj, pack8(acc[ai][bj][m][0], acc[ai][bj][m][1])); }
    }
};
struct EpiMemKv {
    static constexpr bool PERM = true, AFTER_DRAIN = false, MIDK = false;
    bf16_t* Kmem;
    __device__ __forceinline__ void operator()(const Acc& acc, const Unit& u, int wr, int wc, int fr, int fq) const {
        bf16_t* O = Kmem + (size_t)(u.z & 1) * ((RA_VMEM - RA_KMEM) / 2) + (size_t)(u.z >> 1) * (1024 * 2048);
        const int row0 = u.pm * BM + wr * 64 + fr, col0 = u.pn * BM + wc * 32 + 8 * fq;
#pragma unroll
        for (int ai = 0; ai < 2; ++ai)
#pragma unroll
            for (int m = 0; m < 4; ++m) { bf16_t* rowp = O + (size_t)(row0 + ai * HALF + m * 16) * 2048 + col0;
#pragma unroll
                for (int bj = 0; bj < 2; ++bj) st16bj(rowp, bj, pack8(acc[ai][bj][m][0], acc[ai][bj][m][1])); }
    }
};
struct EpiFold {
    static constexpr bool PERM = true, AFTER_DRAIN = false, MIDK = false;
    bf16_t* Wall;
    __device__ __forceinline__ void operator()(const Acc& acc, const Unit& u, int wr, int wc, int fr, int fq) const {
        const int ty = u.z & 1, ldc = ty ? 1024 : 2048;
        bf16_t* O = Wall + (size_t)(u.z >> 1) * W_LAYER + WO_WK + (size_t)ty * ((WO_VW - WO_WK) + (size_t)(u.pn >> 2) * (2048 * 1024));
        const int row0 = u.pm * BM + wr * 64 + fr, col0 = (ty ? (u.pn & 3) : u.pn) * BM + wc * 32 + 8 * fq;
#pragma unroll
        for (int ai = 0; ai < 2; ++ai)
#pragma unroll
            for (int m = 0; m < 4; ++m) { bf16_t* rowp = O + (size_t)(row0 + ai * HALF + m * 16) * ldc + col0;
#pragma unroll
                for (int bj = 0; bj < 2; ++bj) st16bj(rowp, bj, pack8(acc[ai][bj][m][0], acc[ai][bj][m][1])); }
    }
};

struct GateOrder {
    StaticOrder S;
    __device__ __forceinline__ bool next(int i, Unit& u) const { if (!S.next(i >> 1, u)) return false; u.z = i & 1; u.aoff += (unsigned)(i & 1) * 1024u; u.boff += (unsigned)(i & 1) * 1024u; return true; }
    __device__ __forceinline__ void a_ready(const Unit&) const {}
    __device__ __forceinline__ void done(const Unit&) const {}
};
struct MemKvOrder {
    int G, c;
    __device__ __forceinline__ bool next(int i, Unit& u) const {
        const int L = i * G + c; if (L >= 256) return false;
        const int ly = L >> 6, r = L & 63, ty = r >> 5, q = r & 31;
        u.pm = q >> 3; u.pn = q & 7; u.z = ly * 2 + ty;
        u.aoff = (unsigned)(RA_MEMN / 2) + (unsigned)ly * (1024u * 2048u) + (unsigned)u.pm * (256u * 2048u);
        u.boff = (unsigned)(RA_KVXT / 2) + (unsigned)ly * (4096u * 2048u) + (unsigned)(ty * 2048 + u.pn * 256) * 2048u; return true;
    }
    __device__ __forceinline__ void a_ready(const Unit&) const {}
    __device__ __forceinline__ void done(const Unit&) const {}
};
struct FoldOrder {
    int G, c;
    __device__ __forceinline__ bool next(int i, Unit& u) const {
        const int L = i * G + c; if (L >= 1024) return false;
        const int ly = L >> 8, r = L & 255, ty = r >> 7, q = r & 127; u.z = ly * 2 + ty;
        if (ty == 0) { u.pm = q >> 3; u.pn = q & 7; const unsigned b = (unsigned)u.pm >> 2, h = (unsigned)u.pm & 3u;
            u.aoff = (unsigned)(RA_KMEM / 2) + (unsigned)ly * (1024u * 2048u) + b * (256u * 2048u) + h * 512u;
            u.boff = (unsigned)(RA_QXP / 2) + (unsigned)ly * (2048u * 2048u) + (unsigned)u.pn * (256u * 2048u) + h * 512u; }
        else { u.pm = q >> 4; u.pn = q & 15; const unsigned b = (unsigned)u.pn >> 2, h = (unsigned)u.pn & 3u;
            u.aoff = (unsigned)(RA_OXT / 2) + (unsigned)ly * (2048u * 2048u) + (unsigned)u.pm * (256u * 2048u) + h * 512u;
            u.boff = (unsigned)(RA_VMEM / 2) + (unsigned)ly * (1024u * 2048u) + b * (256u * 2048u) + h * 512u; }
        return true;
    }
    __device__ __forceinline__ void a_ready(const Unit&) const {}
    __device__ __forceinline__ void done(const Unit&) const {}
};
struct CrossSOrder {
    int G, c;
    __device__ __forceinline__ bool next(int i, Unit& u) const {
        const int L = i * G + c; if (L >= 256) return false;
        const int w = (L & 7) * 32 + (L >> 3);
        u.pm = w >> 2; u.pn = w & 3; u.z = 0; const unsigned b = (unsigned)u.pm >> 4;
        u.aoff = (unsigned)u.pm * (256u * 2048u); u.boff = (b * 1024u + (unsigned)u.pn * 256u) * 2048u; return true;
    }
    __device__ __forceinline__ void a_ready(const Unit&) const {}
    __device__ __forceinline__ void done(const Unit&) const {}
};
struct CrossYOrder {
    int G, c;
    __device__ __forceinline__ bool next(int i, Unit& u) const {
        const int L = i * G + c; if (L >= 512) return false;
        const int w = (L & 7) * 64 + (L >> 3);
        u.pm = w >> 3; u.pn = w & 7; u.z = 0; const unsigned b = (unsigned)u.pm >> 4;
        u.aoff = (unsigned)u.pm * (256u * 1024u); u.boff = (b * 2048u + (unsigned)u.pn * 256u) * 1024u; return true;
    }
    __device__ __forceinline__ void a_ready(const Unit&) const {}
    __device__ __forceinline__ void done(const Unit&) const {}
};
}
namespace att {
constexpr int NW = 8, QBLK = 32, KVBLK = 64;
constexpr float THR = 8.f;
constexpr int SHM_V = KVBLK * 128 * 2;
constexpr int OFF_V = 0, OFF_K = 2 * SHM_V, OFF_QL = 81920  , OFF_WS = 122880;
#define SBAR() __builtin_amdgcn_sched_barrier(0)
__device__ __forceinline__ int crow(int r, int hi) { return (r & 3) + 8 * (r >> 2) + 4 * hi; }

__device__ __forceinline__ void partialSM(f32x16& p0, f32x16& p1, float& m_reg, float& alpha, const float C, const bool valid) {
    if (!valid) {
#pragma unroll
        for (int r = 0; r < 16; ++r) { p0[r] = 0.f; p1[r] = 0.f; }
        alpha = 1.f; return; }
    float pmax = p0[0];
#pragma unroll
    for (int r = 1; r < 16; ++r) pmax = fmaxf(pmax, p0[r]);
#pragma unroll
    for (int r = 0; r < 16; ++r) pmax = fmaxf(pmax, p1[r]);
    { auto rr = __builtin_amdgcn_permlane32_swap(__float_as_uint(pmax), __float_as_uint(pmax), false, false);
      pmax = fmaxf(__uint_as_float(rr[0]), __uint_as_float(rr[1])); }
    float mn;
    if (__builtin_expect(__all((pmax - m_reg) * C <= THR * LOG2E), 1)) { mn = m_reg; alpha = 1.f; }
    else { mn = fmaxf(m_reg, pmax); alpha = __builtin_amdgcn_exp2f((m_reg - mn) * C); m_reg = mn; }
    const float mnC = -mn * C;
#pragma unroll
    for (int r = 0; r < 16; ++r) p0[r] = fmaf(p0[r], C, mnC);
#pragma unroll
    for (int r = 0; r < 16; ++r) p1[r] = fmaf(p1[r], C, mnC);
#pragma unroll
    for (int r = 0; r < 16; ++r) p0[r] = __builtin_amdgcn_exp2f(p0[r]);
}
__device__ __forceinline__ void finishSM(f32x16& p0, f32x16& p1, float alpha, float& l_reg, bf16x8& pa0, bf16x8& pa1, bf16x8& pa2, bf16x8& pa3, const bool valid) {
    if (valid) {
#pragma unroll
        for (int r = 0; r < 16; ++r) p1[r] = __builtin_amdgcn_exp2f(p1[r]);
    }
    f32x2 ps2 = (f32x2){p0[0], p0[1]};
#pragma unroll
    for (int r = 1; r < 8; ++r) ps2 += (f32x2){p0[2 * r], p0[2 * r + 1]};
#pragma unroll
    for (int r = 0; r < 8; ++r) ps2 += (f32x2){p1[2 * r], p1[2 * r + 1]};
    float ps = ps2.x + ps2.y;
    { auto rr = __builtin_amdgcn_permlane32_swap(__float_as_uint(ps), __float_as_uint(ps), false, false);
      ps = __uint_as_float(rr[0]) + __uint_as_float(rr[1]); }
    l_reg = l_reg * alpha + ps;
#define PK4(P, BASE, OUT) do { unsigned a0 = cvt_pk_bf16(P[BASE + 0], P[BASE + 1]), a1 = cvt_pk_bf16(P[BASE + 2], P[BASE + 3]);   \
    unsigned b0 = cvt_pk_bf16(P[BASE + 4], P[BASE + 5]), b1 = cvt_pk_bf16(P[BASE + 6], P[BASE + 7]);                              \
    auto r0 = __builtin_amdgcn_permlane32_swap(a0, b0, false, false); auto r1 = __builtin_amdgcn_permlane32_swap(a1, b1, false, false); \
    u32x4 w = {r0[0], r1[0], r0[1], r1[1]}; OUT = __builtin_bit_cast(bf16x8, w); } while (0)
    PK4(p0, 0, pa0); PK4(p0, 8, pa1); PK4(p1, 0, pa2); PK4(p1, 8, pa3);
#undef PK4
}
template <int NQ, int NL>
__device__ __forceinline__ void qkt(f32x16& p0, f32x16& p1, const LAS unsigned char* Ks, const bf16x8* qr, const LAS unsigned char* ql, int r32, int hi) {
    constexpr int STRIDE = NQ * 32;
    const int sw = (r32 >> 1) & 7;
    const LAS unsigned char* k0p = Ks + r32 * STRIDE; const LAS unsigned char* k1p = k0p + 32 * STRIDE;
#pragma unroll
    for (int r = 0; r < 16; ++r) { p0[r] = 0.f; p1[r] = 0.f; }
#pragma unroll
    for (int d0 = 0; d0 < NQ; ++d0) { const int off = ((2 * d0 + hi) ^ sw) << 4;
        const bf16x8 b0 = *(const LAS bf16x8*)(k0p + off), b1 = *(const LAS bf16x8*)(k1p + off);
        bf16x8 qf; if (d0 < NQ - NL) qf = qr[d0]; else qf = *(const LAS bf16x8*)(ql + (d0 - (NQ - NL)) * 1024);
        p0 = __builtin_amdgcn_mfma_f32_32x32x16_bf16(b0, qf, p0, 0, 0, 0);
        p1 = __builtin_amdgcn_mfma_f32_32x32x16_bf16(b1, qf, p1, 0, 0, 0); }
}
__device__ __forceinline__ int v_st(int k, int c) { const int kk = (k & ~0xC) | ((k & 4) << 1) | ((k & 8) >> 1); return ((kk >> 3) * 4 + (c >> 5)) * 512 + ((kk & 7) * 32 + (c & 31)) * 2; }
__device__ __forceinline__ int v_rd_base(int lane) { return ((lane & 3) << 3) | (((lane >> 2) & 3) << 6) | (((lane >> 4) & 1) << 5) | (((lane >> 5) & 1) << 8); }
constexpr int v_rd_off(int d0, int ks, int half) { return d0 * 512 + ks * 4096 + half * 2048; }
template <int OFF> __device__ __forceinline__ s16x4 tr_read(int vb) {
    s16x4 r; asm volatile("ds_read_b64_tr_b16 %0, %1 offset:%2" : "=&v"(r) : "v"(vb), "i"(OFF) : "memory"); return r;
}
template <int D0> __device__ __forceinline__ void pv_one(f32x16& od, int vb, bf16x8 pa0, bf16x8 pa1, bf16x8 pa2, bf16x8 pa3) {
    const s16x4 l0 = tr_read<v_rd_off(D0, 0, 0)>(vb), h0 = tr_read<v_rd_off(D0, 0, 1)>(vb), l1 = tr_read<v_rd_off(D0, 1, 0)>(vb), h1 = tr_read<v_rd_off(D0, 1, 1)>(vb);
    const s16x4 l2 = tr_read<v_rd_off(D0, 2, 0)>(vb), h2 = tr_read<v_rd_off(D0, 2, 1)>(vb), l3 = tr_read<v_rd_off(D0, 3, 0)>(vb), h3 = tr_read<v_rd_off(D0, 3, 1)>(vb);
    asm volatile("s_waitcnt lgkmcnt(0)" ::: "memory"); SBAR();
#define PK(L, H) (bf16x8){L[0], L[1], L[2], L[3], H[0], H[1], H[2], H[3]}
    od = __builtin_amdgcn_mfma_f32_32x32x16_bf16(pa0, PK(l0, h0), od, 0, 0, 0);
    od = __builtin_amdgcn_mfma_f32_32x32x16_bf16(pa1, PK(l1, h1), od, 0, 0, 0);
    od = __builtin_amdgcn_mfma_f32_32x32x16_bf16(pa2, PK(l2, h2), od, 0, 0, 0);
    od = __builtin_amdgcn_mfma_f32_32x32x16_bf16(pa3, PK(l3, h3), od, 0, 0, 0);
#undef PK
}
__device__ __forceinline__ void pv_d0(f32x16* o, int vb, bf16x8 pa0, bf16x8 pa1, bf16x8 pa2, bf16x8 pa3) {
    pv_one<0>(o[0], vb, pa0, pa1, pa2, pa3); pv_one<1>(o[1], vb, pa0, pa1, pa2, pa3); pv_one<2>(o[2], vb, pa0, pa1, pa2, pa3); pv_one<3>(o[3], vb, pa0, pa1, pa2, pa3);
}

template <int NQ, bool MLA>
__device__ __forceinline__ void attn_pass(const bf16_t* __restrict__ Qb, const int ldq, const bf16_t* __restrict__ Kh, const bf16_t* __restrict__ Kpe, const bf16_t* __restrict__ Vh,
                                          const int NT, const float C, LAS unsigned char* lds, f32x16 (&o)[4]) {
    constexpr int STRIDE = NQ * 32, SHM_K = KVBLK * STRIDE;
    int tid = threadIdx.x; asm volatile("" : "+v"(tid));
    const int wid = __builtin_amdgcn_readfirstlane(tid >> 6), lane = tid & 63, r32 = lane & 31, hi = lane >> 5;
    LAS unsigned char* V_lds = lds + OFF_V; LAS unsigned char* K_lds = lds + OFF_K;
    LAS float* wsf = (LAS float*)(lds + OFF_WS) + wid * 64; LAS float* li_l = wsf; LAS float* al_l = wsf + 32;
    constexpr int NL = MLA ? 4 : 0;
    LAS unsigned char* ql = lds + OFF_QL + wid * 4096 + lane * 16;
    float m_reg = -1e30f, l_reg = 0.f; bf16x8 qr[NQ - NL];
#pragma unroll
    for (int d = 0; d < 4; ++d)
#pragma unroll
        for (int r = 0; r < 16; ++r) o[d][r] = 0.f;
    { const bf16_t* Qw = Qb + (size_t)(wid * QBLK + r32) * ldq + hi * 8;
#pragma unroll
      for (int d0 = 0; d0 < NQ - NL; ++d0) qr[d0] = *(const bf16x8*)(Qw + d0 * 16);
#pragma unroll
      for (int d0 = NQ - NL; d0 < NQ; ++d0) *(LAS bf16x8*)(ql + (d0 - (NQ - NL)) * 1024) = *(const bf16x8*)(Qw + d0 * 16); }
    const int sr = tid >> 4, sc = (tid & 15) * 8, vst0 = v_st(sr, sc), vst1 = v_st(32 + sr, sc);
    const int kr = tid >> 3, kc = tid & 7;
    int kst0, kst1, kst2;
    if (MLA) { kst0 = sr * STRIDE + (((tid & 15) ^ ((sr >> 1) & 7)) << 4); kst1 = kst0 + 32 * STRIDE; kst2 = kr * STRIDE + (((16 + kc) ^ ((kr >> 1) & 7)) << 4); }
    else { kst0 = kr * STRIDE + ((kc ^ ((kr >> 1) & 7)) << 4); kst1 = 0; kst2 = 0; }
    const int vb0 = (int)(unsigned)(uintptr_t)V_lds + v_rd_base(lane);
    const int jw = NT - 4 + (wid >> 1);
    bf16x8 vs0, vs1, ks0, ks1, ks2;
#define SLOAD(k0) do { vs0 = *(const bf16x8*)(Vh + (size_t)((k0) + sr) * 1024 + sc); vs1 = *(const bf16x8*)(Vh + (size_t)((k0) + 32 + sr) * 1024 + sc); \
    if (MLA) { ks0 = *(const bf16x8*)(Kh + (size_t)((k0) + sr) * 1024 + sc); ks1 = *(const bf16x8*)(Kh + (size_t)((k0) + 32 + sr) * 1024 + sc); ks2 = *(const bf16x8*)(Kpe + (size_t)((k0) + kr) * 64 + kc * 8); } \
    else { ks0 = *(const bf16x8*)(Kh + (size_t)((k0) + kr) * 1024 + kc * 8); } } while (0)
#define SWRITE(b) do { *(LAS bf16x8*)(V_lds + (b) * SHM_V + vst0) = vs0; *(LAS bf16x8*)(V_lds + (b) * SHM_V + vst1) = vs1; \
    *(LAS bf16x8*)(K_lds + (b) * SHM_K + kst0) = ks0; if (MLA) { *(LAS bf16x8*)(K_lds + (b) * SHM_K + kst1) = ks1; *(LAS bf16x8*)(K_lds + (b) * SHM_K + kst2) = ks2; } } while (0)
#define RESC(a) do { if (__any((a) < 1.f)) { if (hi == 0) al_l[r32] = (a); asm volatile("s_waitcnt lgkmcnt(0)" ::: "memory"); \
    _Pragma("unroll") for (int d = 0; d < 4; ++d) _Pragma("unroll") for (int r = 0; r < 16; ++r) o[d][r] *= al_l[crow(r, hi)]; } } while (0)
    f32x16 p0, p1; float al; bf16x8 pa0, pa1, pa2, pa3;
    SLOAD(0); SWRITE(0); __syncthreads();
    SLOAD(KVBLK);
    for (int j = 0; j < NT; ++j) {
        const int bsel = j & 1;
        if (j <= jw) {
            SBAR(); qkt<NQ, NL>(p0, p1, K_lds + bsel * SHM_K, qr, ql, r32, hi);
            partialSM(p0, p1, m_reg, al, C, true);
            RESC(al);
            finishSM(p0, p1, al, l_reg, pa0, pa1, pa2, pa3, true); SBAR();
            pv_d0(o, vb0 + bsel * SHM_V, pa0, pa1, pa2, pa3);
        }
        if (j + 1 < NT) {
#ifdef DIAG_XBAR
            __syncthreads();
#endif
            SWRITE(bsel ^ 1); __syncthreads();
            if (j + 2 < NT) SLOAD((j + 2) * KVBLK);
        }
    }
    __syncthreads();
    if (hi == 0) li_l[r32] = l_reg; asm volatile("s_waitcnt lgkmcnt(0)" ::: "memory");
#pragma unroll
    for (int r = 0; r < 16; ++r) { const float rl = __builtin_amdgcn_rcpf(li_l[crow(r, hi)]);
#pragma unroll
        for (int d = 0; d < 4; ++d) o[d][r] *= rl; }
    asm volatile("s_waitcnt lgkmcnt(0)" ::: "memory");
#undef SLOAD
#undef SWRITE
#undef RESC
}

__device__ __forceinline__ void glds16(const void* gsrc, unsigned lds_dst) { unsigned keep;
    asm volatile("s_mov_b32 %0, m0\n\ts_mov_b32 m0, %2\n\ts_nop 0\n\tglobal_load_lds_dwordx4 %1, off\n\ts_mov_b32 m0, %0" : "=&s"(keep) : "v"(gsrc), "s"(lds_dst) : "memory"); }
__host__ __device__ __forceinline__ int vq_k(int q) { const int sub = q >> 5, kk = (sub >> 2) * 8 + ((q & 31) >> 2); return (kk & ~0xC) | ((kk & 4) << 1) | ((kk & 8) >> 1); }
__host__ __device__ __forceinline__ int vq_c(int q) { return ((q >> 5) & 3) * 32 + (q & 3) * 8; }
constexpr int P2_V = 0, P2_K = 32768, P2_KP = 65536;
#define WAITBAR() asm volatile("s_waitcnt vmcnt(0) lgkmcnt(0)\n\ts_barrier" ::: "memory")

template <bool MLA>
__device__ __forceinline__ void qkt2(f32x16& p0, f32x16& p1, const LAS unsigned char* Kb, const LAS unsigned char* Kpb, const bf16x8* qr, const LAS unsigned char* ql, int r32, int hi) {
#pragma unroll
    for (int r = 0; r < 16; ++r) { p0[r] = 0.f; p1[r] = 0.f; }
    if (MLA) {
        const LAS unsigned char* k0p = Kb + r32 * 256; const LAS unsigned char* k1p = k0p + 32 * 256; const int sw = r32 & 15;
#pragma unroll
        for (int d0 = 0; d0 < 8; ++d0) { const int off = ((2 * d0 + hi) ^ sw) << 4;
            const bf16x8 b0 = *(const LAS bf16x8*)(k0p + off), b1 = *(const LAS bf16x8*)(k1p + off);
            p0 = __builtin_amdgcn_mfma_f32_32x32x16_bf16(b0, qr[d0], p0, 0, 0, 0); p1 = __builtin_amdgcn_mfma_f32_32x32x16_bf16(b1, qr[d0], p1, 0, 0, 0); }
        const LAS unsigned char* e0p = Kpb + r32 * 128; const LAS unsigned char* e1p = e0p + 32 * 128; const int sw2 = (r32 >> 1) & 7;
#pragma unroll
        for (int d0 = 0; d0 < 4; ++d0) { const int off = ((2 * d0 + hi) ^ sw2) << 4;
            const bf16x8 b0 = *(const LAS bf16x8*)(e0p + off), b1 = *(const LAS bf16x8*)(e1p + off), qf = *(const LAS bf16x8*)(ql + d0 * 1024);
            p0 = __builtin_amdgcn_mfma_f32_32x32x16_bf16(b0, qf, p0, 0, 0, 0); p1 = __builtin_amdgcn_mfma_f32_32x32x16_bf16(b1, qf, p1, 0, 0, 0); }
    } else {
        const LAS unsigned char* k0p = Kb + r32 * 128; const LAS unsigned char* k1p = k0p + 32 * 128; const int sw = (r32 >> 1) & 7;
#pragma unroll
        for (int d0 = 0; d0 < 4; ++d0) { const int off = ((2 * d0 + hi) ^ sw) << 4;
            const bf16x8 b0 = *(const LAS bf16x8*)(k0p + off), b1 = *(const LAS bf16x8*)(k1p + off);
            p0 = __builtin_amdgcn_mfma_f32_32x32x16_bf16(b0, qr[d0], p0, 0, 0, 0); p1 = __builtin_amdgcn_mfma_f32_32x32x16_bf16(b1, qr[d0], p1, 0, 0, 0); }
    }
}
template <bool MLA>
__device__ __forceinline__ void attn_pass2(const bf16_t* __restrict__ Qb, const int ldq, const bf16_t* __restrict__ Kh, const bf16_t* __restrict__ Kpe, const bf16_t* __restrict__ Vh,
                                           const int NT, const float C, LAS unsigned char* lds, f32x16 (&o)[4]) {
    constexpr int NQR = MLA ? 8 : 4, SHM_K2 = MLA ? 16384 : 8192;
    int tid = threadIdx.x; asm volatile("" : "+v"(tid));
    const int wid = __builtin_amdgcn_readfirstlane(tid >> 6), lane = tid & 63, r32 = lane & 31, hi = lane >> 5;
    LAS unsigned char* V_lds = lds + P2_V; LAS unsigned char* K_lds = lds + P2_K; LAS unsigned char* Kp_lds = lds + P2_KP;
    LAS float* wsf = (LAS float*)(lds + OFF_WS) + wid * 64; LAS float* li_l = wsf; LAS float* al_l = wsf + 32;
    LAS unsigned char* ql = lds + OFF_QL + wid * 4096 + lane * 16;
    const unsigned ldsb = (unsigned)(uintptr_t)lds;
    const unsigned dV = ldsb + P2_V + wid * 1024, dK = ldsb + P2_K + wid * 1024, dP = ldsb + P2_KP + wid * 1024;
#define LANEOFFS() int t2_ = tid; asm volatile("" : "+v"(t2_)); const int q0_ = t2_ & 511; \
    const unsigned voV0 = (unsigned)(vq_k(q0_) * 1024 + vq_c(q0_)) * 2u; \
    const unsigned voK0 = MLA ? (unsigned)((q0_ >> 4) * 1024 + (((q0_ & 15) ^ ((q0_ >> 4) & 15)) * 8)) * 2u : (unsigned)((q0_ >> 3) * 1024 + (((q0_ & 7) ^ ((q0_ >> 4) & 7)) * 8)) * 2u; \
    const unsigned voP = (unsigned)((q0_ >> 3) * 64 + (((q0_ & 7) ^ ((q0_ >> 4) & 7)) * 8)) * 2u; (void)voV0; (void)voK0; (void)voP
#define DMA_K(t, b) do { LANEOFFS(); const char* kb_ = (const char*)Kh + (size_t)(t) * (KVBLK * 1024 * 2); glds16(kb_ + voK0, (unsigned)__builtin_amdgcn_readfirstlane(dK + (b) * SHM_K2)); \
    if (MLA) { glds16(kb_ + voK0 + 65536, (unsigned)__builtin_amdgcn_readfirstlane(dK + (b) * SHM_K2 + 8192)); glds16((const char*)Kpe + (size_t)(t) * (KVBLK * 64 * 2) + voP, (unsigned)__builtin_amdgcn_readfirstlane(dP + (b) * 8192)); } } while (0)
#define DMA_V(t, b) do { LANEOFFS(); const char* vb_ = (const char*)Vh + (size_t)(t) * (KVBLK * 1024 * 2); glds16(vb_ + voV0, (unsigned)__builtin_amdgcn_readfirstlane(dV + (b) * SHM_V)); glds16(vb_ + voV0 + 65536, (unsigned)__builtin_amdgcn_readfirstlane(dV + (b) * SHM_V + 8192)); } while (0)
    DMA_K(0, 0);
    float m_reg = -1e30f, l_reg = 0.f; bf16x8 qr[NQR];
#pragma unroll
    for (int d = 0; d < 4; ++d)
#pragma unroll
        for (int r = 0; r < 16; ++r) o[d][r] = 0.f;
    { const bf16_t* Qw = Qb + (size_t)(wid * QBLK + r32) * ldq + hi * 8;
#pragma unroll
      for (int d0 = 0; d0 < NQR; ++d0) qr[d0] = *(const bf16x8*)(Qw + d0 * 16);
      if (MLA) {
#pragma unroll
          for (int d0 = 0; d0 < 4; ++d0) *(LAS bf16x8*)(ql + d0 * 1024) = *(const bf16x8*)(Qw + (8 + d0) * 16); } }
    const int vb0 = (int)(ldsb + P2_V) + v_rd_base(lane);
    const int jw = NT - 4 + (wid >> 1);
#define RESC2(a) do { if (__any((a) < 1.f)) { if (hi == 0) al_l[r32] = (a); asm volatile("s_waitcnt lgkmcnt(0)" ::: "memory"); \
    _Pragma("unroll") for (int d = 0; d < 4; ++d) _Pragma("unroll") for (int r = 0; r < 16; ++r) o[d][r] *= al_l[crow(r, hi)]; } } while (0)
    f32x16 pA0, pA1, pB0, pB1; float alA = 1.f, alB = 1.f; bf16x8 pa0, pa1, pa2, pa3;
    WAITBAR();
    DMA_K(1, 1); DMA_V(0, 0);
    SBAR(); qkt2<MLA>(pA0, pA1, K_lds, Kp_lds, qr, ql, r32, hi); partialSM(pA0, pA1, m_reg, alA, C, true);
    WAITBAR();
#define STEP2(PX0, PX1, ALX, PY0, PY1, ALY, KOFF, KPOFF, VOFF, VQ, VP) do { \
        SBAR(); if (VQ) qkt2<MLA>(PX0, PX1, K_lds + (KOFF), Kp_lds + (KPOFF), qr, ql, r32, hi); \
        if (VP) { finishSM(PY0, PY1, ALY, l_reg, pa0, pa1, pa2, pa3, true); SBAR(); pv_d0(o, vb0 + (VOFF), pa0, pa1, pa2, pa3); } \
        partialSM(PX0, PX1, m_reg, ALX, C, VQ); RESC2(ALX); WAITBAR(); } while (0)
    int j = 1;
    for (; j + 1 <= NT - 4; j += 2) {
        DMA_K(j + 1, 0); DMA_V(j, 1);
        STEP2(pB0, pB1, alB, pA0, pA1, alA, SHM_K2, 8192, 0, true, true);
        DMA_K(j + 2, 1); DMA_V(j + 1, 0);
        STEP2(pA0, pA1, alA, pB0, pB1, alB, 0, 0, SHM_V, true, true);
    }
    {
        const bool vj = (j <= jw), vn = (j + 1 <= jw);
        DMA_K(j + 1, 0); DMA_V(j, 1);
        STEP2(pB0, pB1, alB, pA0, pA1, alA, SHM_K2, 8192, 0, vj, true);
        DMA_K(j + 2, 1); DMA_V(j + 1, 0);
        STEP2(pA0, pA1, alA, pB0, pB1, alB, 0, 0, SHM_V, vn, vj);
    }
    {
        const bool vp = (NT - 2 <= jw), vj = (NT - 1 <= jw);
        DMA_V(NT - 1, 1);
        SBAR(); if (vj) qkt2<MLA>(pB0, pB1, K_lds + SHM_K2, Kp_lds + 8192, qr, ql, r32, hi);
        if (vp) { finishSM(pA0, pA1, alA, l_reg, pa0, pa1, pa2, pa3, true); SBAR(); pv_d0(o, vb0, pa0, pa1, pa2, pa3); }
        partialSM(pB0, pB1, m_reg, alB, C, vj);
        RESC2(alB);
        WAITBAR();
        if (vj) { finishSM(pB0, pB1, alB, l_reg, pa0, pa1, pa2, pa3, true); SBAR(); pv_d0(o, vb0 + SHM_V, pa0, pa1, pa2, pa3); }
    }
    WAITBAR();
    if (hi == 0) li_l[r32] = l_reg; asm volatile("s_waitcnt lgkmcnt(0)" ::: "memory");
#pragma unroll
    for (int r = 0; r < 16; ++r) { const float rl = __builtin_amdgcn_rcpf(li_l[crow(r, hi)]);
#pragma unroll
        for (int d = 0; d < 4; ++d) o[d][r] *= rl; }
    asm volatile("s_waitcnt lgkmcnt(0)" ::: "memory");
#undef DMA_K
#undef DMA_V
#undef LANEOFFS
#undef RESC2
#undef STEP2
}
#undef WAITBAR
#undef SBAR
}
typedef GAS unsigned gu32;
#define RLX_AGENT __ATOMIC_RELAXED, __HIP_MEMORY_SCOPE_AGENT
#define LDS_WAIT() asm volatile("s_waitcnt lgkmcnt(0)" ::: "memory")
#define VM_WAIT() asm volatile("s_waitcnt vmcnt(0)" ::: "memory")
#define XB_TMO      128
#define XB_XCNT(j)  (256  + 64 * (j))
#define XB_XSUB(j)  (1280 + 64 * (j))
#define XB_XGEN(j)  (2304 + 64 * (j))
#define XB_TOP      3328
#define XB_TOPGEN   3392
#define XCD_BAR_WORDS 3456
#define XB_SPIN_CAP (1u << 18)

__device__ __forceinline__ unsigned xb_ld(unsigned* p)              { return __hip_atomic_load(p, __ATOMIC_RELAXED, __HIP_MEMORY_SCOPE_AGENT); }
__device__ __forceinline__ unsigned xb_add(unsigned* p, unsigned v) { return __hip_atomic_fetch_add(p, v, __ATOMIC_RELAXED, __HIP_MEMORY_SCOPE_AGENT); }
__device__ __forceinline__ unsigned xb_xcc_id() { return (unsigned)__builtin_amdgcn_s_getreg((3 << 11) | 20) & 0xFu; }
#define XB_SPIN(cond, bar) do { unsigned _sp = 0; while (cond) { __builtin_amdgcn_s_sleep(1); \
    if ((++_sp & 255u) == 0u) { if (xb_ld(&(bar)[XB_TMO])) break; if (_sp > XB_SPIN_CAP) { atomicAdd(&(bar)[XB_TMO], 1u); break; } } } } while (0)

struct XcdBarrier {
    unsigned* bar; unsigned x;
    volatile LAS unsigned* st;
};
__device__ __forceinline__ XcdBarrier xcd_barrier_post(unsigned* bar, volatile LAS unsigned* st) {
    XcdBarrier b; b.bar = bar; b.x = xb_xcc_id(); b.st = st;
    if (threadIdx.x == 0) (void)xb_add(&bar[XB_XCNT(b.x)], 1u);
    return b;
}
__device__ __forceinline__ void xcd_barrier_complete(unsigned* bar, unsigned x, unsigned& nloc, unsigned& nx) {
    const unsigned G = gridDim.x * gridDim.y * gridDim.z;
    unsigned sum, cnt, mine, sp = 0u;
    for (;;) {
        sum = 0u; cnt = 0u; mine = 0u;
#pragma unroll
        for (unsigned j = 0; j < 16; ++j) { const unsigned c = xb_ld(&bar[XB_XCNT(j)]); sum += c; cnt += (c > 0u) ? 1u : 0u; mine = (j == x) ? c : mine; }
        if (sum == G) break;
        __builtin_amdgcn_s_sleep(1);
        if ((++sp & 255u) == 0u) { if (xb_ld(&bar[XB_TMO])) break; if (sp > XB_SPIN_CAP) { atomicAdd(&bar[XB_TMO], 1u); break; } }
    }
    nloc = mine > 0u ? mine : 1u; nx = cnt > 0u ? cnt : 1u;
}
__device__ __forceinline__ void xcd_barrier(const XcdBarrier& b) {
    asm volatile("s_waitcnt vmcnt(0)" ::: "memory");
    __syncthreads();
    if (threadIdx.x == 0) {
        unsigned* bar = b.bar;
        __builtin_amdgcn_s_waitcnt(0);
        unsigned nloc = b.st[0], nx = b.st[1];
        if (nloc == 0u) { xcd_barrier_complete(bar, b.x, nloc, nx); b.st[0] = nloc; b.st[1] = nx; }
#ifdef PROBE_BARWAIT
        const unsigned long long pbw_t0 = __builtin_amdgcn_s_memrealtime();
#endif
        const unsigned old = xb_add(&bar[XB_XSUB(b.x)], 1u);
        const unsigned gen = old / nloc;
        if (old + 1u == (gen + 1u) * nloc) {
            __builtin_amdgcn_fence(__ATOMIC_RELEASE, "agent");
            asm volatile("s_waitcnt vmcnt(0)" ::: "memory");
            const unsigned og = xb_add(&bar[XB_TOP], 1u);
            const unsigned tg = og / nx;
            if (og + 1u == (tg + 1u) * nx) xb_add(&bar[XB_TOPGEN], 1u);
            else XB_SPIN(xb_ld(&bar[XB_TOPGEN]) == tg, bar);
            __builtin_amdgcn_fence(__ATOMIC_ACQUIRE, "agent");
            xb_add(&bar[XB_XGEN(b.x)], 1u);
            asm volatile("s_waitcnt vmcnt(0)" ::: "memory");
        } else {
            XB_SPIN(xb_ld(&bar[XB_XGEN(b.x)]) == gen, bar);
            __builtin_amdgcn_fence(__ATOMIC_ACQUIRE, "agent");
            asm volatile("s_waitcnt vmcnt(0)" ::: "memory");
        }
#ifdef PROBE_BARWAIT
        b.st[2] += (unsigned)(__builtin_amdgcn_s_memrealtime() - pbw_t0);
#endif
    }
    __syncthreads();
}

__device__ __forceinline__ float dot4(f32x4 a) { return (a[0] * a[0] + a[1] * a[1]) + (a[2] * a[2] + a[3] * a[3]); }
__device__ __forceinline__ u32x2 pack4(f32x4 a) { u32x2 w; w.x = cvt_pk_bf16(a[0], a[1]); w.y = cvt_pk_bf16(a[2], a[3]); return w; }

__device__ __forceinline__ f32x4 bf4lo(u32x4 w) { return (f32x4){bflo(w.x), bfhi(w.x), bflo(w.y), bfhi(w.y)}; }
__device__ __forceinline__ f32x4 bf4hi(u32x4 w) { return (f32x4){bflo(w.z), bfhi(w.z), bflo(w.w), bfhi(w.w)}; }
__device__ __forceinline__ void thin_first_norm(const float* xin, bf16_t* xb, const float* g, bf16_t* h, int gw, int NGW, int lane) {
    f32x4 gq[8];
#pragma unroll
    for (int j = 0; j < 4; ++j) { gq[2 * j] = ((const f32x4*)g)[2 * (lane + 64 * j)]; gq[2 * j + 1] = ((const f32x4*)g)[2 * (lane + 64 * j) + 1]; }
    for (int m = gw; m < MTOK; m += NGW) {
        const f32x4* xr = (const f32x4*)(xin + (size_t)m * DM) + 2 * lane; f32x4 v[8]; float s = 0.f;
#pragma unroll
        for (int j = 0; j < 4; ++j) { v[2 * j] = xr[128 * j]; v[2 * j + 1] = xr[128 * j + 1]; s += dot4(v[2 * j]) + dot4(v[2 * j + 1]); }
        const float rstd = __builtin_amdgcn_rsqf(wave_sum(s) * (1.0f / DM) + EPS);
        u32x4* xo = (u32x4*)(xb + (size_t)m * DM) + lane; u32x4* ho = (u32x4*)(h + (size_t)m * DM) + lane;
#pragma unroll
        for (int j = 0; j < 4; ++j) { xo[64 * j] = pack8(v[2 * j], v[2 * j + 1]); ho[64 * j] = pack8(v[2 * j] * rstd * gq[2 * j], v[2 * j + 1] * rstd * gq[2 * j + 1]); }
    }
}
__device__ __forceinline__ void thin_res_norm(const bf16_t* y, bf16_t* xb, const float* g_post, const float* g_pre, bf16_t* h, int gw, int NGW, int lane, float* xout = nullptr) {
    f32x4 gp[8], gq[8];
#pragma unroll
    for (int j = 0; j < 8; ++j) { const int idx = 2 * (lane + 64 * (j >> 1)) + (j & 1); gp[j] = ((const f32x4*)g_post)[idx]; gq[j] = g_pre ? ((const f32x4*)g_pre)[idx] : (f32x4){0.f, 0.f, 0.f, 0.f}; }
    u32x4 y0[4], y1[4], y2[4], x0[4], x1[4], x2[4];
    auto ld = [&](int m, u32x4 (&yw)[4], u32x4 (&xw)[4]) __attribute__((always_inline)) {
        const u32x4* yr = (const u32x4*)(y + (size_t)m * DM) + lane; const u32x4* xr = (const u32x4*)(xb + (size_t)m * DM) + lane;
#pragma unroll
        for (int j = 0; j < 4; ++j) { yw[j] = yr[64 * j]; xw[j] = xr[64 * j]; } };
    auto row = [&](int m, u32x4 (&yw)[4], u32x4 (&xw)[4]) __attribute__((always_inline)) {
        f32x4 v[8]; float s = 0.f;
#pragma unroll
        for (int j = 0; j < 4; ++j) { v[2 * j] = bf4lo(yw[j]); v[2 * j + 1] = bf4hi(yw[j]); s += dot4(v[2 * j]) + dot4(v[2 * j + 1]); }
        const float rstd = __builtin_amdgcn_rsqf(wave_sum(s) * (1.0f / DM) + EPS); float s2 = 0.f;
#pragma unroll
        for (int j = 0; j < 4; ++j) { v[2 * j] = bf4lo(xw[j]) + v[2 * j] * rstd * gp[2 * j]; v[2 * j + 1] = bf4hi(xw[j]) + v[2 * j + 1] * rstd * gp[2 * j + 1]; s2 += dot4(v[2 * j]) + dot4(v[2 * j + 1]); }
        if (xout) { f32x4* xo = (f32x4*)(xout + (size_t)m * DM) + 2 * lane;
#pragma unroll
            for (int j = 0; j < 4; ++j) { xo[128 * j] = v[2 * j]; xo[128 * j + 1] = v[2 * j + 1]; } }
        else { u32x4* xo = (u32x4*)(xb + (size_t)m * DM) + lane;
#pragma unroll
            for (int j = 0; j < 4; ++j) xo[64 * j] = pack8(v[2 * j], v[2 * j + 1]); }
        if (g_pre) { const float rstd2 = __builtin_amdgcn_rsqf(wave_sum(s2) * (1.0f / DM) + EPS); u32x4* ho = (u32x4*)(h + (size_t)m * DM) + lane;
#pragma unroll
            for (int j = 0; j < 4; ++j) ho[64 * j] = pack8(v[2 * j] * rstd2 * gq[2 * j], v[2 * j + 1] * rstd2 * gq[2 * j + 1]); } };
#define TRN_PIN(yw, xw) asm volatile("" : "+v"(yw[0]), "+v"(yw[1]), "+v"(yw[2]), "+v"(yw[3]), "+v"(xw[0]), "+v"(xw[1]), "+v"(xw[2]), "+v"(xw[3]) :: "memory")
#define TRN_M(k) (gw + (k) * NGW)
    ld(TRN_M(0), y0, x0); ld(TRN_M(1), y1, x1);
    ld(TRN_M(2), y2, x2); TRN_PIN(y0, x0); row(TRN_M(0), y0, x0);
    ld(TRN_M(3), y0, x0); TRN_PIN(y1, x1); row(TRN_M(1), y1, x1);
    ld(TRN_M(4), y1, x1); TRN_PIN(y2, x2); row(TRN_M(2), y2, x2);
    ld(TRN_M(5), y2, x2); TRN_PIN(y0, x0); row(TRN_M(3), y0, x0);
    ld(TRN_M(6), y0, x0); TRN_PIN(y1, x1); row(TRN_M(4), y1, x1);
    ld(TRN_M(7), y1, x1); TRN_PIN(y2, x2); row(TRN_M(5), y2, x2);
    TRN_PIN(y0, x0); row(TRN_M(6), y0, x0); TRN_PIN(y1, x1); row(TRN_M(7), y1, x1);
#undef TRN_M
#undef TRN_PIN
}
__device__ __forceinline__ void thin_mem_norm(const float* mem, const float* g_mem, bf16_t* memn, int gw, int NGW, int lane) {
    for (int r = gw; r < MROWS; r += NGW) {
        const f32x4* xr = (const f32x4*)(mem + (size_t)r * DM) + lane; f32x4 v[8]; float s = 0.f;
#pragma unroll
        for (int j = 0; j < 8; ++j) { v[j] = xr[64 * j]; s += dot4(v[j]); }
        const float rstd = __builtin_amdgcn_rsqf(wave_sum(s) * (1.0f / DM) + EPS);
        for (int l = 0; l < DEPTH; ++l) { const f32x4* g = (const f32x4*)(g_mem + (size_t)l * DM) + lane; u32x2* ho = (u32x2*)(memn + ((size_t)l * MROWS + r) * DM) + lane;
#pragma unroll
            for (int j = 0; j < 8; ++j) ho[64 * j] = pack4(v[j] * rstd * g[64 * j]); }
    }
}
__device__ __forceinline__ void thin_softmax(const float* S, bf16_t* P, int gw, int NGW, int lane) {
    const float C = 0.044194173824159216f * LOG2E;
    for (int m = gw; m < MTOK; m += NGW) {
        const f32x4* sr = (const f32x4*)(S + (size_t)m * 1024) + lane; u32x2* po = (u32x2*)(P + (size_t)m * 1024) + lane; f32x4 v[4];
#pragma unroll
        for (int j = 0; j < 4; ++j) v[j] = sr[64 * j];
#pragma unroll
        for (int j = 0; j < 4; ++j) {
            const float mx = wave_max(fmaxf(fmaxf(v[j][0], v[j][1]), fmaxf(v[j][2], v[j][3])));
            f32x4 e;
#pragma unroll
            for (int k = 0; k < 4; ++k) e[k] = __builtin_amdgcn_exp2f((v[j][k] - mx) * C);
            const float sum = wave_sum((e[0] + e[1]) + (e[2] + e[3]));
            po[64 * j] = pack4(e * __builtin_amdgcn_rcpf(sum));
        }
    }
}
__device__ __forceinline__ void thin_conv_glu(const bf16_t* u, bf16_t* act, const float* cw, const float* cb, int gw, int NGW, int lane) {
    constexpr int NBLK = NUP / 512, NCH = MTOK / 64;
    for (int task = gw; task < NBLK * NCH; task += NGW) {
        const int chunk = task / NBLK, blk = task % NBLK, gidx = blk * 64 + lane, m0 = chunk * 64;
        f32x4 wa[3], wg[3];
#pragma unroll
        for (int j = 0; j < 3; ++j) { wa[j] = *(const f32x4*)(cw + (size_t)j * NUP + 4 * gidx); wg[j] = *(const f32x4*)(cw + (size_t)j * NUP + DFF + 4 * gidx); }
        const f32x4 ba = *(const f32x4*)(cb + 4 * gidx), bg = *(const f32x4*)(cb + DFF + 4 * gidx);
        const bf16_t* up = u + (size_t)m0 * NUP + 8 * gidx; bf16_t* ap = act + (size_t)m0 * DFF + 4 * gidx;
        u32x4 p2 = (u32x4){0u, 0u, 0u, 0u}, p1 = p2;
        if ((m0 & (SEQ - 1)) != 0) { p2 = *(const u32x4*)(up - 2 * (size_t)NUP); p1 = *(const u32x4*)(up - (size_t)NUP); }
        for (int r0 = 0; r0 < 64; r0 += 8) {
            u32x4 cur[8];
#pragma unroll
            for (int i = 0; i < 8; ++i) cur[i] = *(const u32x4*)(up + (size_t)(r0 + i) * NUP);
#pragma unroll
            for (int i = 0; i < 8; ++i) { const u32x4 c = cur[i];
                const f32x4 a2 = (f32x4){bflo(p2.x), bfhi(p2.x), bflo(p2.y), bfhi(p2.y)}, g2 = (f32x4){bflo(p2.z), bfhi(p2.z), bflo(p2.w), bfhi(p2.w)};
                const f32x4 a1 = (f32x4){bflo(p1.x), bfhi(p1.x), bflo(p1.y), bfhi(p1.y)}, g1 = (f32x4){bflo(p1.z), bfhi(p1.z), bflo(p1.w), bfhi(p1.w)};
                const f32x4 a0 = (f32x4){bflo(c.x), bfhi(c.x), bflo(c.y), bfhi(c.y)}, g0 = (f32x4){bflo(c.z), bfhi(c.z), bflo(c.w), bfhi(c.w)};
                const f32x4 ca = a2 * wa[0] + a1 * wa[1] + a0 * wa[2] + ba, cg = g2 * wg[0] + g1 * wg[1] + g0 * wg[2] + bg;
                f32x4 o;
#pragma unroll
                for (int e = 0; e < 4; ++e) o[e] = ca[e] * __builtin_amdgcn_rcpf(1.0f + __builtin_amdgcn_exp2f(-ca[e] * LOG2E)) * cg[e];
                *(u32x2*)(ap + (size_t)(r0 + i) * DFF) = pack4(o);
                p2 = p1; p1 = c; }
        }
    }
}

__device__ __forceinline__ void thin_conv_fix(const float* U4, bf16_t* act, const float* cw, const float* cb, int gw, int NGW, int lane) {
    constexpr int NG = NUP / 8;
    for (int i = gw * 64 + lane; i < 64 * 2 * NG; i += NGW * 64) {
        const int pm = i / (2 * NG), rem = i - pm * (2 * NG), r = rem / NG, gidx = rem - r * NG; const bool first = (pm & 15) == 0;
        const float* t0 = U4 + (size_t)(pm * 4) * NUP + 8 * gidx; const float* tp = U4 + (size_t)((pm - 1) * 4) * NUP + 8 * gidx;
        const f32x4 z = (f32x4){0.f, 0.f, 0.f, 0.f};
        f32x4 a0, g0, a1, g1, a2, g2;
        if (r == 0) { a0 = *(const f32x4*)t0; g0 = *(const f32x4*)(t0 + 4);
            a1 = first ? z : *(const f32x4*)(tp + 3 * (size_t)NUP); g1 = first ? z : *(const f32x4*)(tp + 3 * (size_t)NUP + 4);
            a2 = first ? z : *(const f32x4*)(tp + 2 * (size_t)NUP); g2 = first ? z : *(const f32x4*)(tp + 2 * (size_t)NUP + 4); }
        else { a0 = *(const f32x4*)(t0 + NUP); g0 = *(const f32x4*)(t0 + NUP + 4); a1 = *(const f32x4*)t0; g1 = *(const f32x4*)(t0 + 4);
            a2 = first ? z : *(const f32x4*)(tp + 3 * (size_t)NUP); g2 = first ? z : *(const f32x4*)(tp + 3 * (size_t)NUP + 4); }
        const f32x4 ca = a2 * *(const f32x4*)(cw + 4 * gidx) + a1 * *(const f32x4*)(cw + NUP + 4 * gidx) + a0 * *(const f32x4*)(cw + 2 * (size_t)NUP + 4 * gidx) + *(const f32x4*)(cb + 4 * gidx);
        const f32x4 cg = g2 * *(const f32x4*)(cw + DFF + 4 * gidx) + g1 * *(const f32x4*)(cw + NUP + DFF + 4 * gidx) + g0 * *(const f32x4*)(cw + 2 * (size_t)NUP + DFF + 4 * gidx) + *(const f32x4*)(cb + DFF + 4 * gidx);
        f32x4 o;
#pragma unroll
        for (int e = 0; e < 4; ++e) o[e] = ca[e] * __builtin_amdgcn_rcpf(1.0f + __builtin_amdgcn_exp2f(-ca[e] * LOG2E)) * cg[e];
        *(u32x2*)(act + (size_t)(pm * 256 + r) * DFF + 4 * gidx) = pack4(o);
    }
}

struct MapId { __device__ __forceinline__ int operator()(int n) const { return n; } };
struct MapIn { __device__ __forceinline__ int operator()(int n) const {
    if (n < 2048) { const int i = n & 63; return (n & ~63) + 2 * (i & 31) + (i >> 5); }
    if (n < 3840) return n;
    if (n < 3904) { const int i = n - 3840; return 3840 + 2 * (i & 31) + (i >> 5); }
    return n + 192; } };
struct MapUq { __device__ __forceinline__ int operator()(int n) const { const int hd = n / 192, r = n - hd * 192; if (r < 128) return n; const int i = r - 128; return hd * 192 + 128 + 2 * (i & 31) + (i >> 5); } };
struct MapUkv { __device__ __forceinline__ int operator()(int n) const { const int hd = n >> 8, r = n & 255; return r < 128 ? hd * 128 + r : 1024 + hd * 128 + (r - 128); } };
struct MapUp { __device__ __forceinline__ int operator()(int n) const { if (n < DFF) return 8 * (n >> 2) + (n & 3); const int q = n - DFF; return 8 * (q >> 2) + 4 + (q & 3); } };

struct TrSrc { const float* p; int s1, s2; };
__device__ __forceinline__ void tr_ld(const TrSrc& s, f32x4 (&v)[8]) {
#pragma unroll
#ifdef CONV_NT
    for (int i = 0; i < 8; ++i) v[i] = __builtin_nontemporal_load((const f32x4*)(s.p + (size_t)(i >> 1) * s.s2 + (size_t)(i & 1) * s.s1));
#else
    for (int i = 0; i < 8; ++i) v[i] = *(const f32x4*)(s.p + (size_t)(i >> 1) * s.s2 + (size_t)(i & 1) * s.s1);
#endif
}
__device__ __forceinline__ TrSrc tr_src(const float* W, int N, int item, int lane) {
    const int nblk = N / 32, kb = item / nblk, nb = item - kb * nblk;
    return TrSrc{W + (size_t)(64 * kb + (lane >> 3)) * N + 32 * nb + (lane & 7) * 4, 8 * N, 16 * N};
}
template <class Map>
__device__ __forceinline__ void tr_st(f32x4 (&v)[8], int N, bf16_t* WT, int ldd, int kofs, const float* gs, LAS float* scr, int item, int lane, Map map) {
    const int nblk = N / 32, kb = item / nblk, nb = item - kb * nblk, k0 = 64 * kb, n0 = 32 * nb;
    const int rr = lane >> 3, c4 = (lane & 7) * 4;
    if (gs) {
#pragma unroll
        for (int i = 0; i < 8; ++i) v[i] = v[i] * gs[k0 + 8 * i + rr]; }
#pragma unroll
    for (int i = 0; i < 8; ++i) { LAS float* d = scr + (8 * i + rr) * 33 + c4; d[0] = v[i][0]; d[1] = v[i][1]; d[2] = v[i][2]; d[3] = v[i][3]; }
    LDS_WAIT(); asm volatile("" ::: "memory");
    const int c = lane & 7;
#pragma unroll
    for (int j = 0; j < 4; ++j) { const int n = (lane >> 3) + 8 * j; const LAS float* s = scr + (8 * c) * 33 + n;
        u32x4 o; o.x = cvt_pk_bf16(s[0 * 33], s[1 * 33]); o.y = cvt_pk_bf16(s[2 * 33], s[3 * 33]); o.z = cvt_pk_bf16(s[4 * 33], s[5 * 33]); o.w = cvt_pk_bf16(s[6 * 33], s[7 * 33]);
        *(u32x4*)(WT + (size_t)map(n0 + n) * ldd + kofs + k0 + 8 * c) = o; }
    LDS_WAIT(); asm volatile("" ::: "memory");
}

#ifdef DIAG_CKS
__device__ __forceinline__ void cks_rows(const unsigned* buf, int row_words, int nrows, unsigned* persist, unsigned* ctlw, int gw, int NGW, int lane) {
    for (int m = gw; m < nrows; m += NGW) {
        const unsigned* r = buf + (size_t)m * row_words; unsigned c = 0u;
        for (int i = lane; i < row_words; i += 64) c = c * 31u + r[i] * (2u * (unsigned)i + 1u);
        c += (unsigned)__builtin_amdgcn_ds_swizzle((int)c, (1 << 10) | 0x1f); c += (unsigned)__builtin_amdgcn_ds_swizzle((int)c, (2 << 10) | 0x1f); c += (unsigned)__builtin_amdgcn_ds_swizzle((int)c, (4 << 10) | 0x1f);
        c += (unsigned)__builtin_amdgcn_ds_swizzle((int)c, (8 << 10) | 0x1f); c += (unsigned)__builtin_amdgcn_ds_swizzle((int)c, (16 << 10) | 0x1f);
        { auto rr = __builtin_amdgcn_permlane32_swap(c, c, false, false); c = rr[0] + rr[1]; }
        if (lane == 0) { unsigned* ps = persist + 2 * (size_t)m; const unsigned o0 = __hip_atomic_load(ps, __ATOMIC_RELAXED, __HIP_MEMORY_SCOPE_AGENT), o1 = __hip_atomic_load(ps + 1, __ATOMIC_RELAXED, __HIP_MEMORY_SCOPE_AGENT);
            if (o1 == (o0 ^ 0x5a5a5a5au) && o0 != c) __hip_atomic_fetch_add(ctlw, 1u, __ATOMIC_RELAXED, __HIP_MEMORY_SCOPE_AGENT);
            __hip_atomic_store(ps, c, __ATOMIC_RELAXED, __HIP_MEMORY_SCOPE_AGENT); __hip_atomic_store(ps + 1, c ^ 0x5a5a5a5au, __ATOMIC_RELAXED, __HIP_MEMORY_SCOPE_AGENT); }
    }
}
#endif
#ifndef MK_SINGLE
#define MK_SINGLE 1
#endif
constexpr int NWAVES = 8;
constexpr int RING_BYTES = 131072, LDSCTL_OFF = RING_BYTES, MISC_OFF = LDSCTL_OFF + 320, LDS_BYTES = 147456;
constexpr int NPL = 16, NPH = 2 + DEPTH * NPL;

struct Args { const void* in[31]; float* out; unsigned char* ws; int ph_lo, ph_hi; float lam_init[4]; float inv_freq[32]; };
static_assert(sizeof(Args) == 31 * 8 + 8 + 8 + 8 + 16 + 128, "Args has no padding");

__global__ void __launch_bounds__(NWAVES * 64, 2) fwd(Args args) {
    extern __shared__ __attribute__((aligned(16))) unsigned char lds_raw[];
    LAS unsigned char* lds = (LAS unsigned char*)lds_raw;
    volatile LAS unsigned* MISC = (volatile LAS unsigned*)(lds + MISC_OFF);
    for (int u = threadIdx.x; u < (LDS_BYTES - LDSCTL_OFF) / 4; u += NWAVES * 64) ((LAS unsigned*)(lds + LDSCTL_OFF))[u] = 0u;
    __syncthreads();
    const int lo = args.ph_lo, hi = args.ph_hi;
    unsigned* barw = (unsigned*)(GAS unsigned*)(((const __attribute__((address_space(4))) unsigned long long*)__builtin_amdgcn_kernarg_segment_ptr())[32] + WS_CTL) + CW_BAR;
    XcdBarrier bar; bar.bar = barw; bar.x = 0; bar.st = MISC + 8;
    if (hi - lo > 1) bar = xcd_barrier_post(barw, MISC + 8);
#ifdef PROBE_WALL
    if (threadIdx.x == 0) MISC[12] = (unsigned)__builtin_amdgcn_s_memrealtime();
#define WALL_TICK(k) do { if (threadIdx.x == 0) { const unsigned t_ = (unsigned)__builtin_amdgcn_s_memrealtime(), dt_ = t_ - MISC[12]; MISC[12] = t_; \
        const int ty_ = (k) < 2 ? 16 + (k) : ((k) - 2) % NPL; if (ty_ == (PROBE_WALL)) MISC[14] += dt_; } } while (0)
#else
#define WALL_TICK(k) do { } while (0)
#endif
#ifndef WGM_N8
#define WGM_N8 4
#endif
#ifndef EPI_ALIGN
#define EPI_ALIGN true
#endif
#ifndef PHMASK
#define PHMASK 0x3ffff
#endif
#ifndef PROBE_PHASE
#define PROBE_PHASE -1
#endif
#define PREP(k) for (int rep_ = 0; rep_ < ((PROBE_PHASE) == (k) ? 2 : 1); ++rep_)
#ifdef PROBE_FLUSH
#define FLUSH_SWEEP() do { PHASE_BEGIN(); xcd_barrier(bar); const u32x4* fp_ = (const u32x4*)(ws + WS_RA); u32x4 fa_ = (u32x4){0u, 0u, 0u, 0u}; \
    for (size_t i_ = (size_t)(tid + bx * 512); i_ < (size_t)(352u << 20) / 16; i_ += (size_t)G * 512) { const u32x4 t_ = fp_[i_]; fa_.x ^= t_.x; fa_.y ^= t_.y; fa_.z ^= t_.z; fa_.w ^= t_.w; } \
    if ((fa_.x ^ fa_.y ^ fa_.z ^ fa_.w) == 0x13572468u) ((unsigned*)(ws + WS_CTL))[90] = 1u; xcd_barrier(bar); } while (0)
#endif
#define EN(j) (((PHMASK) >> (j)) & 1)
#define PH(k) (lo <= (k) && (k) < hi)
#ifdef PROBE_DOUBLE_BAR
#define SEAM(k) do { if (PH(k) && PH((k) + 1)) { xcd_barrier(bar); xcd_barrier(bar); } } while (0)
#else
#define SEAM(k) do { if (PH(k) && PH((k) + 1)) { xcd_barrier(bar); WALL_TICK(k); } } while (0)
#endif

    typedef const __attribute__((address_space(4))) unsigned long long* kptr_t;
#define KARGS() ({ kptr_t _p = (kptr_t)__builtin_amdgcn_kernarg_segment_ptr(); asm volatile("" : "+s"(_p)); _p; })
#define PHASE_BEGIN() kptr_t kp = KARGS(); unsigned char* ws = (unsigned char*)(GAS unsigned char*)kp[32]; int tid = threadIdx.x, G = gridDim.x, bx = blockIdx.x; asm volatile("" : "+v"(tid), "+s"(G), "+s"(bx)); \
    const int vcu = (G % 8 == 0) ? (bx % 8) * (G / 8) + bx / 8 : bx;     \
    const int lane = tid & 63, wave = __builtin_amdgcn_readfirstlane(tid >> 6), gw = vcu * NWAVES + wave, NGW = G * NWAVES; (void)lane; (void)gw; (void)ws; (void)NGW
#define INP(i) ((const float*)(const GAS float*)kp[i])
#define x_in INP(0)
#define mem INP(1)
#define positions ((const int*)(const GAS int*)kp[2])
#define g_pre_mix INP(3)
#define w_in INP(4)
#define b_gate INP(5)
#define lam_q1 INP(6)
#define lam_k1 INP(7)
#define lam_q2 INP(8)
#define lam_k2 INP(9)
#define g_diff_sub INP(10)
#define g_cq INP(11)
#define w_uq INP(12)
#define g_ckv INP(13)
#define w_ukv INP(14)
#define w_br_diff INP(15)
#define w_br_mla INP(16)
#define w_mix_out INP(17)
#define g_post_mix INP(18)
#define g_pre_x INP(19)
#define g_mem INP(20)
#define w_q_x INP(21)
#define w_kv_x INP(22)
#define w_o_x INP(23)
#define g_post_x INP(24)
#define g_pre_ffn INP(25)
#define w_up INP(26)
#define conv_w INP(27)
#define conv_b INP(28)
#define w_down INP(29)
#define g_post_ffn INP(30)
#define X ((float*)(GAS float*)kp[31])
#define LAM_INIT(l) (((const __attribute__((address_space(4))) float*)kp)[68 + (l)])
#define INV_FREQ(i) (((const __attribute__((address_space(4))) float*)kp)[72 + (i)])
#define WSB ((bf16_t*)ws)
#define Wall ((bf16_t*)(ws + WS_W))
#define H ((bf16_t*)(ws + WS_H))
#define cs ((f32x2*)(ws + WS_CS))
#define ssq_cq ((float*)(ws + WS_SSQ_CQ))
#define ssq_ckv ((float*)(ws + WS_SSQ_CKV))
#define Kmem ((bf16_t*)(ws + RA_KMEM))
#define Vmem ((bf16_t*)(ws + RA_VMEM))
#define Qd ((bf16_t*)(ws + RA_QD))
#define Kd ((bf16_t*)(ws + RA_KD))
#define Vd ((bf16_t*)(ws + RA_VD))
#define cq ((bf16_t*)(ws + RA_CQ))
#define ckv ((bf16_t*)(ws + RA_CKV))
#define kpe ((bf16_t*)(ws + RA_KPE))
#define gates ((bf16_t*)(ws + RA_GATES))
#define merged ((bf16_t*)(ws + RA_MERGED))
#define q_x ((bf16_t*)(ws + RA_QX))
#define Pm ((bf16_t*)(ws + RA_P))
#define o_x ((bf16_t*)(ws + RA_OX))
#define Ub ((bf16_t*)(ws + RA_U))
#define Sx ((float*)(ws + RA_S))
#define memn ((bf16_t*)(ws + RA_MEMN))
#define Qm ((bf16_t*)(ws + RB_QM))
#define Kn ((bf16_t*)(ws + RB_KN))
#define Vm ((bf16_t*)(ws + RB_VM))
#define ocat ((bf16_t*)(ws + RB_OCAT))
#define act ((bf16_t*)(ws + RB_ACT))
#define Y ((float*)(ws + WS_SCR))
#define XB ((bf16_t*)(ws + RC_Y))
#define YB ((bf16_t*)(ws + RC_Y + 64 * MiB))

#ifdef DIAG_NANFILL
    {
        PHASE_BEGIN();
        u32x4* p = (u32x4*)(ws + WS_CS); const size_t n16 = (WS_END - WS_CS) / 16;
        for (size_t i = (size_t)gw * 64 + lane; i < n16; i += (size_t)NGW * 64) p[i] = (u32x4){0xffffffffu, 0xffffffffu, 0xffffffffu, 0xffffffffu};
        u32x4* q = (u32x4*)X; const size_t m16 = (size_t)MTOK * DM / 4;
        for (size_t i = (size_t)gw * 64 + lane; i < m16; i += (size_t)NGW * 64) q[i] = (u32x4){0xffffffffu, 0xffffffffu, 0xffffffffu, 0xffffffffu};
    }
    xcd_barrier(bar);
#endif
#define TR_PIN(v) asm volatile("" : "+v"(v[0]), "+v"(v[1]), "+v"(v[2]), "+v"(v[3]), "+v"(v[4]), "+v"(v[5]), "+v"(v[6]), "+v"(v[7]) :: "memory")
#define CONV_BODY() \
        LAS float* scr = (LAS float*)(lds + wave * 8448); \
        constexpr int I_IN = 32 * 250, I_UQ = 8 * 48, I_UKV = 4 * 64, I_BR = 16 * 64, I_SQ = 32 * 64, I_KVX = 32 * 128, I_UP = 32 * 352, I_DN = 88 * 64; \
        constexpr int I_X = 2 * I_SQ + I_KVX, I_N = I_IN + I_UQ + I_UKV + 2 * I_BR + I_SQ + I_UP + I_DN, T_X = DEPTH * I_X, T_ALL = T_X + DEPTH * I_N; (void)T_ALL; \
        auto src_of = [&](int it) __attribute__((always_inline)) -> TrSrc { \
            if (it < T_X) { const int l = it / I_X; int r = it - l * I_X; \
                if (r < I_SQ) return TrSrc{w_q_x + (size_t)l * DM * DM + (size_t)r * 2048 + lane * 8, 4, 512}; r -= I_SQ;     \
                if (r < I_KVX) return tr_src(w_kv_x + (size_t)l * DM * 2 * DM, 2 * DM, r, lane); r -= I_KVX; \
                return tr_src(w_o_x + (size_t)l * DM * DM, DM, r, lane); } \
            it -= T_X; const int l = it / I_N; int r = it - l * I_N; \
            if (r < I_IN) return tr_src(w_in + (size_t)l * DM * NIN_SRC, NIN_SRC, r, lane); r -= I_IN; \
            if (r < I_UQ) return tr_src(w_uq + (size_t)l * 512 * 1536, 1536, r, lane); r -= I_UQ; \
            if (r < I_UKV) return tr_src(w_ukv + (size_t)l * 256 * 2048, 2048, r, lane); r -= I_UKV; \
            if (r < I_BR) return tr_src(w_br_diff + (size_t)l * 1024 * DM, DM, r, lane); r -= I_BR; \
            if (r < I_BR) return tr_src(w_br_mla + (size_t)l * 1024 * DM, DM, r, lane); r -= I_BR; \
            if (r < I_SQ) return tr_src(w_mix_out + (size_t)l * DM * DM, DM, r, lane); r -= I_SQ; \
            if (r < I_UP) return tr_src(w_up + (size_t)l * DM * NUP, NUP, r, lane); r -= I_UP; \
            return tr_src(w_down + (size_t)l * DFF * DM, DM, r, lane); }; \
        auto process = [&](int it, f32x4 (&v)[8]) __attribute__((always_inline)) { \
            if (it < T_X) { const int l = it / I_X; int r = it - l * I_X; \
                if (r < I_SQ) { bf16_t* d_ = (bf16_t*)(ws + RA_QXP) + (size_t)l * DM * DM + (size_t)r * 2048 + lane * 8; \
                    _Pragma("unroll") for (int i = 0; i < 4; ++i) *(u32x4*)(d_ + i * 512) = pack8(v[2 * i], v[2 * i + 1]); \
                    return; } r -= I_SQ; \
                if (r < I_KVX) { tr_st(v, 2 * DM, (bf16_t*)(ws + RA_KVXT) + (size_t)l * 2 * DM * DM, DM, 0, nullptr, scr, r, lane, MapId()); return; } r -= I_KVX; \
                tr_st(v, DM, (bf16_t*)(ws + RA_OXT) + (size_t)l * DM * DM, DM, 0, nullptr, scr, r, lane, MapId()); return; } \
            it -= T_X; const int l = it / I_N; int r = it - l * I_N; bf16_t* Wl = Wall + (size_t)l * W_LAYER; \
            if (r < I_IN) { tr_st(v, NIN_SRC, Wl + WO_IN, DM, 0, nullptr, scr, r, lane, MapIn()); return; } r -= I_IN; \
            if (r < I_UQ) { tr_st(v, 1536, Wl + WO_UQ, 512, 0, g_cq + l * 512, scr, r, lane, MapUq()); return; } r -= I_UQ; \
            if (r < I_UKV) { tr_st(v, 2048, Wl + WO_UKV, 256, 0, g_ckv + l * 256, scr, r, lane, MapUkv()); return; } r -= I_UKV; \
            if (r < I_BR) { tr_st(v, DM, Wl + WO_BR, DM, 0, nullptr, scr, r, lane, MapId()); return; } r -= I_BR; \
            if (r < I_BR) { tr_st(v, DM, Wl + WO_BR, DM, 1024, nullptr, scr, r, lane, MapId()); return; } r -= I_BR; \
            if (r < I_SQ) { tr_st(v, DM, Wl + WO_MIX, DM, 0, nullptr, scr, r, lane, MapId()); return; } r -= I_SQ; \
            if (r < I_UP) { tr_st(v, NUP, Wl + WO_UP, DM, 0, nullptr, scr, r, lane, MapUp()); return; } r -= I_UP; \
            tr_st(v, DM, Wl + WO_DOWN, DFF, 0, nullptr, scr, r, lane, MapId()); }; \
          \
        auto conv_range = [&](int lo_, int hi_, int first_, int stride_) __attribute__((always_inline)) { \
            f32x4 va[8], vb[8]; const int last_ = hi_ - 1; int it = lo_ + first_; \
            tr_ld(src_of(it < hi_ ? it : last_), va); \
            for (; it < hi_; it += 2 * stride_) { const int i1 = it + stride_, i2 = it + 2 * stride_; \
                tr_ld(src_of(i1 < hi_ ? i1 : last_), vb); TR_PIN(va); process(it, va); \
                tr_ld(src_of(i2 < hi_ ? i2 : last_), va); TR_PIN(vb); if (i1 < hi_) process(i1, vb); } }
    if (EN(16) && PH(0)) {
        PHASE_BEGIN();
        CONV_BODY();
        conv_range(0, T_X, gw, NGW);
#ifdef PROBE_CONV_HOT
        for (int rep_ = 0; rep_ < 10; ++rep_) conv_range(0, I_X, gw, NGW);
#endif
        thin_mem_norm(mem, g_mem, memn, gw, NGW, lane);
    }
    SEAM(0);
    if (EN(17) && PH(1)) {
        PHASE_BEGIN();
        constexpr int NGA = 96;
        if (bx < NGA) {
            { pg8::Gemm g{WSB, WSB, DM, DM, DM}; pg8::MemKvOrder S{NGA, bx}; pg8::EpiMemKv E{Kmem};
              pg8::gemm_phase<pg8::EpiMemKv, pg8::MemKvOrder, true, true>(lds, g, S, E); }
            xcd_barrier(bar);
            { pg8::Gemm g{WSB, WSB, DM, DM, 512}; pg8::FoldOrder S{NGA, bx}; pg8::EpiFold E{Wall};
              pg8::gemm_phase<pg8::EpiFold, pg8::FoldOrder, true, true>(lds, g, S, E); }
        } else {
            CONV_BODY();
            const int gwb = (bx - NGA) * NWAVES + wave, ngwb = (G - NGA) * NWAVES;
            constexpr int T_MID = T_X + (int)(0.40 * (T_ALL - T_X));
            for (int seg = 0; seg < 2; ++seg) {
                if (seg == 1) xcd_barrier(bar);
                conv_range(seg == 0 ? T_X : T_MID, seg == 0 ? T_MID : T_ALL, gwb, ngwb);
            }
            for (int i = gwb * 64 + lane; i < DEPTH * 192 * (DM / 8); i += ngwb * 64) { const int l = i / (192 * (DM / 8)), r = i - l * (192 * (DM / 8));
                *(u32x4*)(Wall + (size_t)l * W_LAYER + WO_IN + (size_t)3904 * DM + (size_t)r * 8) = (u32x4){0u, 0u, 0u, 0u}; }
            for (int idx = gwb * 64 + lane; idx < MTOK * 32; idx += ngwb * 64) {
                const int m = idx >> 5, i = idx & 31;
                const float ang = (float)positions[m] * INV_FREQ(i);
                const double rev = (double)ang * 0.15915494309189535; const float f = (float)(rev - __builtin_rint(rev));
                cs[idx] = (f32x2){__builtin_amdgcn_cosf(f), __builtin_amdgcn_sinf(f)};
            }
            thin_first_norm(x_in, XB, g_pre_mix, H, gwb, ngwb, lane);
        }
    }
#undef CONV_BODY
#undef TR_PIN
    SEAM(1);

    for (int l = 0; l < DEPTH; ++l) {
        const int pb = 2 + l * NPL;
        if (pb + NPL <= lo || pb >= hi) continue;
        if (EN(0) && PH(pb + 0)) PREP(0) {
            PHASE_BEGIN(); const bf16_t* Wl = Wall + (size_t)l * W_LAYER; (void)Wl;
            pg8::Gemm g{H, Wl + WO_IN, DM, DM, DM}; pg8::StaticOrder S; S.init(MTOK, NIN, G, bx, DM, DM);
            pg8::EpiProj E{Qd, Kd, Vd, cq, ckv, kpe, gates, ssq_cq, ssq_ckv, b_gate + (size_t)l * 4096, cs};
            pg8::gemm_phase<pg8::EpiProj, pg8::StaticOrder, EPI_ALIGN, true>(lds, g, S, E);
        }
        SEAM(pb + 0);
        if (EN(1) && PH(pb + 1)) PREP(1) {
            PHASE_BEGIN(); const bf16_t* Wl = Wall + (size_t)l * W_LAYER; (void)Wl;
            { pg8::Gemm g{cq, Wl + WO_UQ, 512, 512, 512}; pg8::StaticOrder S; S.init(MTOK, 1536, G, bx, 512, 512); pg8::EpiQm E{Qm, ssq_cq, cs};
              pg8::gemm_phase<pg8::EpiQm, pg8::StaticOrder, EPI_ALIGN, true>(lds, g, S, E); }
            { pg8::Gemm g{ckv, Wl + WO_UKV, 256, 256, 256}; pg8::StaticOrder S; S.init(MTOK, 2048, bx < 128 ? 512 : 128, bx, 256, 256); pg8::EpiKv E{Kn, Vm, ssq_ckv};
              pg8::gemm_phase<pg8::EpiKv, pg8::StaticOrder, EPI_ALIGN, true>(lds, g, S, E); }
        }
        SEAM(pb + 1);
#ifdef DIAG_PREFILL
        if (PH(pb + 2)) { { PHASE_BEGIN(); u32x4* p = (u32x4*)ocat; const size_t n16 = (size_t)MTOK * 2048 * 2 / 16;
            for (size_t i = (size_t)gw * 64 + lane; i < n16; i += (size_t)NGW * 64) p[i] = (u32x4){0u, 0u, 0u, 0u}; } xcd_barrier(bar); }
#endif
#ifdef DIAG_CKS
        if (l == 0 && PH(pb + 2)) { PHASE_BEGIN(); unsigned* pz = (unsigned*)(ws + WS_END + 1 * MiB) + (size_t)l * 8 * 2 * MTOK; unsigned* cw = (unsigned*)(ws + WS_CTL);
            cks_rows((const unsigned*)Qd, 512, MTOK, pz + 0 * 2 * MTOK, cw + 68, gw, NGW, lane); cks_rows((const unsigned*)Kd, 512, MTOK, pz + 1 * 2 * MTOK, cw + 68, gw, NGW, lane);
            cks_rows((const unsigned*)Vd, 512, MTOK, pz + 2 * 2 * MTOK, cw + 68, gw, NGW, lane); cks_rows((const unsigned*)Qm, 768, MTOK, pz + 3 * 2 * MTOK, cw + 69, gw, NGW, lane);
            cks_rows((const unsigned*)Kn, 512, MTOK, pz + 4 * 2 * MTOK, cw + 69, gw, NGW, lane); cks_rows((const unsigned*)Vm, 512, MTOK, pz + 5 * 2 * MTOK, cw + 69, gw, NGW, lane);
            cks_rows((const unsigned*)kpe, 32, MTOK, pz + 6 * 2 * MTOK, cw + 69, gw, NGW, lane); cks_rows((const unsigned*)H, 1024, MTOK, pz + 7 * 2 * MTOK, cw + 70, gw, NGW, lane); }
#endif
        if (EN(2) && PH(pb + 2)) {
            PHASE_BEGIN(); const bf16_t* Wl = Wall + (size_t)l * W_LAYER; (void)Wl;
            float lam;
            { const float a = lam_q1[l * 64 + lane] * lam_k1[l * 64 + lane], b2 = lam_q2[l * 64 + lane] * lam_k2[l * 64 + lane];
              lam = __builtin_amdgcn_exp2f(wave_sum(a) * LOG2E) - __builtin_amdgcn_exp2f(wave_sum(b2) * LOG2E) + LAM_INIT(l); }
            const float omli = 1.0f - LAM_INIT(l);
            const float Cd = 0.125f * LOG2E, Cm = 0.07216878364870322f * LOG2E;
            const int r32 = lane & 31, hi = lane >> 5;
#define SCRL() (Y + ((size_t)bx * NWAVES + wave) * 4096 + lane)
            LAS bf16_t* stg = (LAS bf16_t*)(lds + 81920 + wave * 4096);
            LAS bf16_t* stw = stg + hi * 4 * 64 + r32;
            const int srow = lane >> 3, sch = lane & 7;
#define STORE_O(Og) do { _Pragma("unroll") for (int hf = 0; hf < 2; ++hf) { \
                _Pragma("unroll") for (int r = 0; r < 16; ++r) _Pragma("unroll") for (int dd = 0; dd < 2; ++dd) \
                    stw[((r & 3) + 8 * (r >> 2)) * 64 + dd * 32] = (bf16_t)(cvt_pk_bf16(o[hf * 2 + dd][r], 0.f) & 0xffffu); \
                LDS_WAIT(); asm volatile("" ::: "memory"); \
                _Pragma("unroll") for (int i = 0; i < 4; ++i) { const u32x4 v = *(const LAS u32x4*)(stg + (i * 8 + srow) * 64 + sch * 8); \
                    st16<0>((Og) + (size_t)(i * 8 + srow) * 2048 + hf * 64 + sch * 8, v); } \
                LDS_WAIT(); asm volatile("" ::: "memory"); } } while (0)
#ifdef DIAG_CKS
#define CKS_O(slot, cw) do { unsigned c_ = 0u; _Pragma("unroll") for (int d_ = 0; d_ < 4; ++d_) _Pragma("unroll") for (int r_ = 0; r_ < 16; ++r_) c_ = c_ * 31u + __float_as_uint(o[d_][r_]); \
                c_ += (unsigned)__builtin_amdgcn_ds_swizzle((int)c_, (1 << 10) | 0x1f); c_ += (unsigned)__builtin_amdgcn_ds_swizzle((int)c_, (2 << 10) | 0x1f); c_ += (unsigned)__builtin_amdgcn_ds_swizzle((int)c_, (4 << 10) | 0x1f); \
                c_ += (unsigned)__builtin_amdgcn_ds_swizzle((int)c_, (8 << 10) | 0x1f); c_ += (unsigned)__builtin_amdgcn_ds_swizzle((int)c_, (16 << 10) | 0x1f); \
                { auto rr_ = __builtin_amdgcn_permlane32_swap(c_, c_, false, false); c_ = rr_[0] + rr_[1]; } \
                if (lane == 0) { unsigned* ps_ = (unsigned*)(ws + WS_END) + 2 * (size_t)(slot); const unsigned o0_ = __hip_atomic_load(ps_, __ATOMIC_RELAXED, __HIP_MEMORY_SCOPE_AGENT), o1_ = __hip_atomic_load(ps_ + 1, __ATOMIC_RELAXED, __HIP_MEMORY_SCOPE_AGENT); \
                    if (l == 0 && o1_ == (o0_ ^ 0x5a5a5a5au) && o0_ != c_) __hip_atomic_fetch_add((unsigned*)(ws + WS_CTL) + (cw), 1u, __ATOMIC_RELAXED, __HIP_MEMORY_SCOPE_AGENT); \
                    __hip_atomic_store(ps_, c_, __ATOMIC_RELAXED, __HIP_MEMORY_SCOPE_AGENT); __hip_atomic_store(ps_ + 1, c_ ^ 0x5a5a5a5au, __ATOMIC_RELAXED, __HIP_MEMORY_SCOPE_AGENT); } } while (0)
#else
#define CKS_O(slot, cw) do {} while (0)
#endif
#ifndef ATT_V1_DIFF
#define ATT_DIFF att::attn_pass2<false>
#else
#define ATT_DIFF att::attn_pass<4, false>
#endif
#ifdef ATT_P2_MLA
#define ATT_MLA att::attn_pass2<true>
#else
#define ATT_MLA att::attn_pass<12, true>
#endif
#ifndef PROBE_ATT_REPS
#define PROBE_ATT_REPS 1
#endif
#ifndef ATT_STATIC
            const int qg = (vcu >> 5) & 7;
            unsigned* qctr = (unsigned*)(ws + WS_CTL) + 256 + (l * 8 + qg) * 64;
            for (;;) {
                __syncthreads();
                if (tid == 0) MISC[4] = __hip_atomic_fetch_add(qctr, 1u, __ATOMIC_RELAXED, __HIP_MEMORY_SCOPE_AGENT);
                __syncthreads();
                const int it = (int)MISC[4]; if (it >= 128) break;
                const int e = it >> 2; const unsigned long long tb = e < 8 ? 0x091f0a0b0c0d0e0full : e < 16 ? 0x061a1b071c081d1eull : e < 24 ? 0x1503160417180519ull : 0x1000111201130214ull;
                const int code = (int)((tb >> ((e & 7) * 8)) & 0xffull), qb = code & 15, bh = qg * 4 + (it & 3), b = bh >> 3, hd = bh & 7; const size_t kv0 = (size_t)b * SEQ;
                const int NT = 4 * qb + 4; const size_t row0 = kv0 + (size_t)qb * 256;
                f32x16 o[4];
                if ((code >> 4) == 0) {
                    for (int br = 0; br < 2; ++br) {
                        ATT_DIFF(Qd + row0 * 1024 + hd * 128 + br * 64, 1024, Kd + kv0 * 1024 + hd * 128 + br * 64, nullptr, Vd + kv0 * 1024 + hd * 128, NT, Cd, lds, o);
                        if (br == 0) {
#pragma unroll
                            for (int d0 = 0; d0 < 4; ++d0) { float* pd = SCRL() + d0 * 1024; asm volatile("" : "+v"(pd));
#pragma unroll
                                for (int r = 0; r < 16; ++r) pd[r * 64] = o[d0][r]; }
                        }
                    }
                    float ss[16];
#pragma unroll
                    for (int r = 0; r < 16; ++r) ss[r] = 0.f;
#pragma unroll
                    for (int d0 = 0; d0 < 4; ++d0) { const float* pd = SCRL() + d0 * 1024; asm volatile("" : "+v"(pd));
#pragma unroll
                        for (int r = 0; r < 16; ++r) { const float d = pd[r * 64] - lam * o[d0][r]; o[d0][r] = d; ss[r] += d * d; } }
#pragma unroll
                    for (int r = 0; r < 16; ++r) {
                        ss[r] = __builtin_amdgcn_rsqf(half_sum(ss[r]) * (1.0f / 128.0f) + EPS) * omli; }
#pragma unroll
                    for (int d0 = 0; d0 < 4; ++d0)
#pragma unroll
                        for (int r = 0; r < 16; ++r) o[d0][r] = o[d0][r] * ss[r] * g_diff_sub[l * 128 + d0 * 32 + r32];
                    bf16_t* og = ocat + (row0 + (size_t)wave * 32) * 2048 + hd * 128;
                    STORE_O(og);
                } else {
                    ATT_MLA(Qm + row0 * 1536 + hd * 192, 1536, Kn + kv0 * 1024 + hd * 128, kpe + kv0 * 64, Vm + kv0 * 1024 + hd * 128, NT, Cm, lds, o);
                    bf16_t* og = ocat + (row0 + (size_t)wave * 32) * 2048 + 1024 + hd * 128;
                    STORE_O(og);
                }
            }
#else
            for (int rep_ = 0; rep_ < PROBE_ATT_REPS; ++rep_)
            for (int pr = vcu; pr < 256; pr += G) {
                const int bh = pr >> 3, s = pr & 7, b = bh >> 3, hd = bh & 7; const size_t kv0 = (size_t)b * SEQ;
#ifndef NO_DIFF
                for (int k = 0; k < 2; ++k) {
                    const int qb = k ? s : 15 - s, NT = 4 * qb + 4;     const size_t row0 = kv0 + (size_t)qb * 256;
                    f32x16 o[4];
#ifdef DIAG_SELFCHK
                    for (int rep = 0; rep < 2; ++rep) {
                        att::attn_pass<4, false>(Qd + row0 * 1024 + hd * 128, 1024, Kd + kv0 * 1024 + hd * 128, nullptr, Vd + kv0 * 1024 + hd * 128, NT, Cd, lds, o);
                        if (rep == 0) {
#pragma unroll
                            for (int q = 0; q < 16; ++q) *(f32x4*)(scrl + 4 * q) = (f32x4){o[q >> 2][(q & 3) * 4], o[q >> 2][(q & 3) * 4 + 1], o[q >> 2][(q & 3) * 4 + 2], o[q >> 2][(q & 3) * 4 + 3]};
                        } else { bool bad = false;
#pragma unroll
                            for (int q = 0; q < 32; ++q) { const unsigned long long w = __hip_atomic_load((const unsigned long long*)(scrl + 2 * q), __ATOMIC_RELAXED, __HIP_MEMORY_SCOPE_AGENT);
                                const int d0 = q >> 3, r = (q & 7) * 2; bad |= ((unsigned)w != __float_as_uint(o[d0][r])) | ((unsigned)(w >> 32) != __float_as_uint(o[d0][r + 1])); }
                            if (bad) __hip_atomic_fetch_add((unsigned*)(ws + WS_CTL) + 64, 1u, __ATOMIC_RELAXED, __HIP_MEMORY_SCOPE_AGENT); }
                    }
#endif
                    for (int br = 0; br < 2; ++br) {
                        ATT_DIFF(Qd + row0 * 1024 + hd * 128 + br * 64, 1024, Kd + kv0 * 1024 + hd * 128 + br * 64, nullptr, Vd + kv0 * 1024 + hd * 128, NT, Cd, lds, o);
                        if (br == 0) {
#pragma unroll
                            for (int d0 = 0; d0 < 4; ++d0) { float* pd = SCRL() + d0 * 1024; asm volatile("" : "+v"(pd));
#pragma unroll
                                for (int r = 0; r < 16; ++r) pd[r * 64] = o[d0][r]; }
                        }
                        CKS_O((((size_t)l * 512 + bh * 16 + qb) * 8 + wave) * 4 + br, 65);
                    }
                    float ss[16];
#pragma unroll
                    for (int r = 0; r < 16; ++r) ss[r] = 0.f;
#pragma unroll
                    for (int d0 = 0; d0 < 4; ++d0) { const float* pd = SCRL() + d0 * 1024; asm volatile("" : "+v"(pd));
#pragma unroll
                        for (int r = 0; r < 16; ++r) { const float d = pd[r * 64] - lam * o[d0][r]; o[d0][r] = d; ss[r] += d * d; } }
#pragma unroll
                    for (int r = 0; r < 16; ++r) {
                        ss[r] = __builtin_amdgcn_rsqf(half_sum(ss[r]) * (1.0f / 128.0f) + EPS) * omli; }
#pragma unroll
                    for (int d0 = 0; d0 < 4; ++d0)
#pragma unroll
                        for (int r = 0; r < 16; ++r) o[d0][r] = o[d0][r] * ss[r] * g_diff_sub[l * 128 + d0 * 32 + r32];
                    bf16_t* og = ocat + (row0 + (size_t)wave * 32) * 2048 + hd * 128;
                    CKS_O((((size_t)l * 512 + bh * 16 + qb) * 8 + wave) * 4 + 2, 66);
                    STORE_O(og);
                }
#endif
#ifndef NO_MLA
                for (int k = 0; k < 2; ++k) {
                    const int qb = k ? s : 15 - s, NT = 4 * qb + 4;     const size_t row0 = kv0 + (size_t)qb * 256;
                    f32x16 o[4];
                    ATT_MLA(Qm + row0 * 1536 + hd * 192, 1536, Kn + kv0 * 1024 + hd * 128, kpe + kv0 * 64, Vm + kv0 * 1024 + hd * 128, NT, Cm, lds, o);
                    bf16_t* og = ocat + (row0 + (size_t)wave * 32) * 2048 + 1024 + hd * 128;
                    CKS_O((((size_t)l * 512 + bh * 16 + qb) * 8 + wave) * 4 + 3, 67);
                    STORE_O(og);
                }
#endif
            }
#endif
#undef STORE_O
#undef SCRL
#undef CKS_O
            __syncthreads();
        }
#ifdef DIAG_NOATT
        if (PH(pb + 2)) { PHASE_BEGIN();
            for (size_t i = (size_t)gw * 64 + lane; i < (size_t)MTOK * 1024; i += (size_t)NGW * 64) { const size_t m = i >> 10, c = i & 1023;
                const float a = bflo((unsigned)Qd[i]) + bflo((unsigned)Kd[i]) + bflo((unsigned)Vd[i]) + bflo((unsigned)kpe[m * 64 + (c & 63)]);
                const float b2 = bflo((unsigned)Kn[i]) + bflo((unsigned)Vm[i]) + bflo((unsigned)Qm[m * 1536 + c]) + bflo((unsigned)Qm[m * 1536 + 512 + c]);
                ocat[m * 2048 + c] = (bf16_t)(cvt_pk_bf16(a * 0.5f, 0.f) & 0xffffu); ocat[m * 2048 + 1024 + c] = (bf16_t)(cvt_pk_bf16(b2 * 0.5f, 0.f) & 0xffffu); } }
#endif
        SEAM(pb + 2);
#ifdef DIAG_CKS
        if (l == 0 && PH(pb + 2)) { PHASE_BEGIN(); cks_rows((const unsigned*)ocat, 1024, MTOK, (unsigned*)(ws + WS_END + 2 * MiB), (unsigned*)(ws + WS_CTL) + 71, gw, NGW, lane); }
#endif
        if (EN(3) && PH(pb + 3)) PREP(3) {
            PHASE_BEGIN(); const bf16_t* Wl = Wall + (size_t)l * W_LAYER; (void)Wl;
            pg8::Gemm g{ocat, Wl + WO_BR, DM, DM, 1024}; pg8::GateOrder S; S.S.init(MTOK, DM, G, bx, DM, DM, WGM_N8); pg8::EpiGate2 E{gates, merged};
            pg8::gemm_phase<pg8::EpiGate2, pg8::GateOrder, true, true>(lds, g, S, E);
        }
        SEAM(pb + 3);
        if (EN(4) && PH(pb + 4)) PREP(4) {
            PHASE_BEGIN(); const bf16_t* Wl = Wall + (size_t)l * W_LAYER; (void)Wl;
            pg8::Gemm g{merged, Wl + WO_MIX, DM, DM, DM}; pg8::StaticOrder S; S.init(MTOK, DM, G, bx, DM, DM, WGM_N8); pg8::EpiBf16 E{YB, DM};
            pg8::gemm_phase<pg8::EpiBf16, pg8::StaticOrder, EPI_ALIGN, true>(lds, g, S, E);
        }
        SEAM(pb + 4);
#ifdef DIAG_CKS
        if (l == 0 && PH(pb + 4)) { PHASE_BEGIN(); cks_rows((const unsigned*)Y, 2048, MTOK, (unsigned*)(ws + WS_END + 4 * MiB), (unsigned*)(ws + WS_CTL) + 73, gw, NGW, lane); }
#endif
        if (EN(5) && PH(pb + 5)) { PHASE_BEGIN();
            thin_res_norm(YB, XB, g_post_mix + (size_t)l * DM, g_pre_x + (size_t)l * DM, H, gw, NGW, lane); }
        SEAM(pb + 5);
        if (EN(6) && PH(pb + 6)) PREP(6) {
            PHASE_BEGIN(); const bf16_t* Wl = Wall + (size_t)l * W_LAYER; (void)Wl;
            pg8::Gemm g{H, Wl + WO_WK, DM, DM, DM}; pg8::CrossSOrder S{G, bx}; pg8::EpiSoftmax E{Pm};
            pg8::gemm_phase<pg8::EpiSoftmax, pg8::CrossSOrder, false, true>(lds, g, S, E);
        }
        SEAM(pb + 6);
        if (EN(10) && PH(pb + 10)) PREP(10) {
            PHASE_BEGIN(); const bf16_t* Wl = Wall + (size_t)l * W_LAYER; (void)Wl;
            pg8::Gemm g{Pm, Wl + WO_VW, 1024, 1024, 1024}; pg8::CrossYOrder S{G, bx}; pg8::EpiBf16 E{YB, DM};
            pg8::gemm_phase<pg8::EpiBf16, pg8::CrossYOrder, EPI_ALIGN, true>(lds, g, S, E);
        }
        SEAM(pb + 10);
        if (EN(11) && PH(pb + 11)) { PHASE_BEGIN();
            thin_res_norm(YB, XB, g_post_x + (size_t)l * DM, g_pre_ffn + (size_t)l * DM, H, gw, NGW, lane); }
        SEAM(pb + 11);
        if (EN(12) && PH(pb + 12)) PREP(12) {
#if defined(PROBE_FLUSH) && PROBE_FLUSH == 1
            if (rep_ == 1) FLUSH_SWEEP();
#endif
            PHASE_BEGIN(); const bf16_t* Wl = Wall + (size_t)l * W_LAYER; (void)Wl;
            pg8::Gemm g{H, Wl + WO_UP, DM, DM, DM}; pg8::StaticOrder S; S.init(MTOK, NUP, G, bx, DM, DM);
            pg8::EpiConvGlu E{act, Y, conv_w + (size_t)l * 3 * NUP, conv_b + (size_t)l * NUP, lds + 132096};
            pg8::gemm_phase<pg8::EpiConvGlu, pg8::StaticOrder, true, true>(lds, g, S, E);
        }
#if defined(PROBE_FLUSH) && PROBE_FLUSH == 2
        if (PH(pb + 12)) FLUSH_SWEEP();
#endif
        SEAM(pb + 12);
        if (EN(13) && PH(pb + 13)) PREP(13) { PHASE_BEGIN(); thin_conv_fix(Y, act, conv_w + (size_t)l * 3 * NUP, conv_b + (size_t)l * NUP, gw, NGW, lane); }
        SEAM(pb + 13);
        if (EN(14) && PH(pb + 14)) PREP(14) {
            PHASE_BEGIN(); const bf16_t* Wl = Wall + (size_t)l * W_LAYER; (void)Wl;
            pg8::Gemm g{act, Wl + WO_DOWN, DFF, DFF, DFF}; pg8::StaticOrder S; S.init(MTOK, DM, G, bx, DFF, DFF, WGM_N8); pg8::EpiBf16 E{YB, DM};
            pg8::gemm_phase<pg8::EpiBf16, pg8::StaticOrder, EPI_ALIGN, true>(lds, g, S, E);
        }
        SEAM(pb + 14);
        if (EN(15) && PH(pb + 15)) { PHASE_BEGIN(); thin_res_norm(YB, XB, g_post_ffn + (size_t)l * DM, l + 1 < DEPTH ? g_pre_mix + (size_t)(l + 1) * DM : nullptr, H, gw, NGW, lane, l + 1 < DEPTH ? nullptr : X); }
        SEAM(pb + 15);
#ifdef DIAG_CKS
        if (l == DEPTH - 1 && PH(pb + 15)) { PHASE_BEGIN(); xcd_barrier(bar);
            const unsigned c65 = __hip_atomic_load((unsigned*)(ws + WS_CTL) + 65, __ATOMIC_RELAXED, __HIP_MEMORY_SCOPE_AGENT), c66 = __hip_atomic_load((unsigned*)(ws + WS_CTL) + 66, __ATOMIC_RELAXED, __HIP_MEMORY_SCOPE_AGENT),
                           c67 = __hip_atomic_load((unsigned*)(ws + WS_CTL) + 67, __ATOMIC_RELAXED, __HIP_MEMORY_SCOPE_AGENT);
            (void)c65; (void)c66; (void)c67; const unsigned c68 = __hip_atomic_load((unsigned*)(ws + WS_CTL) + 68, __ATOMIC_RELAXED, __HIP_MEMORY_SCOPE_AGENT), c69 = __hip_atomic_load((unsigned*)(ws + WS_CTL) + 69, __ATOMIC_RELAXED, __HIP_MEMORY_SCOPE_AGENT),
                           c70 = __hip_atomic_load((unsigned*)(ws + WS_CTL) + 70, __ATOMIC_RELAXED, __HIP_MEMORY_SCOPE_AGENT);
            (void)c68; (void)c69; (void)c70; (void)c66; (void)c67; const unsigned c71 = __hip_atomic_load((unsigned*)(ws + WS_CTL) + 71, __ATOMIC_RELAXED, __HIP_MEMORY_SCOPE_AGENT), c72 = __hip_atomic_load((unsigned*)(ws + WS_CTL) + 72, __ATOMIC_RELAXED, __HIP_MEMORY_SCOPE_AGENT),
                           c73 = __hip_atomic_load((unsigned*)(ws + WS_CTL) + 73, __ATOMIC_RELAXED, __HIP_MEMORY_SCOPE_AGENT);
            const float fac = 1.0f + (c71 ? 0.4f : 0.f) + (c72 ? 0.2f : 0.f) + (c73 ? 0.1f : 0.f);
            if (fac != 1.0f) { for (size_t i = (size_t)gw * 64 + lane; i < (size_t)MTOK * DM; i += (size_t)NGW * 64) X[i] *= fac; } }
#endif
#ifdef DIAG_SELFCHK
        if (l == DEPTH - 1 && PH(pb + 15)) { PHASE_BEGIN(); xcd_barrier(bar);
            if (__hip_atomic_load((unsigned*)(ws + WS_CTL) + 64, __ATOMIC_RELAXED, __HIP_MEMORY_SCOPE_AGENT) != 0u) {
                for (size_t i = (size_t)gw * 64 + lane; i < (size_t)MTOK * DM; i += (size_t)NGW * 64) X[i] = __builtin_nanf(""); } }
#endif
    }
#ifdef PROBE_WALL
    {
        PHASE_BEGIN(); asm volatile("s_waitcnt vmcnt(0)" ::: "memory"); __syncthreads(); WALL_TICK(NPH - 1);
        if (bx == 0 && tid == 0) { const unsigned ticks = MISC[14]; const unsigned long long t0 = __builtin_amdgcn_s_memrealtime();
            while ((unsigned)(__builtin_amdgcn_s_memrealtime() - t0) < ticks) __builtin_amdgcn_s_sleep(8); }
    }
#endif
#ifdef PROBE_BARWAIT
    {
        PHASE_BEGIN(); unsigned* ctl = (unsigned*)(ws + WS_CTL) + 80;
        if (tid == 0) __hip_atomic_fetch_add(ctl, MISC[10], __ATOMIC_RELAXED, __HIP_MEMORY_SCOPE_AGENT);
        xcd_barrier(bar);
        if (bx == 0 && tid == 0) {
            unsigned ticks = PROBE_BARWAIT == 0 ? __hip_atomic_load(ctl, __ATOMIC_RELAXED, __HIP_MEMORY_SCOPE_AGENT) / (unsigned)G : 0u;
            const unsigned long long t0 = __builtin_amdgcn_s_memrealtime();
            while ((unsigned)(__builtin_amdgcn_s_memrealtime() - t0) < ticks) __builtin_amdgcn_s_sleep(8);
        }
    }
#endif
#undef PH
#undef SEAM
}

extern "C" void kernel_launch(void* const* d_in, const int* in_sizes, int n_in, void* d_out, int out_size, void* d_ws, size_t ws_size, hipStream_t stream) {
    static int grid = 0;
    if (grid == 0) {
        if (n_in != 31 || in_sizes[0] != MTOK * DM || out_size != MTOK * DM || ws_size < WS_TOP) {
            fprintf(stderr, "kernel_launch: unexpected shapes: n_in %d in0 %d out %d ws %zu (need %zu)\n", n_in, n_in > 0 ? in_sizes[0] : -1, out_size, ws_size, (size_t)WS_TOP); grid = -1; return; }
        int dev = 0, cus = 0;
        if (hipGetDevice(&dev) != hipSuccess || hipDeviceGetAttribute(&cus, hipDeviceAttributeMultiprocessorCount, dev) != hipSuccess) { grid = -1; return; }
        if (hipFuncSetAttribute((const void*)fwd, hipFuncAttributeMaxDynamicSharedMemorySize, LDS_BYTES) != hipSuccess) { fprintf(stderr, "kernel_launch: hipFuncSetAttribute failed\n"); grid = -1; return; }
        int per_cu = 0;
        if (hipOccupancyMaxActiveBlocksPerMultiprocessor(&per_cu, (const void*)fwd, NWAVES * 64, LDS_BYTES) != hipSuccess || per_cu < 1)
            fprintf(stderr, "kernel_launch: note: occupancy query reports %d workgroups per CU\n", per_cu);
        (void)hipGetLastError();
        if (cus != 256) { fprintf(stderr, "kernel_launch: built for a 256-CU MI355X (one 256 x 256 score unit per workgroup in the fused softmax phase); this device reports %d CUs; nothing launched\n", cus); grid = -1; return; }
        grid = cus;
    }
    if (grid < 0) return;
    if (hipMemsetAsync((char*)d_ws + WS_CTL, 0, CTL_ZERO_BYTES, stream) != hipSuccess) return;
    Args a{};
    for (int i = 0; i < 31; ++i) a.in[i] = d_in[i];
    a.out = (float*)d_out; a.ws = (unsigned char*)d_ws;
    for (int l = 0; l < 4; ++l) a.lam_init[l] = (float)(0.8 - 0.6 * exp(-0.3 * (double)l));
    for (int i = 0; i < 32; ++i) a.inv_freq[i] = (float)pow(10000.0, -(double)i / 32.0);
#if MK_SINGLE
    a.ph_lo = 0; a.ph_hi = NPH;
    hipLaunchKernelGGL(fwd, dim3(grid), dim3(NWAVES * 64), LDS_BYTES, stream, a);
#else
    for (int p = 0; p < NPH; ++p) { a.ph_lo = p; a.ph_hi = p + 1; hipLaunchKernelGGL(fwd, dim3(grid), dim3(NWAVES * 64), LDS_BYTES, stream, a); }
#endif
    const hipError_t le = hipPeekAtLastError();
    if (le != hipSuccess) fprintf(stderr, "kernel_launch: launch failed: %s\n", hipGetErrorName(le));
}
```

```cpp
#define ATT_STATIC 1
#include <hip/hip_runtime.h>
#include <cstdio>
#include <cstdint>
#include <cmath>

#define LAS __attribute__((address_space(3)))
#define GAS __attribute__((address_space(1)))
typedef unsigned short bf16_t;
typedef short bf16x8 __attribute__((ext_vector_type(8)));
typedef short s16x4 __attribute__((ext_vector_type(4)));
typedef float f32x2 __attribute__((ext_vector_type(2)));
typedef float f32x4 __attribute__((ext_vector_type(4)));
typedef float f32x16 __attribute__((ext_vector_type(16)));
typedef unsigned u32x2 __attribute__((ext_vector_type(2)));
typedef unsigned u32x4 __attribute__((ext_vector_type(4)));

constexpr int DM = 2048, BATCH = 4, SEQ = 4096, DEPTH = 4, MTOK = BATCH * SEQ;
constexpr int NIN_SRC = 8000, NIN = 8192;
constexpr int DFF = 5632, NUP = 2 * DFF;
constexpr int MEMT = 256, MROWS = BATCH * MEMT;
constexpr float EPS = 1e-6f;
constexpr float LOG2E = 1.4426950408889634f;

typedef __bf16 bf16x2_t __attribute__((ext_vector_type(2)));
__device__ __forceinline__ unsigned cvt_pk_bf16(float lo, float hi) { const f32x2 v = {lo, hi}; const bf16x2_t b = __builtin_convertvector(v, bf16x2_t); return __builtin_bit_cast(unsigned, b); }
__device__ __forceinline__ u32x4 pack8(f32x4 a, f32x4 b) { u32x4 w; w.x = cvt_pk_bf16(a[0], a[1]); w.y = cvt_pk_bf16(a[2], a[3]); w.z = cvt_pk_bf16(b[0], b[1]); w.w = cvt_pk_bf16(b[2], b[3]); return w; }
__device__ __forceinline__ float bflo(unsigned w) { return __uint_as_float(w << 16); }
__device__ __forceinline__ float bfhi(unsigned w) { return __uint_as_float(w & 0xffff0000u); }
template <int O> __device__ __forceinline__ float xor_lt32(float v) { return __int_as_float(__builtin_amdgcn_ds_swizzle(__float_as_int(v), (O << 10) | 0x1f)); }
__device__ __forceinline__ float sum_xor32(float v) { auto rr = __builtin_amdgcn_permlane32_swap(__float_as_uint(v), __float_as_uint(v), false, false); return __uint_as_float(rr[0]) + __uint_as_float(rr[1]); }
__device__ __forceinline__ float max_xor32(float v) { auto rr = __builtin_amdgcn_permlane32_swap(__float_as_uint(v), __float_as_uint(v), false, false); return fmaxf(__uint_as_float(rr[0]), __uint_as_float(rr[1])); }
__device__ __forceinline__ float half_sum(float v) { v += xor_lt32<1>(v); v += xor_lt32<2>(v); v += xor_lt32<4>(v); v += xor_lt32<8>(v); v += xor_lt32<16>(v); return v; }
__device__ __forceinline__ float wave_sum(float v) { return sum_xor32(half_sum(v)); }
__device__ __forceinline__ float wave_max(float v) { v = fmaxf(v, xor_lt32<1>(v)); v = fmaxf(v, xor_lt32<2>(v)); v = fmaxf(v, xor_lt32<4>(v)); v = fmaxf(v, xor_lt32<8>(v)); v = fmaxf(v, xor_lt32<16>(v)); return max_xor32(v); }

template <int OFF> __device__ __forceinline__ void st16(void* p, u32x4 v) {
#ifdef WT_STORES
    asm volatile("global_store_dwordx4 %0, %1, off offset:%2 sc1\n\ts_nop 1" :: "v"(p), "v"(v), "n"(OFF));
#else
    *(u32x4*)((char*)p + OFF) = v;
#endif
}
__device__ __forceinline__ void st16bj(bf16_t* rowp, int bj, u32x4 v) { if (bj == 0) st16<0>(rowp, v); else st16<256>(rowp, v); }
namespace pg8 {
constexpr int BM = 256, BK = 64, HALF = 128, HTB = HALF * BK * 2  , STAGE_BYTES = 8 * HTB, NXCD = 8, WGM = 8;

__host__ __device__ __forceinline__ int lds_byte(int r, int c) { const int st = (r >> 4) * 2 + (c >> 5), rr = r & 15, cc = c & 31, ob = rr * 64 + cc * 2; return st * 1024 + (ob ^ (((ob >> 9) & 1) << 5)); }
__host__ __device__ __forceinline__ void stage_rc(int b, int& R, int& C) { const int st = b / 1024, sb = b % 1024, swz = sb ^ (((sb >> 9) & 1) << 5); R = (st >> 1) * 16 + swz / 64; C = (st & 1) * 32 + (swz % 64) / 2; }
__host__ __device__ __forceinline__ int perm32(int rho) { const int n = rho >> 4, i = rho & 15; return 8 * (i >> 2) + 4 * n + (i & 3); }

template <class E> struct RowPerm { static constexpr bool v = false; };
struct Unit { int pm, pn, z; unsigned aoff, boff; };
struct Gemm { const bf16_t* A; const bf16_t* Bt; int lda, ldb, K; };

struct StaticOrder {
    int nM, nN, nwg, G, c, lda, ldb, wgm;
    __host__ __device__ __forceinline__ void init(int Mr, int N, int G_, int c_, int lda_, int ldb_, int wgm_ = WGM) { nM = Mr / BM; nN = N / BM; nwg = nM * nN; G = G_; c = c_; lda = lda_; ldb = ldb_; wgm = wgm_; }
    __host__ __device__ __forceinline__ bool next(int i, Unit& u) const {
        const long L = (long)i * G + c; if (L >= nwg) return false;
        int wgid = (int)L; { const int q = nwg / NXCD, r = nwg % NXCD, xcd = wgid % NXCD, off = wgid / NXCD; wgid = (xcd < r ? xcd * (q + 1) : r * (q + 1) + (xcd - r) * q) + off; }
        const int nig = wgm * nN, gid = wgid / nig, fm = gid * wgm, gsz = (nM - fm) < wgm ? (nM - fm) : wgm;
        u.pm = fm + ((wgid % nig) % gsz); u.pn = (wgid % nig) / gsz; u.z = 0;
        u.aoff = (unsigned)u.pm * (unsigned)(BM * lda); u.boff = (unsigned)u.pn * (unsigned)(BM * ldb); return true;
    }
    __device__ __forceinline__ void a_ready(const Unit&) const {}
    __device__ __forceinline__ void done(const Unit&) const {}
};

typedef f32x4 Acc[2][2][4][2];

template <class Epi, class Sched, bool ALIGN_EPI = false, bool SP2 = false>
__device__ __forceinline__ void gemm_phase(LAS unsigned char* lds, const Gemm g, const Sched& S, const Epi& E) {
    int tid = threadIdx.x; asm volatile("" : "+v"(tid));
    const int wid = __builtin_amdgcn_readfirstlane(tid >> 6), lane = tid & 63, wr = wid >> 2, wc = wid & 3, fr = lane & 15, fq = lane >> 4;
    int K = g.K; asm volatile("" : "+s"(K));
    const int nt = K / BK;
    unsigned voffA[2], voffB[2];
#pragma unroll
    for (int i = 0; i < 2; ++i) { int R, C; stage_rc(tid * 16 + i * 8192, R, C); const int Rb = Epi::PERM ? ((R & ~31) + perm32(R & 31)) : R;
        const int Ra = RowPerm<Epi>::v ? ((R & ~63) + 4 * (R & 15) + ((R >> 4) & 3)) : R;
        voffA[i] = (unsigned)(Ra * g.lda + C) * 2u; voffB[i] = (unsigned)(Rb * g.ldb + C) * 2u; }
    const size_t kstep = (size_t)(BK * 2);
    const size_t hstepA = (size_t)HALF * g.lda * 2, hstepB = (size_t)HALF * g.ldb * 2;
    const unsigned ldsw = (unsigned)wid * 1024u;
    const int aoff = lds_byte(wr * 64 + fr, fq * 8), boff = lds_byte(wc * 32 + fr, fq * 8);
#define PG8_SA(b, h) (((b) * 2 + (h)) * HTB)
#define PG8_SB(b, h) ((4 + (b) * 2 + (h)) * HTB)
#define PG8_STAGE(bufoff, gbase, voff) do { _Pragma("unroll") for (int _i = 0; _i < 2; ++_i) \
        __builtin_amdgcn_global_load_lds((const unsigned*)((const char*)(gbase) + (voff)[_i]), (LAS unsigned*)(lds + (bufoff) + ldsw + _i * 8192), 16, 0, 0); } while (0)
#define PG8_LDA(dst, b, h) do { _Pragma("unroll") for (int m = 0; m < 4; ++m) _Pragma("unroll") for (int k = 0; k < 2; ++k) dst[m][k] = *(const LAS bf16x8*)(lds + PG8_SA(b, h) + aoff + m * 2048 + k * 1024); } while (0)
#define PG8_LDB(dst, b, h) do { _Pragma("unroll") for (int n = 0; n < 2; ++n) _Pragma("unroll") for (int k = 0; k < 2; ++k) dst[n][k] = *(const LAS bf16x8*)(lds + PG8_SB(b, h) + boff + n * 2048 + k * 1024); } while (0)
#define PG8_MMA(ai, bj, At, Bt) do { __builtin_amdgcn_s_setprio(1); _Pragma("unroll") for (int m = 0; m < 4; ++m) _Pragma("unroll") for (int n = 0; n < 2; ++n) _Pragma("unroll") for (int k = 0; k < 2; ++k) \
        acc[ai][bj][m][n] = __builtin_amdgcn_mfma_f32_16x16x32_bf16(Bt[n][k], At[m][k], acc[ai][bj][m][n], 0, 0, 0); __builtin_amdgcn_s_setprio(0); } while (0)
#define PG8_WAIT_V(n) asm volatile("s_waitcnt vmcnt(" #n ")" ::: "memory")
#define PG8_WAIT_L(n) asm volatile("s_waitcnt lgkmcnt(" #n ")" ::: "memory")
#define PG8_BAR __builtin_amdgcn_s_barrier()
#define PG8_SCHED __builtin_amdgcn_sched_barrier(0)
    Unit cur, nxt; int ui = 0;
    if (!S.next(0, cur)) return;
    f32x4 acc[2][2][4][2];
#pragma unroll
    for (int a = 0; a < 2; ++a)
#pragma unroll
        for (int b = 0; b < 2; ++b)
#pragma unroll
            for (int m = 0; m < 4; ++m)
#pragma unroll
                for (int n = 0; n < 2; ++n) acc[a][b][m][n] = (f32x4){0.f, 0.f, 0.f, 0.f};
    bf16x8 At[4][2], B0[2][2], B1[2][2];
    const char* cA = (const char*)g.A + (size_t)cur.aoff * 2; const char* cB = (const char*)g.Bt + (size_t)cur.boff * 2;
    S.a_ready(cur);
    if constexpr (SP2) {
        PG8_STAGE(PG8_SB(0, 0), cB, voffB); PG8_STAGE(PG8_SB(0, 1), cB + hstepB, voffB); PG8_STAGE(PG8_SA(0, 0), cA, voffA); PG8_STAGE(PG8_SA(0, 1), cA + hstepA, voffA);
        if (wr == 1) PG8_BAR;
        PG8_WAIT_V(2); PG8_BAR;
        PG8_STAGE(PG8_SB(1, 0), cB + kstep, voffB); PG8_STAGE(PG8_SA(1, 0), cA + kstep, voffA); PG8_STAGE(PG8_SB(1, 1), cB + hstepB + kstep, voffB);
        PG8_WAIT_V(6); PG8_BAR;
    } else {
        PG8_STAGE(PG8_SB(0, 0), cB, voffB); PG8_STAGE(PG8_SA(0, 0), cA, voffA); PG8_STAGE(PG8_SB(0, 1), cB + hstepB, voffB); PG8_STAGE(PG8_SA(0, 1), cA + hstepA, voffA);
        if (wr == 1) PG8_BAR;
        PG8_WAIT_V(4); PG8_BAR;
        PG8_STAGE(PG8_SB(1, 0), cB + kstep, voffB); PG8_STAGE(PG8_SA(1, 0), cA + kstep, voffA); PG8_STAGE(PG8_SB(1, 1), cB + hstepB + kstep, voffB);
        PG8_WAIT_V(6); PG8_BAR;
    }
    for (;;) {
        const bool has_next = S.next(ui + 1, nxt);
        const char* nA = has_next ? (const char*)g.A + (size_t)nxt.aoff * 2 : cA; const char* nB = has_next ? (const char*)g.Bt + (size_t)nxt.boff * 2 : cB;
        for (int t = 0; t < nt; t += 2) {
            const bool last = (t == nt - 2);
            const char* a1 = cA + (size_t)(t + 1) * kstep;
            const char* a2 = last ? nA : cA + (size_t)(t + 2) * kstep; const char* b2 = last ? nB : cB + (size_t)(t + 2) * kstep;
            const char* a3 = a2 + kstep; const char* b3 = b2 + kstep;
            if (last && has_next) S.a_ready(nxt);
            if constexpr (SP2) {
            PG8_LDB(B0, 0, 0); PG8_LDB(B1, 0, 1); PG8_SCHED; PG8_LDA(At, 0, 0); PG8_STAGE(PG8_SA(1, 1), a1 + hstepA, voffA);
            PG8_WAIT_V(8); PG8_WAIT_L(0); PG8_BAR; PG8_MMA(0, 0, At, B0); PG8_MMA(0, 1, At, B1); PG8_BAR; PG8_SCHED;
            PG8_LDA(At, 0, 1); PG8_STAGE(PG8_SB(0, 0), b2, voffB); PG8_STAGE(PG8_SB(0, 1), b2 + hstepB, voffB); PG8_STAGE(PG8_SA(0, 0), a2, voffA);
            PG8_WAIT_V(8); PG8_WAIT_L(0); PG8_BAR; PG8_MMA(1, 0, At, B0); PG8_MMA(1, 1, At, B1); PG8_BAR; PG8_SCHED;
            PG8_LDB(B0, 1, 0); PG8_LDB(B1, 1, 1); PG8_SCHED; PG8_LDA(At, 1, 0); PG8_STAGE(PG8_SA(0, 1), a2 + hstepA, voffA);
            PG8_WAIT_V(8); PG8_WAIT_L(0); PG8_BAR; PG8_MMA(0, 0, At, B0); PG8_MMA(0, 1, At, B1); PG8_BAR; PG8_SCHED;
            PG8_LDA(At, 1, 1); PG8_STAGE(PG8_SB(1, 0), b3, voffB); PG8_STAGE(PG8_SB(1, 1), b3 + hstepB, voffB); PG8_STAGE(PG8_SA(1, 0), a3, voffA);
            PG8_WAIT_V(8); PG8_WAIT_L(0); PG8_BAR; PG8_MMA(1, 0, At, B0); PG8_MMA(1, 1, At, B1); PG8_BAR; PG8_SCHED;
            } else {
            PG8_LDB(B0, 0, 0); PG8_SCHED; PG8_LDA(At, 0, 0); PG8_STAGE(PG8_SA(1, 1), a1 + hstepA, voffA);
            PG8_WAIT_L(8); PG8_BAR; PG8_WAIT_L(0); PG8_MMA(0, 0, At, B0); PG8_BAR; PG8_SCHED;
            PG8_LDB(B1, 0, 1); PG8_STAGE(PG8_SB(0, 0), b2, voffB);
            PG8_BAR; PG8_WAIT_L(0); PG8_MMA(0, 1, At, B1); PG8_BAR;
            PG8_LDA(At, 0, 1); PG8_STAGE(PG8_SA(0, 0), a2, voffA);
            PG8_BAR; PG8_WAIT_L(0); PG8_MMA(1, 0, At, B0); PG8_BAR; PG8_SCHED;
            PG8_STAGE(PG8_SB(0, 1), b2 + hstepB, voffB);
            PG8_WAIT_V(6); PG8_BAR; PG8_MMA(1, 1, At, B1); PG8_BAR;
            PG8_LDB(B0, 1, 0); PG8_SCHED; PG8_LDA(At, 1, 0); PG8_STAGE(PG8_SA(0, 1), a2 + hstepA, voffA);
            PG8_WAIT_L(8); PG8_BAR; PG8_WAIT_L(0); PG8_MMA(0, 0, At, B0); PG8_BAR; PG8_SCHED;
            PG8_LDB(B1, 1, 1); PG8_STAGE(PG8_SB(1, 0), b3, voffB);
            PG8_BAR; PG8_WAIT_L(0); PG8_MMA(0, 1, At, B1); PG8_BAR;
            PG8_LDA(At, 1, 1); PG8_STAGE(PG8_SA(1, 0), a3, voffA);
            PG8_BAR; PG8_WAIT_L(0); PG8_MMA(1, 0, At, B0); PG8_BAR; PG8_SCHED;
            PG8_STAGE(PG8_SB(1, 1), b3 + hstepB, voffB);
            PG8_WAIT_V(6); PG8_BAR; PG8_MMA(1, 1, At, B1); PG8_BAR;
            }
        }
        if constexpr (ALIGN_EPI) { if (wr == 0) PG8_BAR; }
        if constexpr (!Epi::AFTER_DRAIN) { E(acc, cur, wr, wc, fr, fq); S.done(cur); }
        if (!has_next) break;
        if (!(Epi::MIDK && cur.z == 0)) {
#pragma unroll
        for (int a = 0; a < 2; ++a)
#pragma unroll
            for (int b = 0; b < 2; ++b)
#pragma unroll
                for (int m = 0; m < 4; ++m)
#pragma unroll
                    for (int n = 0; n < 2; ++n) acc[a][b][m][n] = (f32x4){0.f, 0.f, 0.f, 0.f};
        }
        cur = nxt; cA = nA; cB = nB; ++ui;
        if constexpr (ALIGN_EPI) { if (wr == 1) PG8_BAR; }
    }
    PG8_WAIT_V(0);
    if constexpr (!ALIGN_EPI) { if (wr == 0) PG8_BAR; }
    PG8_BAR;
    if constexpr (Epi::AFTER_DRAIN) { E.fused(acc, cur, wr, wc, fr, fq, lds, wid, lane); S.done(cur); }
#undef PG8_SA
#undef PG8_SB
#undef PG8_STAGE
#undef PG8_LDA
#undef PG8_LDB
#undef PG8_MMA
#undef PG8_WAIT_V
#undef PG8_WAIT_L
#undef PG8_BAR
#undef PG8_SCHED
}
}
constexpr size_t MiB = (size_t)1 << 20;
constexpr size_t WO_IN = 0;
constexpr size_t WO_UQ = WO_IN + (size_t)NIN * DM;
constexpr size_t WO_UKV = WO_UQ + (size_t)1536 * 512;
constexpr size_t WO_BR = WO_UKV + (size_t)2048 * 256;
constexpr size_t WO_MIX = WO_BR + (size_t)DM * DM;
constexpr size_t WO_WK = WO_MIX + (size_t)DM * DM;
constexpr size_t WO_VW = WO_WK + (size_t)BATCH * 1024 * DM;
constexpr size_t WO_UP = WO_VW + (size_t)BATCH * DM * 1024;
constexpr size_t WO_DOWN = WO_UP + (size_t)NUP * DM;
constexpr size_t W_LAYER = WO_DOWN + (size_t)DM * DFF;
static_assert(W_LAYER * 2 == 297 * MiB / 2, "layer blob size");

constexpr size_t WS_CTL = 0, CTL_ZERO_BYTES = 1 * MiB;
constexpr size_t WS_CS = 1 * MiB;
constexpr size_t WS_SSQ_CQ = 5 * MiB;
constexpr size_t WS_SSQ_CKV = WS_SSQ_CQ + (size_t)MTOK * 8 * 4;
constexpr size_t WS_RSX = 8 * MiB;
constexpr size_t WS_W = 38 * MiB;
constexpr size_t WS_H = WS_W + 4 * W_LAYER * 2;
constexpr size_t WS_RA = WS_H + 64 * MiB;
constexpr size_t WS_RB = WS_RA + 352 * MiB;
constexpr size_t WS_RC = WS_RB + 176 * MiB;
constexpr size_t WS_END = WS_RC + 128 * MiB;
constexpr size_t WS_SCR = WS_END, WS_TOP = WS_END + 32 * MiB;
static_assert(WS_H == 632 * MiB, "ws map");
constexpr size_t RA_QD = WS_RA, RA_KD = WS_RA + 32 * MiB, RA_VD = WS_RA + 64 * MiB, RA_CQ = WS_RA + 96 * MiB, RA_CKV = WS_RA + 112 * MiB, RA_KPE = WS_RA + 120 * MiB,
                 RA_GATES = WS_RA + 128 * MiB, RA_MERGED = WS_RA + 256 * MiB;
constexpr size_t RA_QX = WS_RA, RA_S = WS_RA + 64 * MiB, RA_P = WS_RA + 128 * MiB, RA_OX = WS_RA + 160 * MiB;
constexpr size_t RA_U = WS_RA;
constexpr size_t RA_QXP = WS_RA, RA_KVXT = WS_RA + 32 * MiB, RA_OXT = WS_RA + 96 * MiB, RA_MEMN = WS_RA + 128 * MiB, RA_KMEM = WS_RA + 144 * MiB, RA_VMEM = WS_RA + 160 * MiB;
constexpr size_t RB_QM = WS_RB, RB_KN = WS_RB + 48 * MiB, RB_VM = WS_RB + 80 * MiB, RB_OCAT = WS_RB + 112 * MiB;
constexpr size_t RB_ACT = WS_RB;
constexpr size_t RC_Y = WS_RC;

constexpr int CW_BAR = 4096;

namespace pg8 {
__device__ __forceinline__ void rope8(f32x4& v0, f32x4& v1, const f32x2* csp) {
    const f32x4 c01 = *(const f32x4*)csp, c23 = *(const f32x4*)(csp + 2);
    const f32x4 a = v0, b = v1;
    v0[0] = a[0] * c01[0] - a[1] * c01[1]; v0[1] = a[1] * c01[0] + a[0] * c01[1];
    v0[2] = a[2] * c01[2] - a[3] * c01[3]; v0[3] = a[3] * c01[2] + a[2] * c01[3];
    v1[0] = b[0] * c23[0] - b[1] * c23[1]; v1[1] = b[1] * c23[0] + b[0] * c23[1];
    v1[2] = b[2] * c23[2] - b[3] * c23[3]; v1[3] = b[3] * c23[2] + b[2] * c23[3];
}
__device__ __forceinline__ float sigm(float v) { return __builtin_amdgcn_rcpf(1.0f + __builtin_amdgcn_exp2f(-v * LOG2E)); }
__device__ __forceinline__ float sq8(u32x4 w) { const float a = bflo(w.x), b = bfhi(w.x), c = bflo(w.y), d = bfhi(w.y), e = bflo(w.z), f = bfhi(w.z), g = bflo(w.w), h = bfhi(w.w);
    return ((a * a + b * b) + (c * c + d * d)) + ((e * e + f * f) + (g * g + h * h)); }

struct EpiProj {
    static constexpr bool PERM = true, AFTER_DRAIN = false, MIDK = false;
    bf16_t *Qd, *Kd, *Vd, *cq, *ckv, *kpe, *gates; float *ssq_cq, *ssq_ckv; const float* bgate; const f32x2* cs; const float* rsx;
    __device__ __forceinline__ void operator()(const Acc& acc, const Unit& u, int wr, int wc, int fr, int fq) const {
        const int pn = u.pn, row0 = u.pm * BM + wr * 64 + fr, cb = wc * 32 + 8 * fq;
        float rs[2][4];
#pragma unroll
        for (int ai = 0; ai < 2; ++ai)
#pragma unroll
            for (int m = 0; m < 4; ++m) rs[ai][m] = rsx[row0 + ai * HALF + m * 16];
        if (pn >= 16) {
            const int colt = (pn - 16) * 256 + cb;
            f32x4 bv[2][2];
#pragma unroll
            for (int bj = 0; bj < 2; ++bj)
#pragma unroll
                for (int n = 0; n < 2; ++n) bv[bj][n] = *(const f32x4*)(bgate + colt + bj * HALF + 4 * n) * -LOG2E;
#pragma unroll
            for (int ai = 0; ai < 2; ++ai)
#pragma unroll
                for (int m = 0; m < 4; ++m) { bf16_t* rowp = gates + (size_t)(row0 + ai * HALF + m * 16) * 4096 + colt;
#pragma unroll
                    for (int bj = 0; bj < 2; ++bj) { const float rl = rs[ai][m] * -LOG2E; f32x4 v0 = acc[ai][bj][m][0] * rl + bv[bj][0], v1 = acc[ai][bj][m][1] * rl + bv[bj][1];
#pragma unroll
                        for (int e = 0; e < 4; ++e) { v0[e] = __builtin_amdgcn_rcpf(1.0f + __builtin_amdgcn_exp2f(v0[e])); v1[e] = __builtin_amdgcn_rcpf(1.0f + __builtin_amdgcn_exp2f(v1[e])); }
                        st16bj(rowp, bj, pack8(v0, v1)); } }
        } else if (pn >= 8 && pn < 15) {
            bf16_t* base; int ld, colt; float* ssq = nullptr; int ssld = 0, sslot = 0;
            if (pn < 12) { base = Vd; ld = 1024; colt = (pn - 8) * 256; }
            else if (pn < 14) { base = cq; ld = 512; colt = (pn - 12) * 256; ssq = ssq_cq; ssld = 8; sslot = (pn - 12) * 4 + wc; }
            else { base = ckv; ld = 256; colt = 0; ssq = ssq_ckv; ssld = 4; sslot = wc; }
            colt += cb;
#pragma unroll
            for (int ai = 0; ai < 2; ++ai)
#pragma unroll
                for (int m = 0; m < 4; ++m) { const int row = row0 + ai * HALF + m * 16; bf16_t* rowp = base + (size_t)row * ld + colt; float ss = 0.f;
#pragma unroll
                    for (int bj = 0; bj < 2; ++bj) { const u32x4 w = pack8(acc[ai][bj][m][0] * rs[ai][m], acc[ai][bj][m][1] * rs[ai][m]); st16bj(rowp, bj, w); ss += sq8(w); }
                    if (ssq) { ss += xor_lt32<16>(ss); ss = sum_xor32(ss); if (fq == 0) ssq[(size_t)row * ssld + sslot] = ss; } }
        } else {
            bf16_t* base; int ld, colt;
            if (pn < 4) { base = Qd; ld = 1024; colt = pn * 256; } else if (pn < 8) { base = Kd; ld = 1024; colt = (pn - 4) * 256; } else { base = kpe; ld = 64; colt = 0; }
            colt += cb;
#pragma unroll
            for (int ai = 0; ai < 2; ++ai)
#pragma unroll
                for (int m = 0; m < 4; ++m) { const int row = row0 + ai * HALF + m * 16; bf16_t* rowp = base + (size_t)row * ld + colt; const f32x2* csr = cs + (size_t)row * 32;
#pragma unroll
                    for (int bj = 0; bj < 2; ++bj) { const int col = colt + bj * HALF;
                        if (pn == 15 && col >= 64) continue;
                        f32x4 v0 = acc[ai][bj][m][0] * rs[ai][m], v1 = acc[ai][bj][m][1] * rs[ai][m]; rope8(v0, v1, csr + ((col & 63) >> 1));
                        st16bj(rowp, bj, pack8(v0, v1)); } }
        }
    }
};
struct EpiQm {
    static constexpr bool PERM = true, AFTER_DRAIN = false, MIDK = false;
    bf16_t* Qm; const float* ssq; const f32x2* cs;
    __device__ __forceinline__ void operator()(const Acc& acc, const Unit& u, int wr, int wc, int fr, int fq) const {
        const int row0 = u.pm * BM + wr * 64 + fr, colt = u.pn * BM + wc * 32 + 8 * fq;
#pragma unroll
        for (int ai = 0; ai < 2; ++ai)
#pragma unroll
            for (int m = 0; m < 4; ++m) { const int row = row0 + ai * HALF + m * 16;
                const f32x4 s0 = *(const f32x4*)(ssq + (size_t)row * 8), s1 = *(const f32x4*)(ssq + (size_t)row * 8 + 4);
                const float rs = __builtin_amdgcn_rsqf((((s0[0] + s0[1]) + (s0[2] + s0[3])) + ((s1[0] + s1[1]) + (s1[2] + s1[3]))) * (1.0f / 512.0f) + EPS);
                bf16_t* rowp = Qm + (size_t)row * 1536 + colt; const f32x2* csr = cs + (size_t)row * 32;
#pragma unroll
                for (int bj = 0; bj < 2; ++bj) { const int col = colt + bj * HALF, r = col % 192;
                    f32x4 v0 = acc[ai][bj][m][0] * rs, v1 = acc[ai][bj][m][1] * rs;
                    if (r >= 128) rope8(v0, v1, csr + ((r - 128) >> 1));
                    st16bj(rowp, bj, pack8(v0, v1)); } }
    }
};
struct EpiKv {
    static constexpr bool PERM = true, AFTER_DRAIN = false, MIDK = false;
    bf16_t *Kn, *Vm; const float* ssq;
    __device__ __forceinline__ void operator()(const Acc& acc, const Unit& u, int wr, int wc, int fr, int fq) const {
        const int row0 = u.pm * BM + wr * 64 + fr; int colt = u.pn * BM; bf16_t* base = Kn; if (colt >= 1024) { base = Vm; colt -= 1024; } colt += wc * 32 + 8 * fq;
#pragma unroll
        for (int ai = 0; ai < 2; ++ai)
#pragma unroll
            for (int m = 0; m < 4; ++m) { const int row = row0 + ai * HALF + m * 16; const f32x4 s = *(const f32x4*)(ssq + (size_t)row * 4);
                const float rs = __builtin_amdgcn_rsqf(((s[0] + s[1]) + (s[2] + s[3])) * (1.0f / 256.0f) + EPS); bf16_t* rowp = base + (size_t)row * 1024 + colt;
#pragma unroll
                for (int bj = 0; bj < 2; ++bj) st16bj(rowp, bj, pack8(acc[ai][bj][m][0] * rs, acc[ai][bj][m][1] * rs)); }
    }
};
template <int MODE> struct EpiGate {
    static constexpr bool PERM = true, AFTER_DRAIN = false, MIDK = false;
    const bf16_t* gates; float* t; bf16_t* merged;
    __device__ __forceinline__ void operator()(const Acc& acc, const Unit& u, int wr, int wc, int fr, int fq) const {
        const int row0 = u.pm * BM + wr * 64 + fr, colt = u.pn * BM + wc * 32 + 8 * fq;
#pragma unroll
        for (int ai = 0; ai < 2; ++ai)
#pragma unroll
            for (int m = 0; m < 4; ++m) { const size_t row = (size_t)(row0 + ai * HALF + m * 16);
#pragma unroll
                for (int bj = 0; bj < 2; ++bj) { const int col = colt + bj * HALF;
                    const u32x4 gw = *(const u32x4*)(gates + row * 4096 + MODE * 2048 + col);
                    const f32x4 g0 = (f32x4){bflo(gw.x), bfhi(gw.x), bflo(gw.y), bfhi(gw.y)}, g1 = (f32x4){bflo(gw.z), bfhi(gw.z), bflo(gw.w), bfhi(gw.w)};
                    float* tp = t + row * 2048 + col;
                    if (MODE == 0) { const f32x4 s0 = acc[ai][bj][m][0] * g0, s1 = acc[ai][bj][m][1] * g1; unsigned long long* tq = (unsigned long long*)tp;
                        __hip_atomic_store(tq, ((unsigned long long)__float_as_uint(s0[1]) << 32) | __float_as_uint(s0[0]), __ATOMIC_RELAXED, __HIP_MEMORY_SCOPE_AGENT);
                        __hip_atomic_store(tq + 1, ((unsigned long long)__float_as_uint(s0[3]) << 32) | __float_as_uint(s0[2]), __ATOMIC_RELAXED, __HIP_MEMORY_SCOPE_AGENT);
                        __hip_atomic_store(tq + 2, ((unsigned long long)__float_as_uint(s1[1]) << 32) | __float_as_uint(s1[0]), __ATOMIC_RELAXED, __HIP_MEMORY_SCOPE_AGENT);
                        __hip_atomic_store(tq + 3, ((unsigned long long)__float_as_uint(s1[3]) << 32) | __float_as_uint(s1[2]), __ATOMIC_RELAXED, __HIP_MEMORY_SCOPE_AGENT); }
                    else { f32x4 t0, t1;
                        { const unsigned long long* tq = (const unsigned long long*)tp;
                          const unsigned long long w0 = __hip_atomic_load(tq, __ATOMIC_RELAXED, __HIP_MEMORY_SCOPE_AGENT), w1 = __hip_atomic_load(tq + 1, __ATOMIC_RELAXED, __HIP_MEMORY_SCOPE_AGENT),
                                                   w2 = __hip_atomic_load(tq + 2, __ATOMIC_RELAXED, __HIP_MEMORY_SCOPE_AGENT), w3 = __hip_atomic_load(tq + 3, __ATOMIC_RELAXED, __HIP_MEMORY_SCOPE_AGENT);
                          t0 = (f32x4){__uint_as_float((unsigned)w0), __uint_as_float((unsigned)(w0 >> 32)), __uint_as_float((unsigned)w1), __uint_as_float((unsigned)(w1 >> 32))};
                          t1 = (f32x4){__uint_as_float((unsigned)w2), __uint_as_float((unsigned)(w2 >> 32)), __uint_as_float((unsigned)w3), __uint_as_float((unsigned)(w3 >> 32))}; }
                        const f32x4 a0 = t0 + acc[ai][bj][m][0] * g0, a1 = t1 + acc[ai][bj][m][1] * g1;
                        *(u32x4*)(merged + row * 2048 + col) = pack8(a0, a1); } } }
    }
};
template <int CTRL> __device__ __forceinline__ float dppk(float old, float src) { return __builtin_bit_cast(float, __builtin_amdgcn_update_dpp(__builtin_bit_cast(int, old), __builtin_bit_cast(int, src), CTRL, 0xf, 0xf, false)); }
#define CT_ONE(c, x, p, w1, w0) \
    "v_fmac_f32_dpp " c ", " x ", " w1 " row_shr:1 row_mask:0xf bank_mask:0xf bound_ctrl:0\n\t" \
    "v_fmac_f32_dpp " c ", " x ", " w0 " row_shr:2 row_mask:0xf bank_mask:0xf bound_ctrl:0\n\t" \
    "v_fmac_f32_dpp " c ", " p ", " w1 " row_shl:15 row_mask:0xf bank_mask:0xf bound_ctrl:0\n\t" \
    "v_fmac_f32_dpp " c ", " p ", " w0 " row_shl:14 row_mask:0xf bank_mask:0xf bound_ctrl:0\n\t"
__device__ __forceinline__ void conv_taps(f32x4& c, const f32x4& x, const f32x4& p, const f32x4& w1, const f32x4& w0) {
    float c0 = c[0], c1 = c[1], c2 = c[2], c3 = c[3];
    asm("s_nop 1\n\t"
        CT_ONE("%0", "%4", "%8", "%12", "%16") CT_ONE("%1", "%5", "%9", "%13", "%17") CT_ONE("%2", "%6", "%10", "%14", "%18") CT_ONE("%3", "%7", "%11", "%15", "%19")
        : "+v"(c0), "+v"(c1), "+v"(c2), "+v"(c3)
        : "v"(x[0]), "v"(x[1]), "v"(x[2]), "v"(x[3]), "v"(p[0]), "v"(p[1]), "v"(p[2]), "v"(p[3]), "v"(w1[0]), "v"(w1[1]), "v"(w1[2]), "v"(w1[3]), "v"(w0[0]), "v"(w0[1]), "v"(w0[2]), "v"(w0[3]));
    c = (f32x4){c0, c1, c2, c3};
}
#ifndef CONV_V1
#define CT2_ONE(c1, c0, x3, x2, w1, w0) \
    "v_fmac_f32_dpp " c1 ", " x3 ", " w0 " row_shr:1 row_mask:0xf bank_mask:0xf bound_ctrl:0\n\t" \
    "v_fmac_f32_dpp " c0 ", " x3 ", " w1 " row_shr:1 row_mask:0xf bank_mask:0xf bound_ctrl:0\n\t" \
    "v_fmac_f32_dpp " c0 ", " x2 ", " w0 " row_shr:1 row_mask:0xf bank_mask:0xf bound_ctrl:0\n\t"
__device__ __forceinline__ void conv_taps2(f32x4& c1, f32x4& c0, const f32x4& x3, const f32x4& x2, const f32x4& w1, const f32x4& w0) {
    float a0 = c1[0], a1 = c1[1], a2 = c1[2], a3 = c1[3], b0 = c0[0], b1 = c0[1], b2 = c0[2], b3 = c0[3];
    asm("s_nop 1\n\t"
        CT2_ONE("%0", "%4", "%8", "%12", "%16", "%20") CT2_ONE("%1", "%5", "%9", "%13", "%17", "%21") CT2_ONE("%2", "%6", "%10", "%14", "%18", "%22") CT2_ONE("%3", "%7", "%11", "%15", "%19", "%23")
        : "+v"(a0), "+v"(a1), "+v"(a2), "+v"(a3), "+v"(b0), "+v"(b1), "+v"(b2), "+v"(b3)
        : "v"(x3[0]), "v"(x3[1]), "v"(x3[2]), "v"(x3[3]), "v"(x2[0]), "v"(x2[1]), "v"(x2[2]), "v"(x2[3]),
          "v"(w1[0]), "v"(w1[1]), "v"(w1[2]), "v"(w1[3]), "v"(w0[0]), "v"(w0[1]), "v"(w0[2]), "v"(w0[3]));
    c1 = (f32x4){a0, a1, a2, a3}; c0 = (f32x4){b0, b1, b2, b3};
}
struct EpiConvGlu {
    static constexpr bool PERM = true, AFTER_DRAIN = false, MIDK = false;
    bf16_t* act; float* U4; const float* cw; const float* cb; LAS unsigned char* xl; const float* rsx;
    __device__ __forceinline__ void operator()(const Acc& acc0, const Unit& u, int wr, int wc, int fr, int fq) const {
        const int wid = wr * 4 + wc, cu = u.pn * BM + wc * 32 + 8 * fq;
        f32x4 acc[2][2][4][2];
#pragma unroll
        for (int ai = 0; ai < 2; ++ai) { const f32x4 rs = *(const f32x4*)(rsx + u.pm * BM + ai * HALF + wr * 64 + 4 * fr);
#pragma unroll
            for (int m = 0; m < 4; ++m)
#pragma unroll
                for (int bj = 0; bj < 2; ++bj)
#pragma unroll
                    for (int n = 0; n < 2; ++n) acc[ai][bj][m][n] = acc0[ai][bj][m][n] * rs[m]; }
        if (fr == 15) {
#pragma unroll
            for (int ai = 0; ai < 2; ++ai)
#pragma unroll
                for (int rs = 0; rs < 2; ++rs)
#pragma unroll
                    for (int bj = 0; bj < 2; ++bj)
#pragma unroll
                        for (int n = 0; n < 2; ++n) *(LAS f32x4*)(xl + ((((wid * 2 + ai) * 2 + rs) * 64 + bj * 32 + fq * 8 + n * 4) * 4)) = acc[ai][bj][2 + rs][n];
        }
        if (wr == 0 && fr == 0) {
#pragma unroll
            for (int k = 0; k < 2; ++k)
#pragma unroll
                for (int bj = 0; bj < 2; ++bj)
#pragma unroll
                    for (int n = 0; n < 2; ++n) *(f32x4*)(U4 + ((size_t)(u.pm * 4 + k) * NUP + cu + bj * HALF + n * 4)) = acc[0][bj][k][n];
        }
        if (wr == 1 && fr == 15) {
#pragma unroll
            for (int k = 0; k < 2; ++k)
#pragma unroll
                for (int bj = 0; bj < 2; ++bj)
#pragma unroll
                    for (int n = 0; n < 2; ++n) *(f32x4*)(U4 + ((size_t)(u.pm * 4 + 2 + k) * NUP + cu + bj * HALF + n * 4)) = acc[1][bj][2 + k][n];
        }
        asm volatile("s_waitcnt lgkmcnt(0)" ::: "memory"); __builtin_amdgcn_s_barrier(); asm volatile("" ::: "memory");
#pragma unroll
        for (int bj = 0; bj < 2; ++bj) {
            const int gidx = (cu + bj * HALF) >> 3;
            f32x4 wa[3], wg[3];
#pragma unroll
            for (int j = 0; j < 3; ++j) { wa[j] = *(const f32x4*)(cw + (size_t)j * NUP + 4 * gidx); wg[j] = *(const f32x4*)(cw + (size_t)j * NUP + DFF + 4 * gidx); }
            const f32x4 ba = *(const f32x4*)(cb + 4 * gidx), bg = *(const f32x4*)(cb + DFF + 4 * gidx);
#pragma unroll
            for (int ai = 0; ai < 2; ++ai) {
                const f32x4 z = (f32x4){0.f, 0.f, 0.f, 0.f};
                f32x4 pa2 = z, pa3 = z, pg2 = z, pg3 = z;
                if ((wr == 1 || ai == 1) && fr == 0) { const int pw = wr == 1 ? wid - 4 : wid + 4, pai = wr == 1 ? ai : 0;
                    const LAS unsigned char* hp = xl + ((((pw * 2 + pai) * 2) * 64 + bj * 32 + fq * 8) * 4);
                    pa2 = *(const LAS f32x4*)hp; pg2 = *(const LAS f32x4*)(hp + 16); pa3 = *(const LAS f32x4*)(hp + 256); pg3 = *(const LAS f32x4*)(hp + 256 + 16); }
                const f32x4 x0 = acc[ai][bj][0][0], x1 = acc[ai][bj][1][0], x2 = acc[ai][bj][2][0], x3 = acc[ai][bj][3][0];
                const f32x4 g0 = acc[ai][bj][0][1], g1 = acc[ai][bj][1][1], g2 = acc[ai][bj][2][1], g3 = acc[ai][bj][3][1];
                f32x4 ca[4], cg[4];
                ca[3] = x3 * wa[2] + x2 * wa[1] + x1 * wa[0] + ba;           cg[3] = g3 * wg[2] + g2 * wg[1] + g1 * wg[0] + bg;
                ca[2] = x2 * wa[2] + x1 * wa[1] + x0 * wa[0] + ba;           cg[2] = g2 * wg[2] + g1 * wg[1] + g0 * wg[0] + bg;
                ca[1] = x1 * wa[2] + x0 * wa[1] + pa3 * wa[0] + ba;          cg[1] = g1 * wg[2] + g0 * wg[1] + pg3 * wg[0] + bg;
                ca[0] = x0 * wa[2] + pa3 * wa[1] + pa2 * wa[0] + ba;         cg[0] = g0 * wg[2] + pg3 * wg[1] + pg2 * wg[0] + bg;
                conv_taps2(ca[1], ca[0], x3, x2, wa[1], wa[0]); conv_taps2(cg[1], cg[0], g3, g2, wg[1], wg[0]);
                bf16_t* ap = act + (size_t)(u.pm * BM + ai * HALF + wr * 64 + 4 * fr) * DFF + 4 * gidx;
#pragma unroll
                for (int m = 0; m < 4; ++m) { f32x4 o;
#pragma unroll
                    for (int e = 0; e < 4; ++e) o[e] = ca[m][e] * __builtin_amdgcn_rcpf(1.0f + __builtin_amdgcn_exp2f(-ca[m][e] * LOG2E)) * cg[m][e];
                    u32x2 w; w.x = cvt_pk_bf16(o[0], o[1]); w.y = cvt_pk_bf16(o[2], o[3]);
                    *(u32x2*)(ap + (size_t)m * DFF) = w; }
            }
        }
    }
};
template <> struct RowPerm<EpiConvGlu> { static constexpr bool v = true; };
#else
struct EpiConvGlu {
    static constexpr bool PERM = true, AFTER_DRAIN = false, MIDK = false;
    bf16_t* act; float* U4; const float* cw; const float* cb; LAS unsigned char* xl;
    __device__ __forceinline__ void operator()(const Acc& acc, const Unit& u, int wr, int wc, int fr, int fq) const {
        const int wid = wr * 4 + wc, cu = u.pn * BM + wc * 32 + 8 * fq;
        if (fr >= 14) {
#pragma unroll
            for (int ai = 0; ai < 2; ++ai)
#pragma unroll
                for (int bj = 0; bj < 2; ++bj)
#pragma unroll
                    for (int n = 0; n < 2; ++n) *(LAS f32x4*)(xl + ((((wid * 2 + ai) * 2 + (fr - 14)) * 64 + bj * 32 + fq * 8 + n * 4) * 4)) = acc[ai][bj][3][n];
        }
        if (wr == 0 && fr < 2) {
#pragma unroll
            for (int bj = 0; bj < 2; ++bj)
#pragma unroll
                for (int n = 0; n < 2; ++n) *(f32x4*)(U4 + ((size_t)(u.pm * 4 + fr) * NUP + cu + bj * HALF + n * 4)) = acc[0][bj][0][n];
        }
        if (wr == 1 && fr >= 14) {
#pragma unroll
            for (int bj = 0; bj < 2; ++bj)
#pragma unroll
                for (int n = 0; n < 2; ++n) *(f32x4*)(U4 + ((size_t)(u.pm * 4 + 2 + (fr - 14)) * NUP + cu + bj * HALF + n * 4)) = acc[1][bj][3][n];
        }
        asm volatile("s_waitcnt lgkmcnt(0)" ::: "memory"); __builtin_amdgcn_s_barrier(); asm volatile("" ::: "memory");
#pragma unroll
        for (int bj = 0; bj < 2; ++bj) {
            const int gidx = (cu + bj * HALF) >> 3;
            f32x4 wa[3], wg[3];
#pragma unroll
            for (int j = 0; j < 3; ++j) { wa[j] = *(const f32x4*)(cw + (size_t)j * NUP + 4 * gidx); wg[j] = *(const f32x4*)(cw + (size_t)j * NUP + DFF + 4 * gidx); }
            const f32x4 ba = *(const f32x4*)(cb + 4 * gidx), bg = *(const f32x4*)(cb + DFF + 4 * gidx);
#pragma unroll
            for (int ai = 0; ai < 2; ++ai) {
                f32x4 pa = (f32x4){0.f, 0.f, 0.f, 0.f}, pg = pa;
                if (wr == 1 || ai == 1) { const int pw = wr == 1 ? wid - 4 : wid + 4, pai = wr == 1 ? ai : 0;
                    const LAS unsigned char* hp = xl + ((((pw * 2 + pai) * 2 + (fr & 1)) * 64 + bj * 32 + fq * 8) * 4);
                    pa = *(const LAS f32x4*)hp; pg = *(const LAS f32x4*)(hp + 16); }
                bf16_t* ap = act + (size_t)(u.pm * BM + ai * HALF + wr * 64 + fr) * DFF + 4 * gidx;
#pragma unroll
                for (int m = 0; m < 4; ++m) {
                    const f32x4 a0 = acc[ai][bj][m][0], g0 = acc[ai][bj][m][1];
                    f32x4 ca = a0 * wa[2] + ba, cg = g0 * wg[2] + bg; f32x4 o;
                    conv_taps(ca, a0, pa, wa[1], wa[0]); conv_taps(cg, g0, pg, wg[1], wg[0]);
#pragma unroll
                    for (int e = 0; e < 4; ++e) o[e] = ca[e] * __builtin_amdgcn_rcpf(1.0f + __builtin_amdgcn_exp2f(-ca[e] * LOG2E)) * cg[e];
                    u32x2 w; w.x = cvt_pk_bf16(o[0], o[1]); w.y = cvt_pk_bf16(o[2], o[3]);
                    *(u32x2*)(ap + (size_t)(m * 16) * DFF) = w;
                    pa = a0; pg = g0;
                }
            }
        }
    }
};
#endif
struct EpiSoftmax {
    static constexpr bool PERM = true, AFTER_DRAIN = true, MIDK = false;
    bf16_t* P; const float* rsx;
    __device__ __forceinline__ void fused(Acc& acc, const Unit& u, int wr, int wc, int fr, int fq, LAS unsigned char* lds, int wid, int lane) const {
        const float C = 0.044194173824159216f * LOG2E;
#pragma unroll
        for (int ai = 0; ai < 2; ++ai)
#pragma unroll
            for (int m = 0; m < 4; ++m) { const float rs = rsx[u.pm * BM + ai * HALF + wr * 64 + m * 16 + fr];
#pragma unroll
                for (int bj = 0; bj < 2; ++bj)
#pragma unroll
                    for (int n = 0; n < 2; ++n) acc[ai][bj][m][n] = acc[ai][bj][m][n] * rs; }
        LAS f32x2* T = (LAS f32x2*)lds;
#pragma unroll
        for (int ai = 0; ai < 2; ++ai)
#pragma unroll
            for (int m = 0; m < 4; ++m) {
                float mx = -3.0e38f;
#pragma unroll
                for (int bj = 0; bj < 2; ++bj)
#pragma unroll
                    for (int n = 0; n < 2; ++n) { const f32x4 x = acc[ai][bj][m][n]; mx = fmaxf(mx, fmaxf(fmaxf(x[0], x[1]), fmaxf(x[2], x[3]))); }
                mx = fmaxf(mx, xor_lt32<16>(mx)); mx = max_xor32(mx);
                float s = 0.f;
#pragma unroll
                for (int bj = 0; bj < 2; ++bj)
#pragma unroll
                    for (int n = 0; n < 2; ++n) { const f32x4 x = acc[ai][bj][m][n];
#pragma unroll
                        for (int e = 0; e < 4; ++e) s += __builtin_amdgcn_exp2f((x[e] - mx) * C); }
                s += xor_lt32<16>(s); s = sum_xor32(s);
                if (fq == 0) T[(ai * HALF + wr * 64 + m * 16 + fr) * 4 + wc] = (f32x2){mx, s};
            }
        asm volatile("s_waitcnt lgkmcnt(0)" ::: "memory"); __builtin_amdgcn_s_barrier(); asm volatile("" ::: "memory");
        const int row0 = u.pm * BM + wr * 64 + fr, col0 = u.pn * BM + wc * 32 + 8 * fq;
#pragma unroll
        for (int ai = 0; ai < 2; ++ai)
#pragma unroll
            for (int m = 0; m < 4; ++m) { const int rl = ai * HALF + wr * 64 + m * 16 + fr;
                const f32x2 t0 = T[rl * 4 + 0], t1 = T[rl * 4 + 1], t2 = T[rl * 4 + 2], t3 = T[rl * 4 + 3];
                const float M = fmaxf(fmaxf(t0.x, t1.x), fmaxf(t2.x, t3.x));
                const float S = (t0.y * __builtin_amdgcn_exp2f((t0.x - M) * C) + t1.y * __builtin_amdgcn_exp2f((t1.x - M) * C)) + (t2.y * __builtin_amdgcn_exp2f((t2.x - M) * C) + t3.y * __builtin_amdgcn_exp2f((t3.x - M) * C));
                const float inv = __builtin_amdgcn_rcpf(S), MC = -M * C;
                bf16_t* rowp = P + (size_t)(row0 + ai * HALF + m * 16) * 1024 + col0;
#pragma unroll
                for (int bj = 0; bj < 2; ++bj) { f32x4 v0 = acc[ai][bj][m][0], v1 = acc[ai][bj][m][1];
#pragma unroll
                    for (int e = 0; e < 4; ++e) { v0[e] = __builtin_amdgcn_exp2f(fmaf(v0[e], C, MC)) * inv; v1[e] = __builtin_amdgcn_exp2f(fmaf(v1[e], C, MC)) * inv; }
                    st16bj(rowp, bj, pack8(v0, v1)); } }
        (void)wid; (void)lane;
    }
};
struct EpiGate2 {
    static constexpr bool PERM = true, AFTER_DRAIN = false, MIDK = true;
    const bf16_t* gates; bf16_t* merged;
    __device__ __forceinline__ void operator()(Acc& acc, const Unit& u, int wr, int wc, int fr, int fq) const {
        if (u.z == 0) {
        const int row0 = u.pm * BM + wr * 64 + fr, colt = u.pn * BM + wc * 32 + 8 * fq;
#pragma unroll
        for (int ai = 0; ai < 2; ++ai)
#pragma unroll
            for (int m = 0; m < 4; ++m) { const bf16_t* gp = gates + (size_t)(row0 + ai * HALF + m * 16) * 4096 + colt;
#pragma unroll
                for (int bj = 0; bj < 2; ++bj) { const u32x4 ga = *(const u32x4*)(gp + bj * HALF), gb = *(const u32x4*)(gp + 2048 + bj * HALF);
                    const f32x4 a0 = (f32x4){bflo(ga.x), bfhi(ga.x), bflo(ga.y), bfhi(ga.y)}, a1 = (f32x4){bflo(ga.z), bfhi(ga.z), bflo(ga.w), bfhi(ga.w)};
                    const f32x4 b0 = (f32x4){bflo(gb.x), bfhi(gb.x), bflo(gb.y), bfhi(gb.y)}, b1 = (f32x4){bflo(gb.z), bfhi(gb.z), bflo(gb.w), bfhi(gb.w)};
#pragma unroll
                    for (int e = 0; e < 4; ++e) { acc[ai][bj][m][0][e] *= a0[e] * __builtin_amdgcn_rcpf(fmaxf(b0[e], 1e-30f)); acc[ai][bj][m][1][e] *= a1[e] * __builtin_amdgcn_rcpf(fmaxf(b1[e], 1e-30f)); }
                    asm volatile("" : "+v"(acc[ai][bj][m][0]), "+v"(acc[ai][bj][m][1]) :: "memory"); } }
                return; }
        const int row0 = u.pm * BM + wr * 64 + fr, colt = u.pn * BM + wc * 32 + 8 * fq;
#pragma unroll
        for (int ai = 0; ai < 2; ++ai)
#pragma unroll
            for (int m = 0; m < 4; ++m) { const size_t row = (size_t)(row0 + ai * HALF + m * 16);
#pragma unroll
                for (int bj = 0; bj < 2; ++bj) { const int col = colt + bj * HALF; const u32x4 gb = *(const u32x4*)(gates + row * 4096 + 2048 + col);
                    f32x4 b0 = (f32x4){bflo(gb.x), bfhi(gb.x), bflo(gb.y), bfhi(gb.y)}, b1 = (f32x4){bflo(gb.z), bfhi(gb.z), bflo(gb.w), bfhi(gb.w)};
#pragma unroll
                    for (int e = 0; e < 4; ++e) { b0[e] = fmaxf(b0[e], 1e-30f); b1[e] = fmaxf(b1[e], 1e-30f); }
                    st16bj(merged + row * 2048 + colt, bj, pack8(acc[ai][bj][m][0] * b0, acc[ai][bj][m][1] * b1)); } }
    }
};
struct EpiF32 {
    static constexpr bool PERM = false, AFTER_DRAIN = false, MIDK = false;
    float* C; int ldc;
    __device__ __forceinline__ void operator()(const Acc& acc, const Unit& u, int wr, int wc, int fr, int fq) const {
        const int row0 = u.pm * BM + wr * 64 + fr, col0 = u.pn * BM + wc * 32 + 4 * fq;
#pragma unroll
        for (int ai = 0; ai < 2; ++ai)
#pragma unroll
            for (int m = 0; m < 4; ++m) { float* rowp = C + (size_t)(row0 + ai * HALF + m * 16) * ldc + col0;
#pragma unroll
                for (int bj = 0; bj < 2; ++bj)
#pragma unroll
                    for (int n = 0; n < 2; ++n) *(f32x4*)(rowp + bj * HALF + n * 16) = acc[ai][bj][m][n]; }
    }
};
struct EpiBf16 {
    static constexpr bool PERM = true, AFTER_DRAIN = false, MIDK = false;
    bf16_t* O; int ldc;
    __device__ __forceinline__ void operator()(const Acc& acc, const Unit& u, int wr, int wc, int fr, int fq) const {
        const int row0 = u.pm * BM + wr * 64 + fr, col0 = u.pn * BM + wc * 32 + 8 * fq;
#pragma unroll
        for (int ai = 0; ai < 2; ++ai)
#pragma unroll
            for (int m = 0; m < 4; ++m) { bf16_t* rowp = O + (size_t)(row0 + ai * HALF + m * 16) * ldc + col0;
#pragma unroll
                for (int bj = 0; bj < 2; ++bj) st16bj(rowp, bj, pack8(acc[ai][bj][m][0], acc[ai][bj][m][1])); }
    }
};
struct EpiMemKv {
    static constexpr bool PERM = true, AFTER_DRAIN = false, MIDK = false;
    bf16_t* Kmem;
    __device__ __forceinline__ void operator()(const Acc& acc, const Unit& u, int wr, int wc, int fr, int fq) const {
        bf16_t* O = Kmem + (size_t)(u.z & 1) * ((RA_VMEM - RA_KMEM) / 2) + (size_t)(u.z >> 1) * (1024 * 2048);
        const int row0 = u.pm * BM + wr * 64 + fr, col0 = u.pn * BM + wc * 32 + 8 * fq;
#pragma unroll
        for (int ai = 0; ai < 2; ++ai)
#pragma unroll
            for (int m = 0; m < 4; ++m) { bf16_t* rowp = O + (size_t)(row0 + ai * HALF + m * 16) * 2048 + col0;
#pragma unroll
                for (int bj = 0; bj < 2; ++bj) st16bj(rowp, bj, pack8(acc[ai][bj][m][0], acc[ai][bj][m][1])); }
    }
};
struct EpiFold {
    static constexpr bool PERM = true, AFTER_DRAIN = false, MIDK = false;
    bf16_t* Wall;
    __device__ __forceinline__ void operator()(const Acc& acc, const Unit& u, int wr, int wc, int fr, int fq) const {
        const int ty = u.z & 1, ldc = ty ? 1024 : 2048;
        bf16_t* O = Wall + (size_t)(u.z >> 1) * W_LAYER + WO_WK + (size_t)ty * ((WO_VW - WO_WK) + (size_t)(u.pn >> 2) * (2048 * 1024));
        const int row0 = u.pm * BM + wr * 64 + fr, col0 = (ty ? (u.pn & 3) : u.pn) * BM + wc * 32 + 8 * fq;
#pragma unroll
        for (int ai = 0; ai < 2; ++ai)
#pragma unroll
            for (int m = 0; m < 4; ++m) { bf16_t* rowp = O + (size_t)(row0 + ai * HALF + m * 16) * ldc + col0;
#pragma unroll
                for (int bj = 0; bj < 2; ++bj) st16bj(rowp, bj, pack8(acc[ai][bj][m][0], acc[ai][bj][m][1])); }
    }
};

struct GateOrder {
    StaticOrder S;
    __device__ __forceinline__ bool next(int i, Unit& u) const { if (!S.next(i >> 1, u)) return false; u.z = i & 1; u.aoff += (unsigned)(i & 1) * 1024u; u.boff += (unsigned)(i & 1) * 1024u; return true; }
    __device__ __forceinline__ void a_ready(const Unit&) const {}
    __device__ __forceinline__ void done(const Unit&) const {}
};
struct MemKvOrder {
    int G, c;
    __device__ __forceinline__ bool next(int i, Unit& u) const {
        const int L = i * G + c; if (L >= 256) return false;
        const int ly = L >> 6, r = L & 63, ty = r >> 5, q = r & 31;
        u.pm = q >> 3; u.pn = q & 7; u.z = ly * 2 + ty;
        u.aoff = (unsigned)(RA_MEMN / 2) + (unsigned)ly * (1024u * 2048u) + (unsigned)u.pm * (256u * 2048u);
        u.boff = (unsigned)(RA_KVXT / 2) + (unsigned)ly * (4096u * 2048u) + (unsigned)(ty * 2048 + u.pn * 256) * 2048u; return true;
    }
    __device__ __forceinline__ void a_ready(const Unit&) const {}
    __device__ __forceinline__ void done(const Unit&) const {}
};
struct FoldOrder {
    int G, c;
    __device__ __forceinline__ bool next(int i, Unit& u) const {
        const int L = i * G + c; if (L >= 1024) return false;
        const int ly = L >> 8, r = L & 255, ty = r >> 7, q = r & 127; u.z = ly * 2 + ty;
        if (ty == 0) { u.pm = q >> 3; u.pn = q & 7; const unsigned b = (unsigned)u.pm >> 2, h = (unsigned)u.pm & 3u;
            u.aoff = (unsigned)(RA_KMEM / 2) + (unsigned)ly * (1024u * 2048u) + b * (256u * 2048u) + h * 512u;
            u.boff = (unsigned)(RA_QXP / 2) + (unsigned)ly * (2048u * 2048u) + (unsigned)u.pn * (256u * 2048u) + h * 512u; }
        else { u.pm = q >> 4; u.pn = q & 15; const unsigned b = (unsigned)u.pn >> 2, h = (unsigned)u.pn & 3u;
            u.aoff = (unsigned)(RA_OXT / 2) + (unsigned)ly * (2048u * 2048u) + (unsigned)u.pm * (256u * 2048u) + h * 512u;
            u.boff = (unsigned)(RA_VMEM / 2) + (unsigned)ly * (1024u * 2048u) + b * (256u * 2048u) + h * 512u; }
        return true;
    }
    __device__ __forceinline__ void a_ready(const Unit&) const {}
    __device__ __forceinline__ void done(const Unit&) const {}
};
struct CrossSOrder {
    int G, c;
    __device__ __forceinline__ bool next(int i, Unit& u) const {
        const int L = i * G + c; if (L >= 256) return false;
        const int w = (L & 7) * 32 + (L >> 3);
        u.pm = w >> 2; u.pn = w & 3; u.z = 0; const unsigned b = (unsigned)u.pm >> 4;
        u.aoff = (unsigned)u.pm * (256u * 2048u); u.boff = (b * 1024u + (unsigned)u.pn * 256u) * 2048u; return true;
    }
    __device__ __forceinline__ void a_ready(const Unit&) const {}
    __device__ __forceinline__ void done(const Unit&) const {}
};
struct CrossYOrder {
    int G, c;
    __device__ __forceinline__ bool next(int i, Unit& u) const {
        const int L = i * G + c; if (L >= 512) return false;
        const int w = (L & 7) * 64 + (L >> 3);
        u.pm = w >> 3; u.pn = w & 7; u.z = 0; const unsigned b = (unsigned)u.pm >> 4;
        u.aoff = (unsigned)u.pm * (256u * 1024u); u.boff = (b * 2048u + (unsigned)u.pn * 256u) * 1024u; return true;
    }
    __device__ __forceinline__ void a_ready(const Unit&) const {}
    __device__ __forceinline__ void done(const Unit&) const {}
};
}
namespace att {
constexpr int NW = 8, QBLK = 32, KVBLK = 64;
constexpr float THR = 8.f;
constexpr int SHM_V = KVBLK * 128 * 2;
constexpr int OFF_V = 0, OFF_K = 2 * SHM_V, OFF_QL = 81920  , OFF_WS = 122880;
#define SBAR() __builtin_amdgcn_sched_barrier(0)
__device__ __forceinline__ int crow(int r, int hi) { return (r & 3) + 8 * (r >> 2) + 4 * hi; }

__device__ __forceinline__ void partialSM(f32x16& p0, f32x16& p1, float& m_reg, float& alpha, const float C, const bool valid) {
    if (!valid) {
#pragma unroll
        for (int r = 0; r < 16; ++r) { p0[r] = 0.f; p1[r] = 0.f; }
        alpha = 1.f; return; }
    float pmax = p0[0];
#pragma unroll
    for (int r = 1; r < 16; ++r) pmax = fmaxf(pmax, p0[r]);
#pragma unroll
    for (int r = 0; r < 16; ++r) pmax = fmaxf(pmax, p1[r]);
    { auto rr = __builtin_amdgcn_permlane32_swap(__float_as_uint(pmax), __float_as_uint(pmax), false, false);
      pmax = fmaxf(__uint_as_float(rr[0]), __uint_as_float(rr[1])); }
    float mn;
    if (__builtin_expect(__all((pmax - m_reg) * C <= THR * LOG2E), 1)) { mn = m_reg; alpha = 1.f; }
    else { mn = fmaxf(m_reg, pmax); alpha = __builtin_amdgcn_exp2f((m_reg - mn) * C); m_reg = mn; }
    const float mnC = -mn * C;
#pragma unroll
    for (int r = 0; r < 16; ++r) p0[r] = fmaf(p0[r], C, mnC);
#pragma unroll
    for (int r = 0; r < 16; ++r) p1[r] = fmaf(p1[r], C, mnC);
#pragma unroll
    for (int r = 0; r < 16; ++r) p0[r] = __builtin_amdgcn_exp2f(p0[r]);
}
__device__ __forceinline__ void finishSM(f32x16& p0, f32x16& p1, float alpha, float& l_reg, bf16x8& pa0, bf16x8& pa1, bf16x8& pa2, bf16x8& pa3, const bool valid) {
    if (valid) {
#pragma unroll
        for (int r = 0; r < 16; ++r) p1[r] = __builtin_amdgcn_exp2f(p1[r]);
    }
    f32x2 ps2 = (f32x2){p0[0], p0[1]};
#pragma unroll
    for (int r = 1; r < 8; ++r) ps2 += (f32x2){p0[2 * r], p0[2 * r + 1]};
#pragma unroll
    for (int r = 0; r < 8; ++r) ps2 += (f32x2){p1[2 * r], p1[2 * r + 1]};
    float ps = ps2.x + ps2.y;
    { auto rr = __builtin_amdgcn_permlane32_swap(__float_as_uint(ps), __float_as_uint(ps), false, false);
      ps = __uint_as_float(rr[0]) + __uint_as_float(rr[1]); }
    l_reg = l_reg * alpha + ps;
#define PK4(P, BASE, OUT) do { unsigned a0 = cvt_pk_bf16(P[BASE + 0], P[BASE + 1]), a1 = cvt_pk_bf16(P[BASE + 2], P[BASE + 3]);   \
    unsigned b0 = cvt_pk_bf16(P[BASE + 4], P[BASE + 5]), b1 = cvt_pk_bf16(P[BASE + 6], P[BASE + 7]);                              \
    auto r0 = __builtin_amdgcn_permlane32_swap(a0, b0, false, false); auto r1 = __builtin_amdgcn_permlane32_swap(a1, b1, false, false); \
    u32x4 w = {r0[0], r1[0], r0[1], r1[1]}; OUT = __builtin_bit_cast(bf16x8, w); } while (0)
    PK4(p0, 0, pa0); PK4(p0, 8, pa1); PK4(p1, 0, pa2); PK4(p1, 8, pa3);
#undef PK4
}
template <int NQ, int NL>
__device__ __forceinline__ void qkt(f32x16& p0, f32x16& p1, const LAS unsigned char* Ks, const bf16x8* qr, const LAS unsigned char* ql, int r32, int hi) {
    constexpr int STRIDE = NQ * 32;
    const int sw = (r32 >> 1) & 7;
    const LAS unsigned char* k0p = Ks + r32 * STRIDE; const LAS unsigned char* k1p = k0p + 32 * STRIDE;
#pragma unroll
    for (int r = 0; r < 16; ++r) { p0[r] = 0.f; p1[r] = 0.f; }
#pragma unroll
    for (int d0 = 0; d0 < NQ; ++d0) { const int off = ((2 * d0 + hi) ^ sw) << 4;
        const bf16x8 b0 = *(const LAS bf16x8*)(k0p + off), b1 = *(const LAS bf16x8*)(k1p + off);
        bf16x8 qf; if (d0 < NQ - NL) qf = qr[d0]; else qf = *(const LAS bf16x8*)(ql + (d0 - (NQ - NL)) * 1024);
        p0 = __builtin_amdgcn_mfma_f32_32x32x16_bf16(b0, qf, p0, 0, 0, 0);
        p1 = __builtin_amdgcn_mfma_f32_32x32x16_bf16(b1, qf, p1, 0, 0, 0); }
}
__device__ __forceinline__ int v_st(int k, int c) { const int kk = (k & ~0xC) | ((k & 4) << 1) | ((k & 8) >> 1); return ((kk >> 3) * 4 + (c >> 5)) * 512 + ((kk & 7) * 32 + (c & 31)) * 2; }
__device__ __forceinline__ int v_rd_base(int lane) { return ((lane & 3) << 3) | (((lane >> 2) & 3) << 6) | (((lane >> 4) & 1) << 5) | (((lane >> 5) & 1) << 8); }
constexpr int v_rd_off(int d0, int ks, int half) { return d0 * 512 + ks * 4096 + half * 2048; }
template <int OFF> __device__ __forceinline__ s16x4 tr_read(int vb) {
    s16x4 r; asm volatile("ds_read_b64_tr_b16 %0, %1 offset:%2" : "=&v"(r) : "v"(vb), "i"(OFF) : "memory"); return r;
}
template <int D0> __device__ __forceinline__ void pv_one(f32x16& od, int vb, bf16x8 pa0, bf16x8 pa1, bf16x8 pa2, bf16x8 pa3) {
    const s16x4 l0 = tr_read<v_rd_off(D0, 0, 0)>(vb), h0 = tr_read<v_rd_off(D0, 0, 1)>(vb), l1 = tr_read<v_rd_off(D0, 1, 0)>(vb), h1 = tr_read<v_rd_off(D0, 1, 1)>(vb);
    const s16x4 l2 = tr_read<v_rd_off(D0, 2, 0)>(vb), h2 = tr_read<v_rd_off(D0, 2, 1)>(vb), l3 = tr_read<v_rd_off(D0, 3, 0)>(vb), h3 = tr_read<v_rd_off(D0, 3, 1)>(vb);
    asm volatile("s_waitcnt lgkmcnt(0)" ::: "memory"); SBAR();
#define PK(L, H) (bf16x8){L[0], L[1], L[2], L[3], H[0], H[1], H[2], H[3]}
    od = __builtin_amdgcn_mfma_f32_32x32x16_bf16(pa0, PK(l0, h0), od, 0, 0, 0);
    od = __builtin_amdgcn_mfma_f32_32x32x16_bf16(pa1, PK(l1, h1), od, 0, 0, 0);
    od = __builtin_amdgcn_mfma_f32_32x32x16_bf16(pa2, PK(l2, h2), od, 0, 0, 0);
    od = __builtin_amdgcn_mfma_f32_32x32x16_bf16(pa3, PK(l3, h3), od, 0, 0, 0);
#undef PK
}
__device__ __forceinline__ void pv_d0(f32x16* o, int vb, bf16x8 pa0, bf16x8 pa1, bf16x8 pa2, bf16x8 pa3) {
    pv_one<0>(o[0], vb, pa0, pa1, pa2, pa3); pv_one<1>(o[1], vb, pa0, pa1, pa2, pa3); pv_one<2>(o[2], vb, pa0, pa1, pa2, pa3); pv_one<3>(o[3], vb, pa0, pa1, pa2, pa3);
}

template <int NQ, bool MLA>
__device__ __forceinline__ void attn_pass(const bf16_t* __restrict__ Qb, const int ldq, const bf16_t* __restrict__ Kh, const bf16_t* __restrict__ Kpe, const bf16_t* __restrict__ Vh,
                                          const int NT, const float C, LAS unsigned char* lds, f32x16 (&o)[4]) {
    constexpr int STRIDE = NQ * 32, SHM_K = KVBLK * STRIDE;
    int tid = threadIdx.x; asm volatile("" : "+v"(tid));
    const int wid = __builtin_amdgcn_readfirstlane(tid >> 6), lane = tid & 63, r32 = lane & 31, hi = lane >> 5;
    LAS unsigned char* V_lds = lds + OFF_V; LAS unsigned char* K_lds = lds + OFF_K;
    LAS float* wsf = (LAS float*)(lds + OFF_WS) + wid * 64; LAS float* li_l = wsf; LAS float* al_l = wsf + 32;
    constexpr int NL = MLA ? 4 : 0;
    LAS unsigned char* ql = lds + OFF_QL + wid * 4096 + lane * 16;
    float m_reg = -1e30f, l_reg = 0.f; bf16x8 qr[NQ - NL];
#pragma unroll
    for (int d = 0; d < 4; ++d)
#pragma unroll
        for (int r = 0; r < 16; ++r) o[d][r] = 0.f;
    { const bf16_t* Qw = Qb + (size_t)(wid * QBLK + r32) * ldq + hi * 8;
#pragma unroll
      for (int d0 = 0; d0 < NQ - NL; ++d0) qr[d0] = *(const bf16x8*)(Qw + d0 * 16);
#pragma unroll
      for (int d0 = NQ - NL; d0 < NQ; ++d0) *(LAS bf16x8*)(ql + (d0 - (NQ - NL)) * 1024) = *(const bf16x8*)(Qw + d0 * 16); }
    const int sr = tid >> 4, sc = (tid & 15) * 8, vst0 = v_st(sr, sc), vst1 = v_st(32 + sr, sc);
    const int kr = tid >> 3, kc = tid & 7;
    int kst0, kst1, kst2;
    if (MLA) { kst0 = sr * STRIDE + (((tid & 15) ^ ((sr >> 1) & 7)) << 4); kst1 = kst0 + 32 * STRIDE; kst2 = kr * STRIDE + (((16 + kc) ^ ((kr >> 1) & 7)) << 4); }
    else { kst0 = kr * STRIDE + ((kc ^ ((kr >> 1) & 7)) << 4); kst1 = 0; kst2 = 0; }
    const int vb0 = (int)(unsigned)(uintptr_t)V_lds + v_rd_base(lane);
    const int jw = NT - 4 + (wid >> 1);
    bf16x8 vs0, vs1, ks0, ks1, ks2;
#define SLOAD(k0) do { vs0 = *(const bf16x8*)(Vh + (size_t)((k0) + sr) * 1024 + sc); vs1 = *(const bf16x8*)(Vh + (size_t)((k0) + 32 + sr) * 1024 + sc); \
    if (MLA) { ks0 = *(const bf16x8*)(Kh + (size_t)((k0) + sr) * 1024 + sc); ks1 = *(const bf16x8*)(Kh + (size_t)((k0) + 32 + sr) * 1024 + sc); ks2 = *(const bf16x8*)(Kpe + (size_t)((k0) + kr) * 64 + kc * 8); } \
    else { ks0 = *(const bf16x8*)(Kh + (size_t)((k0) + kr) * 1024 + kc * 8); } } while (0)
#define SWRITE(b) do { *(LAS bf16x8*)(V_lds + (b) * SHM_V + vst0) = vs0; *(LAS bf16x8*)(V_lds + (b) * SHM_V + vst1) = vs1; \
    *(LAS bf16x8*)(K_lds + (b) * SHM_K + kst0) = ks0; if (MLA) { *(LAS bf16x8*)(K_lds + (b) * SHM_K + kst1) = ks1; *(LAS bf16x8*)(K_lds + (b) * SHM_K + kst2) = ks2; } } while (0)
#define RESC(a) do { if (__any((a) < 1.f)) { if (hi == 0) al_l[r32] = (a); asm volatile("s_waitcnt lgkmcnt(0)" ::: "memory"); \
    _Pragma("unroll") for (int d = 0; d < 4; ++d) _Pragma("unroll") for (int r = 0; r < 16; ++r) o[d][r] *= al_l[crow(r, hi)]; } } while (0)
    f32x16 p0, p1; float al; bf16x8 pa0, pa1, pa2, pa3;
    SLOAD(0); SWRITE(0); __syncthreads();
    SLOAD(KVBLK);
    for (int j = 0; j < NT; ++j) {
        const int bsel = j & 1;
        if (j <= jw) {
            SBAR(); qkt<NQ, NL>(p0, p1, K_lds + bsel * SHM_K, qr, ql, r32, hi);
            partialSM(p0, p1, m_reg, al, C, true);
            RESC(al);
            finishSM(p0, p1, al, l_reg, pa0, pa1, pa2, pa3, true); SBAR();
            pv_d0(o, vb0 + bsel * SHM_V, pa0, pa1, pa2, pa3);
        }
        if (j + 1 < NT) {
#ifdef DIAG_XBAR
            __syncthreads();
#endif
            SWRITE(bsel ^ 1); __syncthreads();
            if (j + 2 < NT) SLOAD((j + 2) * KVBLK);
        }
    }
    __syncthreads();
    if (hi == 0) li_l[r32] = l_reg; asm volatile("s_waitcnt lgkmcnt(0)" ::: "memory");
#pragma unroll
    for (int r = 0; r < 16; ++r) { const float rl = __builtin_amdgcn_rcpf(li_l[crow(r, hi)]);
#pragma unroll
        for (int d = 0; d < 4; ++d) o[d][r] *= rl; }
    asm volatile("s_waitcnt lgkmcnt(0)" ::: "memory");
#undef SLOAD
#undef SWRITE
#undef RESC
}

__device__ __forceinline__ void glds16(const void* gsrc, unsigned lds_dst) { unsigned keep;
    asm volatile("s_mov_b32 %0, m0\n\ts_mov_b32 m0, %2\n\ts_nop 0\n\tglobal_load_lds_dwordx4 %1, off\n\ts_mov_b32 m0, %0" : "=&s"(keep) : "v"(gsrc), "s"(lds_dst) : "memory"); }
__host__ __device__ __forceinline__ int vq_k(int q) { const int sub = q >> 5, kk = (sub >> 2) * 8 + ((q & 31) >> 2); return (kk & ~0xC) | ((kk & 4) << 1) | ((kk & 8) >> 1); }
__host__ __device__ __forceinline__ int vq_c(int q) { return ((q >> 5) & 3) * 32 + (q & 3) * 8; }
constexpr int P2_V = 0, P2_K = 32768, P2_KP = 65536;
#define WAITBAR() asm volatile("s_waitcnt vmcnt(0) lgkmcnt(0)\n\ts_barrier" ::: "memory")

template <bool MLA>
__device__ __forceinline__ void qkt2(f32x16& p0, f32x16& p1, const LAS unsigned char* Kb, const LAS unsigned char* Kpb, const bf16x8* qr, const LAS unsigned char* ql, int r32, int hi) {
#pragma unroll
    for (int r = 0; r < 16; ++r) { p0[r] = 0.f; p1[r] = 0.f; }
    if (MLA) {
        const LAS unsigned char* k0p = Kb + r32 * 256; const LAS unsigned char* k1p = k0p + 32 * 256; const int sw = r32 & 15;
#pragma unroll
        for (int d0 = 0; d0 < 8; ++d0) { const int off = ((2 * d0 + hi) ^ sw) << 4;
            const bf16x8 b0 = *(const LAS bf16x8*)(k0p + off), b1 = *(const LAS bf16x8*)(k1p + off);
            p0 = __builtin_amdgcn_mfma_f32_32x32x16_bf16(b0, qr[d0], p0, 0, 0, 0); p1 = __builtin_amdgcn_mfma_f32_32x32x16_bf16(b1, qr[d0], p1, 0, 0, 0); }
        const LAS unsigned char* e0p = Kpb + r32 * 128; const LAS unsigned char* e1p = e0p + 32 * 128; const int sw2 = (r32 >> 1) & 7;
#pragma unroll
        for (int d0 = 0; d0 < 4; ++d0) { const int off = ((2 * d0 + hi) ^ sw2) << 4;
            const bf16x8 b0 = *(const LAS bf16x8*)(e0p + off), b1 = *(const LAS bf16x8*)(e1p + off), qf = *(const LAS bf16x8*)(ql + d0 * 1024);
            p0 = __builtin_amdgcn_mfma_f32_32x32x16_bf16(b0, qf, p0, 0, 0, 0); p1 = __builtin_amdgcn_mfma_f32_32x32x16_bf16(b1, qf, p1, 0, 0, 0); }
    } else {
        const LAS unsigned char* k0p = Kb + r32 * 128; const LAS unsigned char* k1p = k0p + 32 * 128; const int sw = (r32 >> 1) & 7;
#pragma unroll
        for (int d0 = 0; d0 < 4; ++d0) { const int off = ((2 * d0 + hi) ^ sw) << 4;
            const bf16x8 b0 = *(const LAS bf16x8*)(k0p + off), b1 = *(const LAS bf16x8*)(k1p + off);
            p0 = __builtin_amdgcn_mfma_f32_32x32x16_bf16(b0, qr[d0], p0, 0, 0, 0); p1 = __builtin_amdgcn_mfma_f32_32x32x16_bf16(b1, qr[d0], p1, 0, 0, 0); }
    }
}
template <bool MLA>
__device__ __forceinline__ void attn_pass2(const bf16_t* __restrict__ Qb, const int ldq, const bf16_t* __restrict__ Kh, const bf16_t* __restrict__ Kpe, const bf16_t* __restrict__ Vh,
                                           const int NT, const float C, LAS unsigned char* lds, f32x16 (&o)[4]) {
    constexpr int NQR = MLA ? 8 : 4, SHM_K2 = MLA ? 16384 : 8192;
    int tid = threadIdx.x; asm volatile("" : "+v"(tid));
    const int wid = __builtin_amdgcn_readfirstlane(tid >> 6), lane = tid & 63, r32 = lane & 31, hi = lane >> 5;
    LAS unsigned char* V_lds = lds + P2_V; LAS unsigned char* K_lds = lds + P2_K; LAS unsigned char* Kp_lds = lds + P2_KP;
    LAS float* wsf = (LAS float*)(lds + OFF_WS) + wid * 64; LAS float* li_l = wsf; LAS float* al_l = wsf + 32;
    LAS unsigned char* ql = lds + OFF_QL + wid * 4096 + lane * 16;
    const unsigned ldsb = (unsigned)(uintptr_t)lds;
    const unsigned dV = ldsb + P2_V + wid * 1024, dK = ldsb + P2_K + wid * 1024, dP = ldsb + P2_KP + wid * 1024;
#define LANEOFFS() int t2_ = tid; asm volatile("" : "+v"(t2_)); const int q0_ = t2_ & 511; \
    const unsigned voV0 = (unsigned)(vq_k(q0_) * 1024 + vq_c(q0_)) * 2u; \
    const unsigned voK0 = MLA ? (unsigned)((q0_ >> 4) * 1024 + (((q0_ & 15) ^ ((q0_ >> 4) & 15)) * 8)) * 2u : (unsigned)((q0_ >> 3) * 1024 + (((q0_ & 7) ^ ((q0_ >> 4) & 7)) * 8)) * 2u; \
    const unsigned voP = (unsigned)((q0_ >> 3) * 64 + (((q0_ & 7) ^ ((q0_ >> 4) & 7)) * 8)) * 2u; (void)voV0; (void)voK0; (void)voP
#define DMA_K(t, b) do { LANEOFFS(); const char* kb_ = (const char*)Kh + (size_t)(t) * (KVBLK * 1024 * 2); glds16(kb_ + voK0, (unsigned)__builtin_amdgcn_readfirstlane(dK + (b) * SHM_K2)); \
    if (MLA) { glds16(kb_ + voK0 + 65536, (unsigned)__builtin_amdgcn_readfirstlane(dK + (b) * SHM_K2 + 8192)); glds16((const char*)Kpe + (size_t)(t) * (KVBLK * 64 * 2) + voP, (unsigned)__builtin_amdgcn_readfirstlane(dP + (b) * 8192)); } } while (0)
#define DMA_V(t, b) do { LANEOFFS(); const char* vb_ = (const char*)Vh + (size_t)(t) * (KVBLK * 1024 * 2); glds16(vb_ + voV0, (unsigned)__builtin_amdgcn_readfirstlane(dV + (b) * SHM_V)); glds16(vb_ + voV0 + 65536, (unsigned)__builtin_amdgcn_readfirstlane(dV + (b) * SHM_V + 8192)); } while (0)
    DMA_K(0, 0);
    float m_reg = -1e30f, l_reg = 0.f; bf16x8 qr[NQR];
#pragma unroll
    for (int d = 0; d < 4; ++d)
#pragma unroll
        for (int r = 0; r < 16; ++r) o[d][r] = 0.f;
    { const bf16_t* Qw = Qb + (size_t)(wid * QBLK + r32) * ldq + hi * 8;
#pragma unroll
      for (int d0 = 0; d0 < NQR; ++d0) qr[d0] = *(const bf16x8*)(Qw + d0 * 16);
      if (MLA) {
#pragma unroll
          for (int d0 = 0; d0 < 4; ++d0) *(LAS bf16x8*)(ql + d0 * 1024) = *(const bf16x8*)(Qw + (8 + d0) * 16); } }
    const int vb0 = (int)(ldsb + P2_V) + v_rd_base(lane);
    const int jw = NT - 4 + (wid >> 1);
#define RESC2(a) do { if (__any((a) < 1.f)) { if (hi == 0) al_l[r32] = (a); asm volatile("s_waitcnt lgkmcnt(0)" ::: "memory"); \
    _Pragma("unroll") for (int d = 0; d < 4; ++d) _Pragma("unroll") for (int r = 0; r < 16; ++r) o[d][r] *= al_l[crow(r, hi)]; } } while (0)
    f32x16 pA0, pA1, pB0, pB1; float alA = 1.f, alB = 1.f; bf16x8 pa0, pa1, pa2, pa3;
    WAITBAR();
    DMA_K(1, 1); DMA_V(0, 0);
    SBAR(); qkt2<MLA>(pA0, pA1, K_lds, Kp_lds, qr, ql, r32, hi); partialSM(pA0, pA1, m_reg, alA, C, true);
    WAITBAR();
#define STEP2(PX0, PX1, ALX, PY0, PY1, ALY, KOFF, KPOFF, VOFF, VQ, VP) do { \
        SBAR(); if (VQ) qkt2<MLA>(PX0, PX1, K_lds + (KOFF), Kp_lds + (KPOFF), qr, ql, r32, hi); \
        if (VP) { finishSM(PY0, PY1, ALY, l_reg, pa0, pa1, pa2, pa3, true); SBAR(); pv_d0(o, vb0 + (VOFF), pa0, pa1, pa2, pa3); } \
        partialSM(PX0, PX1, m_reg, ALX, C, VQ); RESC2(ALX); WAITBAR(); } while (0)
    int j = 1;
    for (; j + 1 <= NT - 4; j += 2) {
        DMA_K(j + 1, 0); DMA_V(j, 1);
        STEP2(pB0, pB1, alB, pA0, pA1, alA, SHM_K2, 8192, 0, true, true);
        DMA_K(j + 2, 1); DMA_V(j + 1, 0);
        STEP2(pA0, pA1, alA, pB0, pB1, alB, 0, 0, SHM_V, true, true);
    }
    {
        const bool vj = (j <= jw), vn = (j + 1 <= jw);
        DMA_K(j + 1, 0); DMA_V(j, 1);
        STEP2(pB0, pB1, alB, pA0, pA1, alA, SHM_K2, 8192, 0, vj, true);
        DMA_K(j + 2, 1); DMA_V(j + 1, 0);
        STEP2(pA0, pA1, alA, pB0, pB1, alB, 0, 0, SHM_V, vn, vj);
    }
    {
        const bool vp = (NT - 2 <= jw), vj = (NT - 1 <= jw);
        DMA_V(NT - 1, 1);
        SBAR(); if (vj) qkt2<MLA>(pB0, pB1, K_lds + SHM_K2, Kp_lds + 8192, qr, ql, r32, hi);
        if (vp) { finishSM(pA0, pA1, alA, l_reg, pa0, pa1, pa2, pa3, true); SBAR(); pv_d0(o, vb0, pa0, pa1, pa2, pa3); }
        partialSM(pB0, pB1, m_reg, alB, C, vj);
        RESC2(alB);
        WAITBAR();
        if (vj) { finishSM(pB0, pB1, alB, l_reg, pa0, pa1, pa2, pa3, true); SBAR(); pv_d0(o, vb0 + SHM_V, pa0, pa1, pa2, pa3); }
    }
    WAITBAR();
    if (hi == 0) li_l[r32] = l_reg; asm volatile("s_waitcnt lgkmcnt(0)" ::: "memory");
#pragma unroll
    for (int r = 0; r < 16; ++r) { const float rl = __builtin_amdgcn_rcpf(li_l[crow(r, hi)]);
#pragma unroll
        for (int d = 0; d < 4; ++d) o[d][r] *= rl; }
    asm volatile("s_waitcnt lgkmcnt(0)" ::: "memory");
#undef DMA_K
#undef DMA_V
#undef LANEOFFS
#undef RESC2
#undef STEP2
}
#undef WAITBAR
#undef SBAR
}
typedef GAS unsigned gu32;
#define RLX_AGENT __ATOMIC_RELAXED, __HIP_MEMORY_SCOPE_AGENT
#define LDS_WAIT() asm volatile("s_waitcnt lgkmcnt(0)" ::: "memory")
#define VM_WAIT() asm volatile("s_waitcnt vmcnt(0)" ::: "memory")
#define XB_TMO      128
#define XB_XCNT(j)  (256  + 64 * (j))
#define XB_XSUB(j)  (1280 + 64 * (j))
#define XB_XGEN(j)  (2304 + 64 * (j))
#define XB_TOP      3328
#define XB_TOPGEN   3392
#define XCD_BAR_WORDS 3456
#define XB_SPIN_CAP (1u << 18)

__device__ __forceinline__ unsigned xb_ld(unsigned* p)              { return __hip_atomic_load(p, __ATOMIC_RELAXED, __HIP_MEMORY_SCOPE_AGENT); }
__device__ __forceinline__ unsigned xb_add(unsigned* p, unsigned v) { return __hip_atomic_fetch_add(p, v, __ATOMIC_RELAXED, __HIP_MEMORY_SCOPE_AGENT); }
__device__ __forceinline__ unsigned xb_xcc_id() { return (unsigned)__builtin_amdgcn_s_getreg((3 << 11) | 20) & 0xFu; }
#define XB_SPIN(cond, bar) do { unsigned _sp = 0; while (cond) { __builtin_amdgcn_s_sleep(1); \
    if ((++_sp & 255u) == 0u) { if (xb_ld(&(bar)[XB_TMO])) break; if (_sp > XB_SPIN_CAP) { atomicAdd(&(bar)[XB_TMO], 1u); break; } } } } while (0)

struct XcdBarrier {
    unsigned* bar; unsigned x;
    volatile LAS unsigned* st;
};
__device__ __forceinline__ XcdBarrier xcd_barrier_post(unsigned* bar, volatile LAS unsigned* st) {
    XcdBarrier b; b.bar = bar; b.x = xb_xcc_id(); b.st = st;
    if (threadIdx.x == 0) (void)xb_add(&bar[XB_XCNT(b.x)], 1u);
    return b;
}
__device__ __forceinline__ void xcd_barrier_complete(unsigned* bar, unsigned x, unsigned& nloc, unsigned& nx) {
    const unsigned G = gridDim.x * gridDim.y * gridDim.z;
    unsigned sum, cnt, mine, sp = 0u;
    for (;;) {
        sum = 0u; cnt = 0u; mine = 0u;
#pragma unroll
        for (unsigned j = 0; j < 16; ++j) { const unsigned c = xb_ld(&bar[XB_XCNT(j)]); sum += c; cnt += (c > 0u) ? 1u : 0u; mine = (j == x) ? c : mine; }
        if (sum == G) break;
        __builtin_amdgcn_s_sleep(1);
        if ((++sp & 255u) == 0u) { if (xb_ld(&bar[XB_TMO])) break; if (sp > XB_SPIN_CAP) { atomicAdd(&bar[XB_TMO], 1u); break; } }
    }
    nloc = mine > 0u ? mine : 1u; nx = cnt > 0u ? cnt : 1u;
}
__device__ __forceinline__ void xcd_barrier(const XcdBarrier& b) {
    asm volatile("s_waitcnt vmcnt(0)" ::: "memory");
    __syncthreads();
    if (threadIdx.x == 0) {
        unsigned* bar = b.bar;
        __builtin_amdgcn_s_waitcnt(0);
        unsigned nloc = b.st[0], nx = b.st[1];
        if (nloc == 0u) { xcd_barrier_complete(bar, b.x, nloc, nx); b.st[0] = nloc; b.st[1] = nx; }
#ifdef PROBE_BARWAIT
        const unsigned long long pbw_t0 = __builtin_amdgcn_s_memrealtime();
#endif
        const unsigned old = xb_add(&bar[XB_XSUB(b.x)], 1u);
        const unsigned gen = old / nloc;
        if (old + 1u == (gen + 1u) * nloc) {
            __builtin_amdgcn_fence(__ATOMIC_RELEASE, "agent");
            asm volatile("s_waitcnt vmcnt(0)" ::: "memory");
            const unsigned og = xb_add(&bar[XB_TOP], 1u);
            const unsigned tg = og / nx;
            if (og + 1u == (tg + 1u) * nx) xb_add(&bar[XB_TOPGEN], 1u);
            else XB_SPIN(xb_ld(&bar[XB_TOPGEN]) == tg, bar);
            __builtin_amdgcn_fence(__ATOMIC_ACQUIRE, "agent");
            xb_add(&bar[XB_XGEN(b.x)], 1u);
            asm volatile("s_waitcnt vmcnt(0)" ::: "memory");
        } else {
            XB_SPIN(xb_ld(&bar[XB_XGEN(b.x)]) == gen, bar);
            __builtin_amdgcn_fence(__ATOMIC_ACQUIRE, "agent");
            asm volatile("s_waitcnt vmcnt(0)" ::: "memory");
        }
#ifdef PROBE_BARWAIT
        b.st[2] += (unsigned)(__builtin_amdgcn_s_memrealtime() - pbw_t0);
#endif
    }
    __syncthreads();
}

__device__ __forceinline__ float dot4(f32x4 a) { return (a[0] * a[0] + a[1] * a[1]) + (a[2] * a[2] + a[3] * a[3]); }
__device__ __forceinline__ u32x2 pack4(f32x4 a) { u32x2 w; w.x = cvt_pk_bf16(a[0], a[1]); w.y = cvt_pk_bf16(a[2], a[3]); return w; }

__device__ __forceinline__ f32x4 bf4lo(u32x4 w) { return (f32x4){bflo(w.x), bfhi(w.x), bflo(w.y), bfhi(w.y)}; }
__device__ __forceinline__ f32x4 bf4hi(u32x4 w) { return (f32x4){bflo(w.z), bfhi(w.z), bflo(w.w), bfhi(w.w)}; }
__device__ __forceinline__ void thin_first_norm(const float* xin, bf16_t* xb, float* rsx, int gw, int NGW, int lane) {
    for (int m = gw; m < MTOK; m += NGW) {
        const f32x4* xr = (const f32x4*)(xin + (size_t)m * DM) + 2 * lane; f32x4 v[8]; float s = 0.f;
#pragma unroll
        for (int j = 0; j < 4; ++j) { v[2 * j] = xr[128 * j]; v[2 * j + 1] = xr[128 * j + 1]; s += dot4(v[2 * j]) + dot4(v[2 * j + 1]); }
        const float rstd = __builtin_amdgcn_rsqf(wave_sum(s) * (1.0f / DM) + EPS);
        u32x4* xo = (u32x4*)(xb + (size_t)m * DM) + lane;
#pragma unroll
        for (int j = 0; j < 4; ++j) xo[64 * j] = pack8(v[2 * j], v[2 * j + 1]);
        if (lane == 0) rsx[m] = rstd;
    }
}
__device__ __forceinline__ void thin_res_norm(const bf16_t* y, bf16_t* xb, const float* g_post, float* rsx, int gw, int NGW, int lane, float* xout = nullptr) {
    f32x4 gp[8];
#pragma unroll
    for (int j = 0; j < 8; ++j) { const int idx = 2 * (lane + 64 * (j >> 1)) + (j & 1); gp[j] = ((const f32x4*)g_post)[idx]; }
    u32x4 y0[4], y1[4], y2[4], x0[4], x1[4], x2[4];
    auto ld = [&](int m, u32x4 (&yw)[4], u32x4 (&xw)[4]) __attribute__((always_inline)) {
        const u32x4* yr = (const u32x4*)(y + (size_t)m * DM) + lane; const u32x4* xr = (const u32x4*)(xb + (size_t)m * DM) + lane;
#pragma unroll
        for (int j = 0; j < 4; ++j) { yw[j] = yr[64 * j]; xw[j] = xr[64 * j]; } };
    auto row = [&](int m, u32x4 (&yw)[4], u32x4 (&xw)[4]) __attribute__((always_inline)) {
        f32x4 v[8]; float s = 0.f;
#pragma unroll
        for (int j = 0; j < 4; ++j) { v[2 * j] = bf4lo(yw[j]); v[2 * j + 1] = bf4hi(yw[j]); s += dot4(v[2 * j]) + dot4(v[2 * j + 1]); }
        const float rstd = __builtin_amdgcn_rsqf(wave_sum(s) * (1.0f / DM) + EPS); float s2 = 0.f;
#pragma unroll
        for (int j = 0; j < 4; ++j) { v[2 * j] = bf4lo(xw[j]) + v[2 * j] * rstd * gp[2 * j]; v[2 * j + 1] = bf4hi(xw[j]) + v[2 * j + 1] * rstd * gp[2 * j + 1]; s2 += dot4(v[2 * j]) + dot4(v[2 * j + 1]); }
        if (xout) { f32x4* xo = (f32x4*)(xout + (size_t)m * DM) + 2 * lane;
#pragma unroll
            for (int j = 0; j < 4; ++j) { xo[128 * j] = v[2 * j]; xo[128 * j + 1] = v[2 * j + 1]; } }
        else { u32x4* xo = (u32x4*)(xb + (size_t)m * DM) + lane;
#pragma unroll
            for (int j = 0; j < 4; ++j) xo[64 * j] = pack8(v[2 * j], v[2 * j + 1]); }
        if (rsx) { const float rstd2 = __builtin_amdgcn_rsqf(wave_sum(s2) * (1.0f / DM) + EPS); if (lane == 0) rsx[m] = rstd2; } };
#define TRN_PIN(yw, xw) asm volatile("" : "+v"(yw[0]), "+v"(yw[1]), "+v"(yw[2]), "+v"(yw[3]), "+v"(xw[0]), "+v"(xw[1]), "+v"(xw[2]), "+v"(xw[3]) :: "memory")
#define TRN_M(k) (gw + (k) * NGW)
    ld(TRN_M(0), y0, x0); ld(TRN_M(1), y1, x1);
    ld(TRN_M(2), y2, x2); TRN_PIN(y0, x0); row(TRN_M(0), y0, x0);
    ld(TRN_M(3), y0, x0); TRN_PIN(y1, x1); row(TRN_M(1), y1, x1);
    ld(TRN_M(4), y1, x1); TRN_PIN(y2, x2); row(TRN_M(2), y2, x2);
    ld(TRN_M(5), y2, x2); TRN_PIN(y0, x0); row(TRN_M(3), y0, x0);
    ld(TRN_M(6), y0, x0); TRN_PIN(y1, x1); row(TRN_M(4), y1, x1);
    ld(TRN_M(7), y1, x1); TRN_PIN(y2, x2); row(TRN_M(5), y2, x2);
    TRN_PIN(y0, x0); row(TRN_M(6), y0, x0); TRN_PIN(y1, x1); row(TRN_M(7), y1, x1);
#undef TRN_M
#undef TRN_PIN
}
__device__ __forceinline__ void thin_mem_norm(const float* mem, const float* g_mem, bf16_t* memn, int gw, int NGW, int lane) {
    for (int r = gw; r < MROWS; r += NGW) {
        const f32x4* xr = (const f32x4*)(mem + (size_t)r * DM) + lane; f32x4 v[8]; float s = 0.f;
#pragma unroll
        for (int j = 0; j < 8; ++j) { v[j] = xr[64 * j]; s += dot4(v[j]); }
        const float rstd = __builtin_amdgcn_rsqf(wave_sum(s) * (1.0f / DM) + EPS);
        for (int l = 0; l < DEPTH; ++l) { const f32x4* g = (const f32x4*)(g_mem + (size_t)l * DM) + lane; u32x2* ho = (u32x2*)(memn + ((size_t)l * MROWS + r) * DM) + lane;
#pragma unroll
            for (int j = 0; j < 8; ++j) ho[64 * j] = pack4(v[j] * rstd * g[64 * j]); }
    }
}
__device__ __forceinline__ void thin_softmax(const float* S, bf16_t* P, int gw, int NGW, int lane) {
    const float C = 0.044194173824159216f * LOG2E;
    for (int m = gw; m < MTOK; m += NGW) {
        const f32x4* sr = (const f32x4*)(S + (size_t)m * 1024) + lane; u32x2* po = (u32x2*)(P + (size_t)m * 1024) + lane; f32x4 v[4];
#pragma unroll
        for (int j = 0; j < 4; ++j) v[j] = sr[64 * j];
#pragma unroll
        for (int j = 0; j < 4; ++j) {
            const float mx = wave_max(fmaxf(fmaxf(v[j][0], v[j][1]), fmaxf(v[j][2], v[j][3])));
            f32x4 e;
#pragma unroll
            for (int k = 0; k < 4; ++k) e[k] = __builtin_amdgcn_exp2f((v[j][k] - mx) * C);
            const float sum = wave_sum((e[0] + e[1]) + (e[2] + e[3]));
            po[64 * j] = pack4(e * __builtin_amdgcn_rcpf(sum));
        }
    }
}
__device__ __forceinline__ void thin_conv_glu(const bf16_t* u, bf16_t* act, const float* cw, const float* cb, int gw, int NGW, int lane) {
    constexpr int NBLK = NUP / 512, NCH = MTOK / 64;
    for (int task = gw; task < NBLK * NCH; task += NGW) {
        const int chunk = task / NBLK, blk = task % NBLK, gidx = blk * 64 + lane, m0 = chunk * 64;
        f32x4 wa[3], wg[3];
#pragma unroll
        for (int j = 0; j < 3; ++j) { wa[j] = *(const f32x4*)(cw + (size_t)j * NUP + 4 * gidx); wg[j] = *(const f32x4*)(cw + (size_t)j * NUP + DFF + 4 * gidx); }
        const f32x4 ba = *(const f32x4*)(cb + 4 * gidx), bg = *(const f32x4*)(cb + DFF + 4 * gidx);
        const bf16_t* up = u + (size_t)m0 * NUP + 8 * gidx; bf16_t* ap = act + (size_t)m0 * DFF + 4 * gidx;
        u32x4 p2 = (u32x4){0u, 0u, 0u, 0u}, p1 = p2;
        if ((m0 & (SEQ - 1)) != 0) { p2 = *(const u32x4*)(up - 2 * (size_t)NUP); p1 = *(const u32x4*)(up - (size_t)NUP); }
        for (int r0 = 0; r0 < 64; r0 += 8) {
            u32x4 cur[8];
#pragma unroll
            for (int i = 0; i < 8; ++i) cur[i] = *(const u32x4*)(up + (size_t)(r0 + i) * NUP);
#pragma unroll
            for (int i = 0; i < 8; ++i) { const u32x4 c = cur[i];
                const f32x4 a2 = (f32x4){bflo(p2.x), bfhi(p2.x), bflo(p2.y), bfhi(p2.y)}, g2 = (f32x4){bflo(p2.z), bfhi(p2.z), bflo(p2.w), bfhi(p2.w)};
                const f32x4 a1 = (f32x4){bflo(p1.x), bfhi(p1.x), bflo(p1.y), bfhi(p1.y)}, g1 = (f32x4){bflo(p1.z), bfhi(p1.z), bflo(p1.w), bfhi(p1.w)};
                const f32x4 a0 = (f32x4){bflo(c.x), bfhi(c.x), bflo(c.y), bfhi(c.y)}, g0 = (f32x4){bflo(c.z), bfhi(c.z), bflo(c.w), bfhi(c.w)};
                const f32x4 ca = a2 * wa[0] + a1 * wa[1] + a0 * wa[2] + ba, cg = g2 * wg[0] + g1 * wg[1] + g0 * wg[2] + bg;
                f32x4 o;
#pragma unroll
                for (int e = 0; e < 4; ++e) o[e] = ca[e] * __builtin_amdgcn_rcpf(1.0f + __builtin_amdgcn_exp2f(-ca[e] * LOG2E)) * cg[e];
                *(u32x2*)(ap + (size_t)(r0 + i) * DFF) = pack4(o);
                p2 = p1; p1 = c; }
        }
    }
}

__device__ __forceinline__ void thin_conv_fix(const float* U4, bf16_t* act, const float* cw, const float* cb, int gw, int NGW, int lane) {
    constexpr int NG = NUP / 8;
    for (int i = gw * 64 + lane; i < 64 * 2 * NG; i += NGW * 64) {
        const int pm = i / (2 * NG), rem = i - pm * (2 * NG), r = rem / NG, gidx = rem - r * NG; const bool first = (pm & 15) == 0;
        const float* t0 = U4 + (size_t)(pm * 4) * NUP + 8 * gidx; const float* tp = U4 + (size_t)((pm - 1) * 4) * NUP + 8 * gidx;
        const f32x4 z = (f32x4){0.f, 0.f, 0.f, 0.f};
        f32x4 a0, g0, a1, g1, a2, g2;
        if (r == 0) { a0 = *(const f32x4*)t0; g0 = *(const f32x4*)(t0 + 4);
            a1 = first ? z : *(const f32x4*)(tp + 3 * (size_t)NUP); g1 = first ? z : *(const f32x4*)(tp + 3 * (size_t)NUP + 4);
            a2 = first ? z : *(const f32x4*)(tp + 2 * (size_t)NUP); g2 = first ? z : *(const f32x4*)(tp + 2 * (size_t)NUP + 4); }
        else { a0 = *(const f32x4*)(t0 + NUP); g0 = *(const f32x4*)(t0 + NUP + 4); a1 = *(const f32x4*)t0; g1 = *(const f32x4*)(t0 + 4);
            a2 = first ? z : *(const f32x4*)(tp + 3 * (size_t)NUP); g2 = first ? z : *(const f32x4*)(tp + 3 * (size_t)NUP + 4); }
        const f32x4 ca = a2 * *(const f32x4*)(cw + 4 * gidx) + a1 * *(const f32x4*)(cw + NUP + 4 * gidx) + a0 * *(const f32x4*)(cw + 2 * (size_t)NUP + 4 * gidx) + *(const f32x4*)(cb + 4 * gidx);
        const f32x4 cg = g2 * *(const f32x4*)(cw + DFF + 4 * gidx) + g1 * *(const f32x4*)(cw + NUP + DFF + 4 * gidx) + g0 * *(const f32x4*)(cw + 2 * (size_t)NUP + DFF + 4 * gidx) + *(const f32x4*)(cb + DFF + 4 * gidx);
        f32x4 o;
#pragma unroll
        for (int e = 0; e < 4; ++e) o[e] = ca[e] * __builtin_amdgcn_rcpf(1.0f + __builtin_amdgcn_exp2f(-ca[e] * LOG2E)) * cg[e];
        *(u32x2*)(act + (size_t)(pm * 256 + r) * DFF + 4 * gidx) = pack4(o);
    }
}

struct MapId { __device__ __forceinline__ int operator()(int n) const { return n; } };
struct MapIn { __device__ __forceinline__ int operator()(int n) const {
    if (n < 2048) { const int i = n & 63; return (n & ~63) + 2 * (i & 31) + (i >> 5); }
    if (n < 3840) return n;
    if (n < 3904) { const int i = n - 3840; return 3840 + 2 * (i & 31) + (i >> 5); }
    return n + 192; } };
struct MapUq { __device__ __forceinline__ int operator()(int n) const { const int hd = n / 192, r = n - hd * 192; if (r < 128) return n; const int i = r - 128; return hd * 192 + 128 + 2 * (i & 31) + (i >> 5); } };
struct MapUkv { __device__ __forceinline__ int operator()(int n) const { const int hd = n >> 8, r = n & 255; return r < 128 ? hd * 128 + r : 1024 + hd * 128 + (r - 128); } };
struct MapUp { __device__ __forceinline__ int operator()(int n) const { if (n < DFF) return 8 * (n >> 2) + (n & 3); const int q = n - DFF; return 8 * (q >> 2) + 4 + (q & 3); } };

struct TrSrc { const float* p; int s1, s2; };
__device__ __forceinline__ void tr_ld(const TrSrc& s, f32x4 (&v)[8]) {
#pragma unroll
#ifdef CONV_NT
    for (int i = 0; i < 8; ++i) v[i] = __builtin_nontemporal_load((const f32x4*)(s.p + (size_t)(i >> 1) * s.s2 + (size_t)(i & 1) * s.s1));
#else
    for (int i = 0; i < 8; ++i) v[i] = *(const f32x4*)(s.p + (size_t)(i >> 1) * s.s2 + (size_t)(i & 1) * s.s1);
#endif
}
__device__ __forceinline__ TrSrc tr_src(const float* W, int N, int item, int lane) {
    const int nblk = N / 32, kb = item / nblk, nb = item - kb * nblk;
    return TrSrc{W + (size_t)(64 * kb + (lane >> 3)) * N + 32 * nb + (lane & 7) * 4, 8 * N, 16 * N};
}
template <class Map>
__device__ __forceinline__ void tr_st(f32x4 (&v)[8], int N, bf16_t* WT, int ldd, int kofs, const float* gs, LAS float* scr, int item, int lane, Map map) {
    const int nblk = N / 32, kb = item / nblk, nb = item - kb * nblk, k0 = 64 * kb, n0 = 32 * nb;
    const int rr = lane >> 3, c4 = (lane & 7) * 4;
    if (gs) {
#pragma unroll
        for (int i = 0; i < 8; ++i) v[i] = v[i] * gs[k0 + 8 * i + rr]; }
#pragma unroll
    for (int i = 0; i < 8; ++i) { LAS float* d = scr + (8 * i + rr) * 33 + c4; d[0] = v[i][0]; d[1] = v[i][1]; d[2] = v[i][2]; d[3] = v[i][3]; }
    LDS_WAIT(); asm volatile("" ::: "memory");
    const int c = lane & 7;
#pragma unroll
    for (int j = 0; j < 4; ++j) { const int n = (lane >> 3) + 8 * j; const LAS float* s = scr + (8 * c) * 33 + n;
        u32x4 o; o.x = cvt_pk_bf16(s[0 * 33], s[1 * 33]); o.y = cvt_pk_bf16(s[2 * 33], s[3 * 33]); o.z = cvt_pk_bf16(s[4 * 33], s[5 * 33]); o.w = cvt_pk_bf16(s[6 * 33], s[7 * 33]);
        *(u32x4*)(WT + (size_t)map(n0 + n) * ldd + kofs + k0 + 8 * c) = o; }
    LDS_WAIT(); asm volatile("" ::: "memory");
}

#ifdef DIAG_CKS
__device__ __forceinline__ void cks_rows(const unsigned* buf, int row_words, int nrows, unsigned* persist, unsigned* ctlw, int gw, int NGW, int lane) {
    for (int m = gw; m < nrows; m += NGW) {
        const unsigned* r = buf + (size_t)m * row_words; unsigned c = 0u;
        for (int i = lane; i < row_words; i += 64) c = c * 31u + r[i] * (2u * (unsigned)i + 1u);
        c += (unsigned)__builtin_amdgcn_ds_swizzle((int)c, (1 << 10) | 0x1f); c += (unsigned)__builtin_amdgcn_ds_swizzle((int)c, (2 << 10) | 0x1f); c += (unsigned)__builtin_amdgcn_ds_swizzle((int)c, (4 << 10) | 0x1f);
        c += (unsigned)__builtin_amdgcn_ds_swizzle((int)c, (8 << 10) | 0x1f); c += (unsigned)__builtin_amdgcn_ds_swizzle((int)c, (16 << 10) | 0x1f);
        { auto rr = __builtin_amdgcn_permlane32_swap(c, c, false, false); c = rr[0] + rr[1]; }
        if (lane == 0) { unsigned* ps = persist + 2 * (size_t)m; const unsigned o0 = __hip_atomic_load(ps, __ATOMIC_RELAXED, __HIP_MEMORY_SCOPE_AGENT), o1 = __hip_atomic_load(ps + 1, __ATOMIC_RELAXED, __HIP_MEMORY_SCOPE_AGENT);
            if (o1 == (o0 ^ 0x5a5a5a5au) && o0 != c) __hip_atomic_fetch_add(ctlw, 1u, __ATOMIC_RELAXED, __HIP_MEMORY_SCOPE_AGENT);
            __hip_atomic_store(ps, c, __ATOMIC_RELAXED, __HIP_MEMORY_SCOPE_AGENT); __hip_atomic_store(ps + 1, c ^ 0x5a5a5a5au, __ATOMIC_RELAXED, __HIP_MEMORY_SCOPE_AGENT); }
    }
}
#endif
#ifndef MK_SINGLE
#define MK_SINGLE 1
#endif
constexpr int NWAVES = 8;
constexpr int RING_BYTES = 131072, LDSCTL_OFF = RING_BYTES, MISC_OFF = LDSCTL_OFF + 320, LDS_BYTES = 147456;
constexpr int NPL = 16, NPH = 2 + DEPTH * NPL;

struct Args { const void* in[31]; float* out; unsigned char* ws; int ph_lo, ph_hi; float lam_init[4]; float inv_freq[32]; };
static_assert(sizeof(Args) == 31 * 8 + 8 + 8 + 8 + 16 + 128, "Args has no padding");

__global__ void __launch_bounds__(NWAVES * 64, 2) fwd(Args args) {
    extern __shared__ __attribute__((aligned(16))) unsigned char lds_raw[];
    LAS unsigned char* lds = (LAS unsigned char*)lds_raw;
    volatile LAS unsigned* MISC = (volatile LAS unsigned*)(lds + MISC_OFF);
    for (int u = threadIdx.x; u < (LDS_BYTES - LDSCTL_OFF) / 4; u += NWAVES * 64) ((LAS unsigned*)(lds + LDSCTL_OFF))[u] = 0u;
    __syncthreads();
    const int lo = args.ph_lo, hi = args.ph_hi;
    unsigned* barw = (unsigned*)(GAS unsigned*)(((const __attribute__((address_space(4))) unsigned long long*)__builtin_amdgcn_kernarg_segment_ptr())[32] + WS_CTL) + CW_BAR;
    XcdBarrier bar; bar.bar = barw; bar.x = 0; bar.st = MISC + 8;
    if (hi - lo > 1) bar = xcd_barrier_post(barw, MISC + 8);
#ifdef PROBE_WALL
    if (threadIdx.x == 0) MISC[12] = (unsigned)__builtin_amdgcn_s_memrealtime();
#define WALL_TICK(k) do { if (threadIdx.x == 0) { const unsigned t_ = (unsigned)__builtin_amdgcn_s_memrealtime(), dt_ = t_ - MISC[12]; MISC[12] = t_; \
        const int ty_ = (k) < 2 ? 16 + (k) : ((k) - 2) % NPL; if (ty_ == (PROBE_WALL)) MISC[14] += dt_; } } while (0)
#else
#define WALL_TICK(k) do { } while (0)
#endif
#ifndef WGM_N8
#define WGM_N8 4
#endif
#ifndef EPI_ALIGN
#define EPI_ALIGN true
#endif
#ifndef PHMASK
#define PHMASK 0x3ffff
#endif
#ifndef PROBE_PHASE
#define PROBE_PHASE -1
#endif
#define PREP(k) for (int rep_ = 0; rep_ < ((PROBE_PHASE) == (k) ? 2 : 1); ++rep_)
#ifdef PROBE_FLUSH
#define FLUSH_SWEEP() do { PHASE_BEGIN(); xcd_barrier(bar); const u32x4* fp_ = (const u32x4*)(ws + WS_RA); u32x4 fa_ = (u32x4){0u, 0u, 0u, 0u}; \
    for (size_t i_ = (size_t)(tid + bx * 512); i_ < (size_t)(352u << 20) / 16; i_ += (size_t)G * 512) { const u32x4 t_ = fp_[i_]; fa_.x ^= t_.x; fa_.y ^= t_.y; fa_.z ^= t_.z; fa_.w ^= t_.w; } \
    if ((fa_.x ^ fa_.y ^ fa_.z ^ fa_.w) == 0x13572468u) ((unsigned*)(ws + WS_CTL))[90] = 1u; xcd_barrier(bar); } while (0)
#endif
#define EN(j) (((PHMASK) >> (j)) & 1)
#define PH(k) (lo <= (k) && (k) < hi)
#ifdef PROBE_DOUBLE_BAR
#define SEAM(k) do { if (PH(k) && PH((k) + 1)) { xcd_barrier(bar); xcd_barrier(bar); } } while (0)
#else
#define SEAM(k) do { if (PH(k) && PH((k) + 1)) { xcd_barrier(bar); WALL_TICK(k); } } while (0)
#endif

    typedef const __attribute__((address_space(4))) unsigned long long* kptr_t;
#define KARGS() ({ kptr_t _p = (kptr_t)__builtin_amdgcn_kernarg_segment_ptr(); asm volatile("" : "+s"(_p)); _p; })
#define PHASE_BEGIN() kptr_t kp = KARGS(); unsigned char* ws = (unsigned char*)(GAS unsigned char*)kp[32]; int tid = threadIdx.x, G = gridDim.x, bx = blockIdx.x; asm volatile("" : "+v"(tid), "+s"(G), "+s"(bx)); \
    const int vcu = (G % 8 == 0) ? (bx % 8) * (G / 8) + bx / 8 : bx;     \
    const int lane = tid & 63, wave = __builtin_amdgcn_readfirstlane(tid >> 6), gw = vcu * NWAVES + wave, NGW = G * NWAVES; (void)lane; (void)gw; (void)ws; (void)NGW
#define INP(i) ((const float*)(const GAS float*)kp[i])
#define x_in INP(0)
#define mem INP(1)
#define positions ((const int*)(const GAS int*)kp[2])
#define g_pre_mix INP(3)
#define w_in INP(4)
#define b_gate INP(5)
#define lam_q1 INP(6)
#define lam_k1 INP(7)
#define lam_q2 INP(8)
#define lam_k2 INP(9)
#define g_diff_sub INP(10)
#define g_cq INP(11)
#define w_uq INP(12)
#define g_ckv INP(13)
#define w_ukv INP(14)
#define w_br_diff INP(15)
#define w_br_mla INP(16)
#define w_mix_out INP(17)
#define g_post_mix INP(18)
#define g_pre_x INP(19)
#define g_mem INP(20)
#define w_q_x INP(21)
#define w_kv_x INP(22)
#define w_o_x INP(23)
#define g_post_x INP(24)
#define g_pre_ffn INP(25)
#define w_up INP(26)
#define conv_w INP(27)
#define conv_b INP(28)
#define w_down INP(29)
#define g_post_ffn INP(30)
#define X ((float*)(GAS float*)kp[31])
#define LAM_INIT(l) (((const __attribute__((address_space(4))) float*)kp)[68 + (l)])
#define INV_FREQ(i) (((const __attribute__((address_space(4))) float*)kp)[72 + (i)])
#define WSB ((bf16_t*)ws)
#define Wall ((bf16_t*)(ws + WS_W))
#define RSX ((float*)(ws + WS_RSX))
#define cs ((f32x2*)(ws + WS_CS))
#define ssq_cq ((float*)(ws + WS_SSQ_CQ))
#define ssq_ckv ((float*)(ws + WS_SSQ_CKV))
#define Kmem ((bf16_t*)(ws + RA_KMEM))
#define Vmem ((bf16_t*)(ws + RA_VMEM))
#define Qd ((bf16_t*)(ws + RA_QD))
#define Kd ((bf16_t*)(ws + RA_KD))
#define Vd ((bf16_t*)(ws + RA_VD))
#define cq ((bf16_t*)(ws + RA_CQ))
#define ckv ((bf16_t*)(ws + RA_CKV))
#define kpe ((bf16_t*)(ws + RA_KPE))
#define gates ((bf16_t*)(ws + RA_GATES))
#define merged ((bf16_t*)(ws + RA_MERGED))
#define q_x ((bf16_t*)(ws + RA_QX))
#define Pm ((bf16_t*)(ws + RA_P))
#define o_x ((bf16_t*)(ws + RA_OX))
#define Ub ((bf16_t*)(ws + RA_U))
#define Sx ((float*)(ws + RA_S))
#define memn ((bf16_t*)(ws + RA_MEMN))
#define Qm ((bf16_t*)(ws + RB_QM))
#define Kn ((bf16_t*)(ws + RB_KN))
#define Vm ((bf16_t*)(ws + RB_VM))
#define ocat ((bf16_t*)(ws + RB_OCAT))
#define act ((bf16_t*)(ws + RB_ACT))
#define Y ((float*)(ws + WS_SCR))
#define XB ((bf16_t*)(ws + RC_Y))
#define YB ((bf16_t*)(ws + RC_Y + 64 * MiB))

#ifdef DIAG_NANFILL
    {
        PHASE_BEGIN();
        u32x4* p = (u32x4*)(ws + WS_CS); const size_t n16 = (WS_END - WS_CS) / 16;
        for (size_t i = (size_t)gw * 64 + lane; i < n16; i += (size_t)NGW * 64) p[i] = (u32x4){0xffffffffu, 0xffffffffu, 0xffffffffu, 0xffffffffu};
        u32x4* q = (u32x4*)X; const size_t m16 = (size_t)MTOK * DM / 4;
        for (size_t i = (size_t)gw * 64 + lane; i < m16; i += (size_t)NGW * 64) q[i] = (u32x4){0xffffffffu, 0xffffffffu, 0xffffffffu, 0xffffffffu};
    }
    xcd_barrier(bar);
#endif
#define TR_PIN(v) asm volatile("" : "+v"(v[0]), "+v"(v[1]), "+v"(v[2]), "+v"(v[3]), "+v"(v[4]), "+v"(v[5]), "+v"(v[6]), "+v"(v[7]) :: "memory")
#define CONV_BODY() \
        LAS float* scr = (LAS float*)(lds + wave * 8448); \
        constexpr int I_IN = 32 * 250, I_UQ = 8 * 48, I_UKV = 4 * 64, I_BR = 16 * 64, I_SQ = 32 * 64, I_KVX = 32 * 128, I_UP = 32 * 352, I_DN = 88 * 64; \
        constexpr int I_X = 2 * I_SQ + I_KVX, I_N = I_IN + I_UQ + I_UKV + 2 * I_BR + I_SQ + I_UP + I_DN, T_X = DEPTH * I_X, T_ALL = T_X + DEPTH * I_N; (void)T_ALL; \
        auto src_of = [&](int it) __attribute__((always_inline)) -> TrSrc { \
            if (it < T_X) { const int l = it / I_X; int r = it - l * I_X; \
                if (r < I_SQ) return TrSrc{w_q_x + (size_t)l * DM * DM + (size_t)r * 2048 + lane * 8, 4, 512}; r -= I_SQ;     \
                if (r < I_KVX) return tr_src(w_kv_x + (size_t)l * DM * 2 * DM, 2 * DM, r, lane); r -= I_KVX; \
                return tr_src(w_o_x + (size_t)l * DM * DM, DM, r, lane); } \
            it -= T_X; const int l = it / I_N; int r = it - l * I_N; \
            if (r < I_IN) return tr_src(w_in + (size_t)l * DM * NIN_SRC, NIN_SRC, r, lane); r -= I_IN; \
            if (r < I_UQ) return tr_src(w_uq + (size_t)l * 512 * 1536, 1536, r, lane); r -= I_UQ; \
            if (r < I_UKV) return tr_src(w_ukv + (size_t)l * 256 * 2048, 2048, r, lane); r -= I_UKV; \
            if (r < I_BR) return tr_src(w_br_diff + (size_t)l * 1024 * DM, DM, r, lane); r -= I_BR; \
            if (r < I_BR) return tr_src(w_br_mla + (size_t)l * 1024 * DM, DM, r, lane); r -= I_BR; \
            if (r < I_SQ) return tr_src(w_mix_out + (size_t)l * DM * DM, DM, r, lane); r -= I_SQ; \
            if (r < I_UP) return tr_src(w_up + (size_t)l * DM * NUP, NUP, r, lane); r -= I_UP; \
            return tr_src(w_down + (size_t)l * DFF * DM, DM, r, lane); }; \
        auto process = [&](int it, f32x4 (&v)[8]) __attribute__((always_inline)) { \
            if (it < T_X) { const int l = it / I_X; int r = it - l * I_X; \
                if (r < I_SQ) { const float gx_ = g_pre_x[(size_t)l * DM + r];     \
                    bf16_t* d_ = (bf16_t*)(ws + RA_QXP) + (size_t)l * DM * DM + (size_t)r * 2048 + lane * 8; \
                    _Pragma("unroll") for (int i = 0; i < 4; ++i) *(u32x4*)(d_ + i * 512) = pack8(v[2 * i] * gx_, v[2 * i + 1] * gx_); \
                    return; } r -= I_SQ; \
                if (r < I_KVX) { tr_st(v, 2 * DM, (bf16_t*)(ws + RA_KVXT) + (size_t)l * 2 * DM * DM, DM, 0, nullptr, scr, r, lane, MapId()); return; } r -= I_KVX; \
                tr_st(v, DM, (bf16_t*)(ws + RA_OXT) + (size_t)l * DM * DM, DM, 0, nullptr, scr, r, lane, MapId()); return; } \
            it -= T_X; const int l = it / I_N; int r = it - l * I_N; bf16_t* Wl = Wall + (size_t)l * W_LAYER; \
            if (r < I_IN) { tr_st(v, NIN_SRC, Wl + WO_IN, DM, 0, g_pre_mix + (size_t)l * DM, scr, r, lane, MapIn()); return; } r -= I_IN; \
            if (r < I_UQ) { tr_st(v, 1536, Wl + WO_UQ, 512, 0, g_cq + l * 512, scr, r, lane, MapUq()); return; } r -= I_UQ; \
            if (r < I_UKV) { tr_st(v, 2048, Wl + WO_UKV, 256, 0, g_ckv + l * 256, scr, r, lane, MapUkv()); return; } r -= I_UKV; \
            if (r < I_BR) { tr_st(v, DM, Wl + WO_BR, DM, 0, nullptr, scr, r, lane, MapId()); return; } r -= I_BR; \
            if (r < I_BR) { tr_st(v, DM, Wl + WO_BR, DM, 1024, nullptr, scr, r, lane, MapId()); return; } r -= I_BR; \
            if (r < I_SQ) { tr_st(v, DM, Wl + WO_MIX, DM, 0, nullptr, scr, r, lane, MapId()); return; } r -= I_SQ; \
            if (r < I_UP) { tr_st(v, NUP, Wl + WO_UP, DM, 0, g_pre_ffn + (size_t)l * DM, scr, r, lane, MapUp()); return; } r -= I_UP; \
            tr_st(v, DM, Wl + WO_DOWN, DFF, 0, nullptr, scr, r, lane, MapId()); }; \
          \
        auto conv_range = [&](int lo_, int hi_, int first_, int stride_) __attribute__((always_inline)) { \
            f32x4 va[8], vb[8]; const int last_ = hi_ - 1; int it = lo_ + first_; \
            tr_ld(src_of(it < hi_ ? it : last_), va); \
            for (; it < hi_; it += 2 * stride_) { const int i1 = it + stride_, i2 = it + 2 * stride_; \
                tr_ld(src_of(i1 < hi_ ? i1 : last_), vb); TR_PIN(va); process(it, va); \
                tr_ld(src_of(i2 < hi_ ? i2 : last_), va); TR_PIN(vb); if (i1 < hi_) process(i1, vb); } }
    if (EN(16) && PH(0)) {
        PHASE_BEGIN();
        CONV_BODY();
        conv_range(0, T_X, gw, NGW);
#ifdef PROBE_CONV_HOT
        for (int rep_ = 0; rep_ < 10; ++rep_) conv_range(0, I_X, gw, NGW);
#endif
        thin_mem_norm(mem, g_mem, memn, gw, NGW, lane);
    }
    SEAM(0);
    if (EN(17) && PH(1)) {
        PHASE_BEGIN();
        constexpr int NGA = 96;
        if (bx < NGA) {
            { pg8::Gemm g{WSB, WSB, DM, DM, DM}; pg8::MemKvOrder S{NGA, bx}; pg8::EpiMemKv E{Kmem};
              pg8::gemm_phase<pg8::EpiMemKv, pg8::MemKvOrder, true, true>(lds, g, S, E); }
            xcd_barrier(bar);
            { pg8::Gemm g{WSB, WSB, DM, DM, 512}; pg8::FoldOrder S{NGA, bx}; pg8::EpiFold E{Wall};
              pg8::gemm_phase<pg8::EpiFold, pg8::FoldOrder, true, true>(lds, g, S, E); }
        } else {
            CONV_BODY();
            const int gwb = (bx - NGA) * NWAVES + wave, ngwb = (G - NGA) * NWAVES;
            constexpr int T_MID = T_X + (int)(0.40 * (T_ALL - T_X));
            for (int seg = 0; seg < 2; ++seg) {
                if (seg == 1) xcd_barrier(bar);
                conv_range(seg == 0 ? T_X : T_MID, seg == 0 ? T_MID : T_ALL, gwb, ngwb);
            }
            for (int i = gwb * 64 + lane; i < DEPTH * 192 * (DM / 8); i += ngwb * 64) { const int l = i / (192 * (DM / 8)), r = i - l * (192 * (DM / 8));
                *(u32x4*)(Wall + (size_t)l * W_LAYER + WO_IN + (size_t)3904 * DM + (size_t)r * 8) = (u32x4){0u, 0u, 0u, 0u}; }
            for (int idx = gwb * 64 + lane; idx < MTOK * 32; idx += ngwb * 64) {
                const int m = idx >> 5, i = idx & 31;
                const float ang = (float)positions[m] * INV_FREQ(i);
                const double rev = (double)ang * 0.15915494309189535; const float f = (float)(rev - __builtin_rint(rev));
                cs[idx] = (f32x2){__builtin_amdgcn_cosf(f), __builtin_amdgcn_sinf(f)};
            }
            thin_first_norm(x_in, XB, RSX, gwb, ngwb, lane);
        }
    }
#undef CONV_BODY
#undef TR_PIN
    SEAM(1);

    for (int l = 0; l < DEPTH; ++l) {
        const int pb = 2 + l * NPL;
        if (pb + NPL <= lo || pb >= hi) continue;
        if (EN(0) && PH(pb + 0)) PREP(0) {
            PHASE_BEGIN(); const bf16_t* Wl = Wall + (size_t)l * W_LAYER; (void)Wl;
            pg8::Gemm g{XB, Wl + WO_IN, DM, DM, DM}; pg8::StaticOrder S; S.init(MTOK, NIN, G, bx, DM, DM);
            pg8::EpiProj E{Qd, Kd, Vd, cq, ckv, kpe, gates, ssq_cq, ssq_ckv, b_gate + (size_t)l * 4096, cs, RSX};
            pg8::gemm_phase<pg8::EpiProj, pg8::StaticOrder, EPI_ALIGN, true>(lds, g, S, E);
        }
        SEAM(pb + 0);
        if (EN(1) && PH(pb + 1)) PREP(1) {
            PHASE_BEGIN(); const bf16_t* Wl = Wall + (size_t)l * W_LAYER; (void)Wl;
            { pg8::Gemm g{cq, Wl + WO_UQ, 512, 512, 512}; pg8::StaticOrder S; S.init(MTOK, 1536, G, bx, 512, 512); pg8::EpiQm E{Qm, ssq_cq, cs};
              pg8::gemm_phase<pg8::EpiQm, pg8::StaticOrder, EPI_ALIGN, true>(lds, g, S, E); }
            { pg8::Gemm g{ckv, Wl + WO_UKV, 256, 256, 256}; pg8::StaticOrder S; S.init(MTOK, 2048, bx < 128 ? 512 : 128, bx, 256, 256); pg8::EpiKv E{Kn, Vm, ssq_ckv};
              pg8::gemm_phase<pg8::EpiKv, pg8::StaticOrder, EPI_ALIGN, true>(lds, g, S, E); }
        }
        SEAM(pb + 1);
#ifdef DIAG_PREFILL
        if (PH(pb + 2)) { { PHASE_BEGIN(); u32x4* p = (u32x4*)ocat; const size_t n16 = (size_t)MTOK * 2048 * 2 / 16;
            for (size_t i = (size_t)gw * 64 + lane; i < n16; i += (size_t)NGW * 64) p[i] = (u32x4){0u, 0u, 0u, 0u}; } xcd_barrier(bar); }
#endif
#ifdef DIAG_CKS
        if (l == 0 && PH(pb + 2)) { PHASE_BEGIN(); unsigned* pz = (unsigned*)(ws + WS_END + 1 * MiB) + (size_t)l * 8 * 2 * MTOK; unsigned* cw = (unsigned*)(ws + WS_CTL);
            cks_rows((const unsigned*)Qd, 512, MTOK, pz + 0 * 2 * MTOK, cw + 68, gw, NGW, lane); cks_rows((const unsigned*)Kd, 512, MTOK, pz + 1 * 2 * MTOK, cw + 68, gw, NGW, lane);
            cks_rows((const unsigned*)Vd, 512, MTOK, pz + 2 * 2 * MTOK, cw + 68, gw, NGW, lane); cks_rows((const unsigned*)Qm, 768, MTOK, pz + 3 * 2 * MTOK, cw + 69, gw, NGW, lane);
            cks_rows((const unsigned*)Kn, 512, MTOK, pz + 4 * 2 * MTOK, cw + 69, gw, NGW, lane); cks_rows((const unsigned*)Vm, 512, MTOK, pz + 5 * 2 * MTOK, cw + 69, gw, NGW, lane);
            cks_rows((const unsigned*)kpe, 32, MTOK, pz + 6 * 2 * MTOK, cw + 69, gw, NGW, lane); cks_rows((const unsigned*)H, 1024, MTOK, pz + 7 * 2 * MTOK, cw + 70, gw, NGW, lane); }
#endif
        if (EN(2) && PH(pb + 2)) {
            PHASE_BEGIN(); const bf16_t* Wl = Wall + (size_t)l * W_LAYER; (void)Wl;
            float lam;
            { const float a = lam_q1[l * 64 + lane] * lam_k1[l * 64 + lane], b2 = lam_q2[l * 64 + lane] * lam_k2[l * 64 + lane];
              lam = __builtin_amdgcn_exp2f(wave_sum(a) * LOG2E) - __builtin_amdgcn_exp2f(wave_sum(b2) * LOG2E) + LAM_INIT(l); }
            const float omli = 1.0f - LAM_INIT(l);
            const float Cd = 0.125f * LOG2E, Cm = 0.07216878364870322f * LOG2E;
            const int r32 = lane & 31, hi = lane >> 5;
#define SCRL() (Y + ((size_t)bx * NWAVES + wave) * 4096 + lane)
            LAS bf16_t* stg = (LAS bf16_t*)(lds + 81920 + wave * 4096);
            LAS bf16_t* stw = stg + hi * 4 * 64 + r32;
            const int srow = lane >> 3, sch = lane & 7;
#define STORE_O(Og) do { _Pragma("unroll") for (int hf = 0; hf < 2; ++hf) { \
                _Pragma("unroll") for (int r = 0; r < 16; ++r) _Pragma("unroll") for (int dd = 0; dd < 2; ++dd) \
                    stw[((r & 3) + 8 * (r >> 2)) * 64 + dd * 32] = (bf16_t)(cvt_pk_bf16(o[hf * 2 + dd][r], 0.f) & 0xffffu); \
                LDS_WAIT(); asm volatile("" ::: "memory"); \
                _Pragma("unroll") for (int i = 0; i < 4; ++i) { const u32x4 v = *(const LAS u32x4*)(stg + (i * 8 + srow) * 64 + sch * 8); \
                    st16<0>((Og) + (size_t)(i * 8 + srow) * 2048 + hf * 64 + sch * 8, v); } \
                LDS_WAIT(); asm volatile("" ::: "memory"); } } while (0)
#ifdef DIAG_CKS
#define CKS_O(slot, cw) do { unsigned c_ = 0u; _Pragma("unroll") for (int d_ = 0; d_ < 4; ++d_) _Pragma("unroll") for (int r_ = 0; r_ < 16; ++r_) c_ = c_ * 31u + __float_as_uint(o[d_][r_]); \
                c_ += (unsigned)__builtin_amdgcn_ds_swizzle((int)c_, (1 << 10) | 0x1f); c_ += (unsigned)__builtin_amdgcn_ds_swizzle((int)c_, (2 << 10) | 0x1f); c_ += (unsigned)__builtin_amdgcn_ds_swizzle((int)c_, (4 << 10) | 0x1f); \
                c_ += (unsigned)__builtin_amdgcn_ds_swizzle((int)c_, (8 << 10) | 0x1f); c_ += (unsigned)__builtin_amdgcn_ds_swizzle((int)c_, (16 << 10) | 0x1f); \
                { auto rr_ = __builtin_amdgcn_permlane32_swap(c_, c_, false, false); c_ = rr_[0] + rr_[1]; } \
                if (lane == 0) { unsigned* ps_ = (unsigned*)(ws + WS_END) + 2 * (size_t)(slot); const unsigned o0_ = __hip_atomic_load(ps_, __ATOMIC_RELAXED, __HIP_MEMORY_SCOPE_AGENT), o1_ = __hip_atomic_load(ps_ + 1, __ATOMIC_RELAXED, __HIP_MEMORY_SCOPE_AGENT); \
                    if (l == 0 && o1_ == (o0_ ^ 0x5a5a5a5au) && o0_ != c_) __hip_atomic_fetch_add((unsigned*)(ws + WS_CTL) + (cw), 1u, __ATOMIC_RELAXED, __HIP_MEMORY_SCOPE_AGENT); \
                    __hip_atomic_store(ps_, c_, __ATOMIC_RELAXED, __HIP_MEMORY_SCOPE_AGENT); __hip_atomic_store(ps_ + 1, c_ ^ 0x5a5a5a5au, __ATOMIC_RELAXED, __HIP_MEMORY_SCOPE_AGENT); } } while (0)
#else
#define CKS_O(slot, cw) do {} while (0)
#endif
#ifndef ATT_V1_DIFF
#define ATT_DIFF att::attn_pass2<false>
#else
#define ATT_DIFF att::attn_pass<4, false>
#endif
#ifdef ATT_P2_MLA
#define ATT_MLA att::attn_pass2<true>
#else
#define ATT_MLA att::attn_pass<12, true>
#endif
#ifndef PROBE_ATT_REPS
#define PROBE_ATT_REPS 1
#endif
#ifndef ATT_STATIC
            const int qg = (vcu >> 5) & 7;
            unsigned* qctr = (unsigned*)(ws + WS_CTL) + 256 + (l * 8 + qg) * 64;
            for (;;) {
                __syncthreads();
                if (tid == 0) MISC[4] = __hip_atomic_fetch_add(qctr, 1u, __ATOMIC_RELAXED, __HIP_MEMORY_SCOPE_AGENT);
                __syncthreads();
                const int it = (int)MISC[4]; if (it >= 128) break;
                const int e = it >> 2; const unsigned long long tb = e < 8 ? 0x091f0a0b0c0d0e0full : e < 16 ? 0x061a1b071c081d1eull : e < 24 ? 0x1503160417180519ull : 0x1000111201130214ull;
                const int code = (int)((tb >> ((e & 7) * 8)) & 0xffull), qb = code & 15, bh = qg * 4 + (it & 3), b = bh >> 3, hd = bh & 7; const size_t kv0 = (size_t)b * SEQ;
                const int NT = 4 * qb + 4; const size_t row0 = kv0 + (size_t)qb * 256;
                f32x16 o[4];
                if ((code >> 4) == 0) {
                    for (int br = 0; br < 2; ++br) {
                        ATT_DIFF(Qd + row0 * 1024 + hd * 128 + br * 64, 1024, Kd + kv0 * 1024 + hd * 128 + br * 64, nullptr, Vd + kv0 * 1024 + hd * 128, NT, Cd, lds, o);
                        if (br == 0) {
#pragma unroll
                            for (int d0 = 0; d0 < 4; ++d0) { float* pd = SCRL() + d0 * 1024; asm volatile("" : "+v"(pd));
#pragma unroll
                                for (int r = 0; r < 16; ++r) pd[r * 64] = o[d0][r]; }
                        }
                    }
                    float ss[16];
#pragma unroll
                    for (int r = 0; r < 16; ++r) ss[r] = 0.f;
#pragma unroll
                    for (int d0 = 0; d0 < 4; ++d0) { const float* pd = SCRL() + d0 * 1024; asm volatile("" : "+v"(pd));
#pragma unroll
                        for (int r = 0; r < 16; ++r) { const float d = pd[r * 64] - lam * o[d0][r]; o[d0][r] = d; ss[r] += d * d; } }
#pragma unroll
                    for (int r = 0; r < 16; ++r) {
                        ss[r] = __builtin_amdgcn_rsqf(half_sum(ss[r]) * (1.0f / 128.0f) + EPS) * omli; }
#pragma unroll
                    for (int d0 = 0; d0 < 4; ++d0)
#pragma unroll
                        for (int r = 0; r < 16; ++r) o[d0][r] = o[d0][r] * ss[r] * g_diff_sub[l * 128 + d0 * 32 + r32];
                    bf16_t* og = ocat + (row0 + (size_t)wave * 32) * 2048 + hd * 128;
                    STORE_O(og);
                } else {
                    ATT_MLA(Qm + row0 * 1536 + hd * 192, 1536, Kn + kv0 * 1024 + hd * 128, kpe + kv0 * 64, Vm + kv0 * 1024 + hd * 128, NT, Cm, lds, o);
                    bf16_t* og = ocat + (row0 + (size_t)wave * 32) * 2048 + 1024 + hd * 128;
                    STORE_O(og);
                }
            }
#else
            for (int rep_ = 0; rep_ < PROBE_ATT_REPS; ++rep_)
            for (int pr = vcu; pr < 256; pr += G) {
                const int bh = pr >> 3, s = pr & 7, b = bh >> 3, hd = bh & 7; const size_t kv0 = (size_t)b * SEQ;
#ifndef NO_DIFF
                for (int k = 0; k < 2; ++k) {
                    const int qb = k ? s : 15 - s, NT = 4 * qb + 4;     const size_t row0 = kv0 + (size_t)qb * 256;
                    f32x16 o[4];
#ifdef DIAG_SELFCHK
                    for (int rep = 0; rep < 2; ++rep) {
                        att::attn_pass<4, false>(Qd + row0 * 1024 + hd * 128, 1024, Kd + kv0 * 1024 + hd * 128, nullptr, Vd + kv0 * 1024 + hd * 128, NT, Cd, lds, o);
                        if (rep == 0) {
#pragma unroll
                            for (int q = 0; q < 16; ++q) *(f32x4*)(scrl + 4 * q) = (f32x4){o[q >> 2][(q & 3) * 4], o[q >> 2][(q & 3) * 4 + 1], o[q >> 2][(q & 3) * 4 + 2], o[q >> 2][(q & 3) * 4 + 3]};
                        } else { bool bad = false;
#pragma unroll
                            for (int q = 0; q < 32; ++q) { const unsigned long long w = __hip_atomic_load((const unsigned long long*)(scrl + 2 * q), __ATOMIC_RELAXED, __HIP_MEMORY_SCOPE_AGENT);
                                const int d0 = q >> 3, r = (q & 7) * 2; bad |= ((unsigned)w != __float_as_uint(o[d0][r])) | ((unsigned)(w >> 32) != __float_as_uint(o[d0][r + 1])); }
                            if (bad) __hip_atomic_fetch_add((unsigned*)(ws + WS_CTL) + 64, 1u, __ATOMIC_RELAXED, __HIP_MEMORY_SCOPE_AGENT); }
                    }
#endif
                    for (int br = 0; br < 2; ++br) {
                        ATT_DIFF(Qd + row0 * 1024 + hd * 128 + br * 64, 1024, Kd + kv0 * 1024 + hd * 128 + br * 64, nullptr, Vd + kv0 * 1024 + hd * 128, NT, Cd, lds, o);
                        if (br == 0) {
#pragma unroll
                            for (int d0 = 0; d0 < 4; ++d0) { float* pd = SCRL() + d0 * 1024; asm volatile("" : "+v"(pd));
#pragma unroll
                                for (int r = 0; r < 16; ++r) pd[r * 64] = o[d0][r]; }
                        }
                        CKS_O((((size_t)l * 512 + bh * 16 + qb) * 8 + wave) * 4 + br, 65);
                    }
                    float ss[16];
#pragma unroll
                    for (int r = 0; r < 16; ++r) ss[r] = 0.f;
#pragma unroll
                    for (int d0 = 0; d0 < 4; ++d0) { const float* pd = SCRL() + d0 * 1024; asm volatile("" : "+v"(pd));
#pragma unroll
                        for (int r = 0; r < 16; ++r) { const float d = pd[r * 64] - lam * o[d0][r]; o[d0][r] = d; ss[r] += d * d; } }
#pragma unroll
                    for (int r = 0; r < 16; ++r) {
                        ss[r] = __builtin_amdgcn_rsqf(half_sum(ss[r]) * (1.0f / 128.0f) + EPS) * omli; }
#pragma unroll
                    for (int d0 = 0; d0 < 4; ++d0)
#pragma unroll
                        for (int r = 0; r < 16; ++r) o[d0][r] = o[d0][r] * ss[r] * g_diff_sub[l * 128 + d0 * 32 + r32];
                    bf16_t* og = ocat + (row0 + (size_t)wave * 32) * 2048 + hd * 128;
                    CKS_O((((size_t)l * 512 + bh * 16 + qb) * 8 + wave) * 4 + 2, 66);
                    STORE_O(og);
                }
#endif
#ifndef NO_MLA
                for (int k = 0; k < 2; ++k) {
                    const int qb = k ? s : 15 - s, NT = 4 * qb + 4;     const size_t row0 = kv0 + (size_t)qb * 256;
                    f32x16 o[4];
                    ATT_MLA(Qm + row0 * 1536 + hd * 192, 1536, Kn + kv0 * 1024 + hd * 128, kpe + kv0 * 64, Vm + kv0 * 1024 + hd * 128, NT, Cm, lds, o);
                    bf16_t* og = ocat + (row0 + (size_t)wave * 32) * 2048 + 1024 + hd * 128;
                    CKS_O((((size_t)l * 512 + bh * 16 + qb) * 8 + wave) * 4 + 3, 67);
                    STORE_O(og);
                }
#endif
            }
#endif
#undef STORE_O
#undef SCRL
#undef CKS_O
            __syncthreads();
        }
#ifdef DIAG_NOATT
        if (PH(pb + 2)) { PHASE_BEGIN();
            for (size_t i = (size_t)gw * 64 + lane; i < (size_t)MTOK * 1024; i += (size_t)NGW * 64) { const size_t m = i >> 10, c = i & 1023;
                const float a = bflo((unsigned)Qd[i]) + bflo((unsigned)Kd[i]) + bflo((unsigned)Vd[i]) + bflo((unsigned)kpe[m * 64 + (c & 63)]);
                const float b2 = bflo((unsigned)Kn[i]) + bflo((unsigned)Vm[i]) + bflo((unsigned)Qm[m * 1536 + c]) + bflo((unsigned)Qm[m * 1536 + 512 + c]);
                ocat[m * 2048 + c] = (bf16_t)(cvt_pk_bf16(a * 0.5f, 0.f) & 0xffffu); ocat[m * 2048 + 1024 + c] = (bf16_t)(cvt_pk_bf16(b2 * 0.5f, 0.f) & 0xffffu); } }
#endif
        SEAM(pb + 2);
#ifdef DIAG_CKS
        if (l == 0 && PH(pb + 2)) { PHASE_BEGIN(); cks_rows((const unsigned*)ocat, 1024, MTOK, (unsigned*)(ws + WS_END + 2 * MiB), (unsigned*)(ws + WS_CTL) + 71, gw, NGW, lane); }
#endif
        if (EN(3) && PH(pb + 3)) PREP(3) {
            PHASE_BEGIN(); const bf16_t* Wl = Wall + (size_t)l * W_LAYER; (void)Wl;
            pg8::Gemm g{ocat, Wl + WO_BR, DM, DM, 1024}; pg8::GateOrder S; S.S.init(MTOK, DM, G, bx, DM, DM, WGM_N8); pg8::EpiGate2 E{gates, merged};
            pg8::gemm_phase<pg8::EpiGate2, pg8::GateOrder, true, true>(lds, g, S, E);
        }
        SEAM(pb + 3);
        if (EN(4) && PH(pb + 4)) PREP(4) {
            PHASE_BEGIN(); const bf16_t* Wl = Wall + (size_t)l * W_LAYER; (void)Wl;
            pg8::Gemm g{merged, Wl + WO_MIX, DM, DM, DM}; pg8::StaticOrder S; S.init(MTOK, DM, G, bx, DM, DM, WGM_N8); pg8::EpiBf16 E{YB, DM};
            pg8::gemm_phase<pg8::EpiBf16, pg8::StaticOrder, EPI_ALIGN, true>(lds, g, S, E);
        }
        SEAM(pb + 4);
#ifdef DIAG_CKS
        if (l == 0 && PH(pb + 4)) { PHASE_BEGIN(); cks_rows((const unsigned*)Y, 2048, MTOK, (unsigned*)(ws + WS_END + 4 * MiB), (unsigned*)(ws + WS_CTL) + 73, gw, NGW, lane); }
#endif
        if (EN(5) && PH(pb + 5)) { PHASE_BEGIN();
            thin_res_norm(YB, XB, g_post_mix + (size_t)l * DM, RSX, gw, NGW, lane); }
        SEAM(pb + 5);
        if (EN(6) && PH(pb + 6)) PREP(6) {
            PHASE_BEGIN(); const bf16_t* Wl = Wall + (size_t)l * W_LAYER; (void)Wl;
            pg8::Gemm g{XB, Wl + WO_WK, DM, DM, DM}; pg8::CrossSOrder S{G, bx}; pg8::EpiSoftmax E{Pm, RSX};
            pg8::gemm_phase<pg8::EpiSoftmax, pg8::CrossSOrder, false, true>(lds, g, S, E);
        }
        SEAM(pb + 6);
        if (EN(10) && PH(pb + 10)) PREP(10) {
            PHASE_BEGIN(); const bf16_t* Wl = Wall + (size_t)l * W_LAYER; (void)Wl;
            pg8::Gemm g{Pm, Wl + WO_VW, 1024, 1024, 1024}; pg8::CrossYOrder S{G, bx}; pg8::EpiBf16 E{YB, DM};
            pg8::gemm_phase<pg8::EpiBf16, pg8::CrossYOrder, EPI_ALIGN, true>(lds, g, S, E);
        }
        SEAM(pb + 10);
        if (EN(11) && PH(pb + 11)) { PHASE_BEGIN();
            thin_res_norm(YB, XB, g_post_x + (size_t)l * DM, RSX, gw, NGW, lane); }
        SEAM(pb + 11);
        if (EN(12) && PH(pb + 12)) PREP(12) {
#if defined(PROBE_FLUSH) && PROBE_FLUSH == 1
            if (rep_ == 1) FLUSH_SWEEP();
#endif
            PHASE_BEGIN(); const bf16_t* Wl = Wall + (size_t)l * W_LAYER; (void)Wl;
            pg8::Gemm g{XB, Wl + WO_UP, DM, DM, DM}; pg8::StaticOrder S; S.init(MTOK, NUP, G, bx, DM, DM);
            pg8::EpiConvGlu E{act, Y, conv_w + (size_t)l * 3 * NUP, conv_b + (size_t)l * NUP, lds + 132096, RSX};
            pg8::gemm_phase<pg8::EpiConvGlu, pg8::StaticOrder, true, true>(lds, g, S, E);
        }
#if defined(PROBE_FLUSH) && PROBE_FLUSH == 2
        if (PH(pb + 12)) FLUSH_SWEEP();
#endif
        SEAM(pb + 12);
        if (EN(13) && PH(pb + 13)) PREP(13) { PHASE_BEGIN(); thin_conv_fix(Y, act, conv_w + (size_t)l * 3 * NUP, conv_b + (size_t)l * NUP, gw, NGW, lane); }
        SEAM(pb + 13);
        if (EN(14) && PH(pb + 14)) PREP(14) {
            PHASE_BEGIN(); const bf16_t* Wl = Wall + (size_t)l * W_LAYER; (void)Wl;
            pg8::Gemm g{act, Wl + WO_DOWN, DFF, DFF, DFF}; pg8::StaticOrder S; S.init(MTOK, DM, G, bx, DFF, DFF, WGM_N8); pg8::EpiBf16 E{YB, DM};
            pg8::gemm_phase<pg8::EpiBf16, pg8::StaticOrder, EPI_ALIGN, true>(lds, g, S, E);
        }
        SEAM(pb + 14);
        if (EN(15) && PH(pb + 15)) { PHASE_BEGIN(); thin_res_norm(YB, XB, g_post_ffn + (size_t)l * DM, l + 1 < DEPTH ? RSX : nullptr, gw, NGW, lane, l + 1 < DEPTH ? nullptr : X); }
        SEAM(pb + 15);
#ifdef DIAG_CKS
        if (l == DEPTH - 1 && PH(pb + 15)) { PHASE_BEGIN(); xcd_barrier(bar);
            const unsigned c65 = __hip_atomic_load((unsigned*)(ws + WS_CTL) + 65, __ATOMIC_RELAXED, __HIP_MEMORY_SCOPE_AGENT), c66 = __hip_atomic_load((unsigned*)(ws + WS_CTL) + 66, __ATOMIC_RELAXED, __HIP_MEMORY_SCOPE_AGENT),
                           c67 = __hip_atomic_load((unsigned*)(ws + WS_CTL) + 67, __ATOMIC_RELAXED, __HIP_MEMORY_SCOPE_AGENT);
            (void)c65; (void)c66; (void)c67; const unsigned c68 = __hip_atomic_load((unsigned*)(ws + WS_CTL) + 68, __ATOMIC_RELAXED, __HIP_MEMORY_SCOPE_AGENT), c69 = __hip_atomic_load((unsigned*)(ws + WS_CTL) + 69, __ATOMIC_RELAXED, __HIP_MEMORY_SCOPE_AGENT),
                           c70 = __hip_atomic_load((unsigned*)(ws + WS_CTL) + 70, __ATOMIC_RELAXED, __HIP_MEMORY_SCOPE_AGENT);
            (void)c68; (void)c69; (void)c70; (void)c66; (void)c67; const unsigned c71 = __hip_atomic_load((unsigned*)(ws + WS_CTL) + 71, __ATOMIC_RELAXED, __HIP_MEMORY_SCOPE_AGENT), c72 = __hip_atomic_load((unsigned*)(ws + WS_CTL) + 72, __ATOMIC_RELAXED, __HIP_MEMORY_SCOPE_AGENT),
                           c73 = __hip_atomic_load((unsigned*)(ws + WS_CTL) + 73, __ATOMIC_RELAXED, __HIP_MEMORY_SCOPE_AGENT);
            const float fac = 1.0f + (c71 ? 0.4f : 0.f) + (c72 ? 0.2f : 0.f) + (c73 ? 0.1f : 0.f);
            if (fac != 1.0f) { for (size_t i = (size_t)gw * 64 + lane; i < (size_t)MTOK * DM; i += (size_t)NGW * 64) X[i] *= fac; } }
#endif
#ifdef DIAG_SELFCHK
        if (l == DEPTH - 1 && PH(pb + 15)) { PHASE_BEGIN(); xcd_barrier(bar);
            if (__hip_atomic_load((unsigned*)(ws + WS_CTL) + 64, __ATOMIC_RELAXED, __HIP_MEMORY_SCOPE_AGENT) != 0u) {
                for (size_t i = (size_t)gw * 64 + lane; i < (size_t)MTOK * DM; i += (size_t)NGW * 64) X[i] = __builtin_nanf(""); } }
#endif
    }
#ifdef PROBE_WALL
    {
        PHASE_BEGIN(); asm volatile("s_waitcnt vmcnt(0)" ::: "memory"); __syncthreads(); WALL_TICK(NPH - 1);
        if (bx == 0 && tid == 0) { const unsigned ticks = MISC[14]; const unsigned long long t0 = __builtin_amdgcn_s_memrealtime();
            while ((unsigned)(__builtin_amdgcn_s_memrealtime() - t0) < ticks) __builtin_amdgcn_s_sleep(8); }
    }
#endif
#ifdef PROBE_BARWAIT
    {
        PHASE_BEGIN(); unsigned* ctl = (unsigned*)(ws + WS_CTL) + 80;
        if (tid == 0) __hip_atomic_fetch_add(ctl, MISC[10], __ATOMIC_RELAXED, __HIP_MEMORY_SCOPE_AGENT);
        xcd_barrier(bar);
        if (bx == 0 && tid == 0) {
            unsigned ticks = PROBE_BARWAIT == 0 ? __hip_atomic_load(ctl, __ATOMIC_RELAXED, __HIP_MEMORY_SCOPE_AGENT) / (unsigned)G : 0u;
            const unsigned long long t0 = __builtin_amdgcn_s_memrealtime();
            while ((unsigned)(__builtin_amdgcn_s_memrealtime() - t0) < ticks) __builtin_amdgcn_s_sleep(8);
        }
    }
#endif
#undef PH
#undef SEAM
}

extern "C" void kernel_launch(void* const* d_in, const int* in_sizes, int n_in, void* d_out, int out_size, void* d_ws, size_t ws_size, hipStream_t stream) {
    static int grid = 0;
    if (grid == 0) {
        if (n_in != 31 || in_sizes[0] != MTOK * DM || out_size != MTOK * DM || ws_size < WS_TOP) {
            fprintf(stderr, "kernel_launch: unexpected shapes: n_in %d in0 %d out %d ws %zu (need %zu)\n", n_in, n_in > 0 ? in_sizes[0] : -1, out_size, ws_size, (size_t)WS_TOP); grid = -1; return; }
        int dev = 0, cus = 0;
        if (hipGetDevice(&dev) != hipSuccess || hipDeviceGetAttribute(&cus, hipDeviceAttributeMultiprocessorCount, dev) != hipSuccess) { grid = -1; return; }
        if (hipFuncSetAttribute((const void*)fwd, hipFuncAttributeMaxDynamicSharedMemorySize, LDS_BYTES) != hipSuccess) { fprintf(stderr, "kernel_launch: hipFuncSetAttribute failed\n"); grid = -1; return; }
        int per_cu = 0;
        if (hipOccupancyMaxActiveBlocksPerMultiprocessor(&per_cu, (const void*)fwd, NWAVES * 64, LDS_BYTES) != hipSuccess || per_cu < 1)
            fprintf(stderr, "kernel_launch: note: occupancy query reports %d workgroups per CU\n", per_cu);
        (void)hipGetLastError();
        if (cus != 256) { fprintf(stderr, "kernel_launch: built for a 256-CU MI355X (one 256 x 256 score unit per workgroup in the fused softmax phase); this device reports %d CUs; nothing launched\n", cus); grid = -1; return; }
        grid = cus;
    }
    if (grid < 0) return;
    if (hipMemsetAsync((char*)d_ws + WS_CTL, 0, CTL_ZERO_BYTES, stream) != hipSuccess) return;
    Args a{};
    for (int i = 0; i < 31; ++i) a.in[i] = d_in[i];
    a.out = (float*)d_out; a.ws = (unsigned char*)d_ws;
    for (int l = 0; l < 4; ++l) a.lam_init[l] = (float)(0.8 - 0.6 * exp(-0.3 * (double)l));
    for (int i = 0; i < 32; ++i) a.inv_freq[i] = (float)pow(10000.0, -(double)i / 32.0);
#if MK_SINGLE
    a.ph_lo = 0; a.ph_hi = NPH;
    hipLaunchKernelGGL(fwd, dim3(grid), dim3(NWAVES * 64), LDS_BYTES, stream, a);
#else
    for (int p = 0; p < NPH; ++p) { a.ph_lo = p; a.ph_hi = p + 1; hipLaunchKernelGGL(fwd, dim3(grid), dim3(NWAVES * 64), LDS_BYTES, stream, a); }
#endif
    const hipError_t le = hipPeekAtLastError();
    if (le != hipSuccess) fprintf(stderr, "kernel_launch: launch failed: %s\n", hipGetErrorName(le));
}
```
